# Optimizing an MI355X kernel written in HIP

```python
import math
import jax, jax.numpy as jnp
from jax import lax
import numpy as np

D_MODEL = 1024
BATCH = 2
SEQ = 16384
DEPTH = 4

GRID_W = 64
CTX_LEN = 256
HEAD_DIM = 64
ROPE_BASE = 10000.0
EPS = 1e-6

POOL_GROUPS = 4
POOL_GROUP_DIM = 64
POOL_WIDTH = POOL_GROUPS * POOL_GROUP_DIM
POOL_WINDOWS = (2, 4, 8, 16)
SWA_Q_HEADS = 12
SWA_KV_HEADS = 4
SWA_WINDOW = 128
SWA_BLOCK = 128
EVEN_IN = POOL_WIDTH + (SWA_Q_HEADS + 2 * SWA_KV_HEADS) * HEAD_DIM
EVEN_MIX = POOL_WIDTH + SWA_Q_HEADS * HEAD_DIM

HYENA_WIDTH = 512
HYENA_EMB = 33
HYENA_HIDDEN = 64
HYENA_FAST_DECAY = 0.3
HYENA_SLOW_DECAY = 1.5
HYENA_TARGET = 1e-2
MLA_HEADS = 8
MLA_NOPE = 64
MLA_ROPE = 32
MLA_QK = MLA_NOPE + MLA_ROPE
MLA_V = 64
MLA_Q_RANK = 256
MLA_KV_RANK = 128
ODD_IN = 3 * HYENA_WIDTH + MLA_Q_RANK + MLA_KV_RANK + MLA_ROPE
ODD_MIX = HYENA_WIDTH + MLA_HEADS * MLA_V
ATTN_BLOCK = 128

N_EXPERTS = 16
N_GROUPS = 4
EXPERTS_PER_GROUP = N_EXPERTS // N_GROUPS
TOP_K = 2
EXPERT_FF = 512

kernel_name = "hybrid_pool_swa_hyena_mla_moe_dit"


def rms(x, g):
    xf = x.astype(jnp.float32)
    y = xf * lax.rsqrt(jnp.mean(xf * xf, axis=-1, keepdims=True) + EPS)
    return (y * g.astype(jnp.float32)).astype(x.dtype)


def modulate(x, g, shift, scale):
    return rms(x, g) * (1 + scale) + shift


def axial_rope(n_lat, d_rot):
    rows = n_lat // GRID_W
    row = jnp.repeat(jnp.arange(rows), GRID_W).astype(jnp.float32)
    col = jnp.tile(jnp.arange(GRID_W), rows).astype(jnp.float32)
    n_freq = d_rot // 4
    inv = ROPE_BASE ** (-jnp.arange(n_freq, dtype=jnp.float32) / n_freq)
    ang = jnp.concatenate([row[:, None] * inv, col[:, None] * inv], axis=-1)
    return jnp.cos(ang), jnp.sin(ang)


def apply_rope(x, cos, sin):
    half = x.shape[-1] // 2
    x1, x2 = x[..., :half], x[..., half:]
    c = cos[:, None, :].astype(x.dtype)
    s = sin[:, None, :].astype(x.dtype)
    return jnp.concatenate([x1 * c - x2 * s, x2 * c + x1 * s], axis=-1)


def pool_mix(a, pool_w, pool_scale):
    B, L, _ = a.shape
    af = a.astype(jnp.float32)
    cs = jnp.concatenate([jnp.zeros_like(af[:, :1]), jnp.cumsum(af, axis=1)], axis=1)
    t = jnp.arange(L)
    outs = []
    for g, w in enumerate(POOL_WINDOWS):
        lo = jnp.clip(t - w // 2, 0, L)
        hi = jnp.clip(t + w // 2, 0, L)
        sl = slice(g * POOL_GROUP_DIM, (g + 1) * POOL_GROUP_DIM)
        cnt = (hi - lo).astype(jnp.float32)[None, :, None]
        outs.append((cs[:, hi, sl] - cs[:, lo, sl]) / cnt - af[:, :, sl])
    p = jnp.stack(outs, axis=2)
    y = jnp.einsum('blgc,gcd->blgd', p, pool_w.astype(jnp.float32)).reshape(B, L, POOL_WIDTH)
    return (y * pool_scale.astype(jnp.float32)).astype(a.dtype)


def swa_latent(q, k, v, kc, vc, sink):
    B, S = q.shape[:2]
    C = kc.shape[1]
    nb = S // SWA_BLOCK
    G = SWA_Q_HEADS // SWA_KV_HEADS
    nk = 3 * SWA_BLOCK
    qb = q.reshape(B, nb, SWA_BLOCK, SWA_KV_HEADS, G, HEAD_DIM)

    def band(t):
        tp = jnp.pad(t, ((0, 0), (SWA_BLOCK, SWA_BLOCK), (0, 0), (0, 0)))
        tp = tp.reshape(B, nb + 2, SWA_BLOCK, SWA_KV_HEADS, HEAD_DIM)
        return jnp.concatenate([tp[:, :nb], tp[:, 1:nb + 1], tp[:, 2:]], axis=2)

    kb, vb = band(k), band(v)
    blk = jnp.arange(nb)[:, None, None] * SWA_BLOCK
    qpos = blk + jnp.arange(SWA_BLOCK)[None, :, None]
    kpos = blk - SWA_BLOCK + jnp.arange(nk)[None, None, :]
    valid = (jnp.abs(kpos - qpos) <= SWA_WINDOW) & (kpos >= 0) & (kpos < S)
    scale = HEAD_DIM ** -0.5
    s_lat = jnp.einsum('bnqhgd,bnkhd->bhgnqk', qb, kb, preferred_element_type=jnp.float32) * scale
    s_lat = jnp.where(valid, s_lat, -jnp.inf)
    s_ctx = jnp.einsum('bnqhgd,bchd->bhgnqc', qb, kc, preferred_element_type=jnp.float32) * scale
    snk = jnp.broadcast_to(sink.astype(jnp.float32).reshape(SWA_KV_HEADS, G)[None, :, :, None, None, None],
                           s_lat.shape[:-1] + (1,))
    p = jax.nn.softmax(jnp.concatenate([s_lat, s_ctx, snk], axis=-1), axis=-1)
    o = (jnp.einsum('bhgnqk,bnkhd->bnqhgd', p[..., :nk].astype(vb.dtype), vb)
         + jnp.einsum('bhgnqc,bchd->bnqhgd', p[..., nk:nk + C].astype(vc.dtype), vc))
    return o.reshape(B, S, SWA_Q_HEADS * HEAD_DIM)


def swa_context(qc, kc, vc, sink):
    B, C = qc.shape[:2]
    G = SWA_Q_HEADS // SWA_KV_HEADS
    q = qc.reshape(B, C, SWA_KV_HEADS, G, HEAD_DIM)
    s = jnp.einsum('bqhgd,bkhd->bhgqk', q, kc, preferred_element_type=jnp.float32) * HEAD_DIM ** -0.5
    snk = jnp.broadcast_to(sink.astype(jnp.float32).reshape(SWA_KV_HEADS, G)[None, :, :, None, None],
                           s.shape[:-1] + (1,))
    p = jax.nn.softmax(jnp.concatenate([s, snk], axis=-1), axis=-1)[..., :C]
    o = jnp.einsum('bhgqk,bkhd->bqhgd', p.astype(vc.dtype), vc)
    return o.reshape(B, C, SWA_Q_HEADS * HEAD_DIM)


def split_even(p):
    B, L = p.shape[:2]
    o1 = POOL_WIDTH
    o2 = o1 + SWA_Q_HEADS * HEAD_DIM
    o3 = o2 + SWA_KV_HEADS * HEAD_DIM
    a = p[..., :o1]
    q = p[..., o1:o2].reshape(B, L, SWA_Q_HEADS, HEAD_DIM)
    k = p[..., o2:o3].reshape(B, L, SWA_KV_HEADS, HEAD_DIM)
    v = p[..., o3:].reshape(B, L, SWA_KV_HEADS, HEAD_DIM)
    return a, q, k, v


def even_mixer(hl, hc, w_in, w_out, pool_w, pool_scale, q_gain, k_gain, sink, rope, need_ctx):
    al, ql, kl, vl = split_even(hl @ w_in)
    ac, qc, kc, vc = split_even(hc @ w_in)
    ql = apply_rope(rms(ql, q_gain), *rope)
    kl = apply_rope(rms(kl, k_gain), *rope)
    kc = rms(kc, k_gain)
    out_l = jnp.concatenate([pool_mix(al, pool_w, pool_scale),
                             swa_latent(ql, kl, vl, kc, vc, sink)], axis=-1) @ w_out
    out_c = None
    if need_ctx:
        qc = rms(qc, q_gain)
        out_c = jnp.concatenate([pool_mix(ac, pool_w, pool_scale),
                                 swa_context(qc, kc, vc, sink)], axis=-1) @ w_out
    return out_l, out_c


def short_conv(x, w, b):
    L = x.shape[1]
    xp = jnp.pad(x, ((0, 0), (1, 1), (0, 0)))
    return xp[:, :L] * w[0] + xp[:, 1:L + 1] * w[1] + xp[:, 2:] * w[2] + b


def hyena_filter(L, w1, b1, w2, b2, w3, freq):
    f32 = jnp.float32
    pos = jnp.arange(L, dtype=f32)
    t = pos / max(L - 1, 1)
    bands = (HYENA_EMB - 1) // 2
    fr = jnp.linspace(1e-4, bands - 1, bands, dtype=f32)
    ang = (2 * math.pi / L) * pos[:, None] * fr
    z = jnp.concatenate([t[:, None], jnp.cos(ang), -jnp.sin(ang)], axis=-1)
    h = jnp.sin(freq[0].astype(f32) * (z @ w1.astype(f32) + b1.astype(f32)))
    h = jnp.sin(freq[1].astype(f32) * (h @ w2.astype(f32) + b2.astype(f32)))
    h = h @ w3.astype(f32)
    deltas = jnp.abs(jnp.linspace(math.log(HYENA_TARGET) / HYENA_FAST_DECAY,
                                  math.log(HYENA_TARGET) / HYENA_SLOW_DECAY, HYENA_WIDTH, dtype=f32))
    decay = jnp.exp(-t[:, None] * deltas)
    h_fwd = h[:, :HYENA_WIDTH] * decay
    h_bwd = h[:, HYENA_WIDTH:] * decay
    g = jnp.concatenate([h_fwd, jnp.zeros_like(h_fwd[:1]), h_bwd[:0:-1]], axis=0)
    return g / jnp.sum(jnp.abs(g), axis=0, keepdims=True)


def hyena_mix(u, conv_w, conv_b, w1, b1, w2, b2, w3, freq, skip):
    L = u.shape[1]
    uc = short_conv(u, conv_w, conv_b).astype(jnp.float32)
    x0 = uc[..., :HYENA_WIDTH]
    x1 = uc[..., HYENA_WIDTH:2 * HYENA_WIDTH]
    v = uc[..., 2 * HYENA_WIDTH:]
    z = v * x1
    g = hyena_filter(L, w1, b1, w2, b2, w3, freq)
    y = jnp.fft.irfft(jnp.fft.rfft(z, n=2 * L, axis=1) * jnp.fft.rfft(g, n=2 * L, axis=0)[None],
                      n=2 * L, axis=1)[:, :L]
    return (x0 * (y + skip.astype(jnp.float32) * z)).astype(u.dtype)


def mla_queries(cq, cq_gain, w_uq, q_gain, rope):
    B, L = cq.shape[:2]
    q = (rms(cq, cq_gain) @ w_uq).reshape(B, L, MLA_HEADS, MLA_QK)
    q = rms(q, q_gain)
    if rope is not None:
        q = jnp.concatenate([q[..., :MLA_NOPE], apply_rope(q[..., MLA_NOPE:], *rope)], axis=-1)
    return q


def mla_keys_values(ckv, kr, ckv_gain, w_ukv, k_gain, rope):
    B, L = ckv.shape[:2]
    kv = (rms(ckv, ckv_gain) @ w_ukv).reshape(B, L, MLA_HEADS, MLA_NOPE + MLA_V)
    k = jnp.concatenate([kv[..., :MLA_NOPE],
                         jnp.broadcast_to(kr[:, :, None, :], (B, L, MLA_HEADS, MLA_ROPE))], axis=-1)
    k = rms(k, k_gain)
    if rope is not None:
        k = jnp.concatenate([k[..., :MLA_NOPE], apply_rope(k[..., MLA_NOPE:], *rope)], axis=-1)
    return k, kv[..., MLA_NOPE:]


def mla_latent(ql, kl, vl, kc, vc):
    B, S = ql.shape[:2]
    nb = S // ATTN_BLOCK
    k_all = jnp.concatenate([kl, kc], axis=1)
    v_all = jnp.concatenate([vl, vc], axis=1)
    qb = ql.reshape(B, nb, ATTN_BLOCK, MLA_HEADS, MLA_QK).transpose(1, 0, 2, 3, 4)
    scale = MLA_QK ** -0.5

    def one_block(q):
        s = jnp.einsum('bqhd,bkhd->bhqk', q, k_all, preferred_element_type=jnp.float32) * scale
        p = jax.nn.softmax(s, axis=-1)
        return jnp.einsum('bhqk,bkhd->bqhd', p.astype(v_all.dtype), v_all)

    o = lax.map(one_block, qb)
    return o.transpose(1, 0, 2, 3, 4).reshape(B, S, MLA_HEADS * MLA_V)


def mla_context(qc, kc, vc):
    B, C = qc.shape[:2]
    s = jnp.einsum('bqhd,bkhd->bhqk', qc, kc, preferred_element_type=jnp.float32) * MLA_QK ** -0.5
    p = jax.nn.softmax(s, axis=-1)
    return jnp.einsum('bhqk,bkhd->bqhd', p.astype(vc.dtype), vc).reshape(B, C, MLA_HEADS * MLA_V)


def split_odd(p):
    o1 = 3 * HYENA_WIDTH
    o2 = o1 + MLA_Q_RANK
    o3 = o2 + MLA_KV_RANK
    return p[..., :o1], p[..., o1:o2], p[..., o2:o3], p[..., o3:]


def odd_mixer(hl, hc, w_in, w_out, conv_w, conv_b, w1, b1, w2, b2, w3, freq, skip,
              cq_gain, ckv_gain, w_uq, w_ukv, q_gain, k_gain, rope, need_ctx):
    ul, cql, ckvl, krl = split_odd(hl @ w_in)
    uc, cqc, ckvc, krc = split_odd(hc @ w_in)
    ql = mla_queries(cql, cq_gain, w_uq, q_gain, rope)
    kl, vl = mla_keys_values(ckvl, krl, ckv_gain, w_ukv, k_gain, rope)
    kc, vc = mla_keys_values(ckvc, krc, ckv_gain, w_ukv, k_gain, None)
    out_l = jnp.concatenate([hyena_mix(ul, conv_w, conv_b, w1, b1, w2, b2, w3, freq, skip),
                             mla_latent(ql, kl, vl, kc, vc)], axis=-1) @ w_out
    out_c = None
    if need_ctx:
        qc = mla_queries(cqc, cq_gain, w_uq, q_gain, None)
        out_c = jnp.concatenate([hyena_mix(uc, conv_w, conv_b, w1, b1, w2, b2, w3, freq, skip),
                                 mla_context(qc, kc, vc)], axis=-1) @ w_out
    return out_l, out_c


def moe(h, router_w, router_b, w_gate, w_up, w_down):
    T = h.shape[0]
    scores = jax.nn.sigmoid(jnp.dot(h, router_w, preferred_element_type=jnp.float32))
    biased = scores + router_b.astype(jnp.float32)
    grp_score = lax.top_k(biased.reshape(T, N_GROUPS, EXPERTS_PER_GROUP), 2)[0].sum(-1)
    sel_group = jnp.argmax(grp_score, axis=-1)
    in_group = (jnp.arange(N_EXPERTS) // EXPERTS_PER_GROUP)[None, :] == sel_group[:, None]
    _, idx = lax.top_k(jnp.where(in_group, biased, -jnp.inf), TOP_K)
    w_sel = jnp.take_along_axis(scores, idx, axis=-1)
    w_sel = w_sel / jnp.sum(w_sel, axis=-1, keepdims=True)
    combine = jnp.sum(jax.nn.one_hot(idx, N_EXPERTS, dtype=jnp.float32) * w_sel[..., None], axis=1)
    out = jnp.zeros(h.shape, jnp.float32)
    for e in range(N_EXPERTS):
        a = jax.nn.silu(h @ w_gate[e]) * (h @ w_up[e])
        out = out + combine[:, e:e + 1] * (a @ w_down[e])
    return out.astype(h.dtype)


def setup_inputs(seed: int = 0) -> dict:
    key = jax.random.key(seed)
    ks = iter(jax.random.split(key, 48))
    f32 = jnp.float32
    n_even = (DEPTH + 1) // 2
    n_odd = DEPTH // 2

    def nrm(shape, scale):
        return jax.random.normal(next(ks), shape, f32) * scale

    def gain(shape):
        return 1.0 + nrm(shape, 0.05)

    D = D_MODEL
    return {
        "x": nrm((BATCH, SEQ, D), 1.0),
        "c": nrm((BATCH, D), 1.0),
        "ctx": nrm((BATCH, CTX_LEN, D), 1.0),
        "c_ctx": nrm((D,), 1.0),
        "ada_w": nrm((DEPTH, D, 6 * D), 0.5 * D ** -0.5),
        "ada_b": nrm((DEPTH, 6 * D), 0.01),
        "norm_g": gain((DEPTH, 2, D)),
        "ev_w_in": nrm((n_even, D, EVEN_IN), D ** -0.5),
        "ev_w_out": nrm((n_even, EVEN_MIX, D), EVEN_MIX ** -0.5),
        "pool_w": nrm((n_even, POOL_GROUPS, POOL_GROUP_DIM, POOL_GROUP_DIM), POOL_GROUP_DIM ** -0.5),
        "pool_scale": 1.0 + nrm((n_even, POOL_WIDTH), 0.1),
        "swa_q_gain": gain((n_even, HEAD_DIM)),
        "swa_k_gain": gain((n_even, HEAD_DIM)),
        "swa_sink": nrm((n_even, SWA_Q_HEADS), 1.0),
        "od_w_in": nrm((n_odd, D, ODD_IN), D ** -0.5),
        "od_w_out": nrm((n_odd, ODD_MIX, D), ODD_MIX ** -0.5),
        "hy_conv_w": nrm((n_odd, 3, 3 * HYENA_WIDTH), 0.5),
        "hy_conv_b": nrm((n_odd, 3 * HYENA_WIDTH), 0.01),
        "hy_w1": nrm((n_odd, HYENA_EMB, HYENA_HIDDEN), HYENA_EMB ** -0.5),
        "hy_b1": nrm((n_odd, HYENA_HIDDEN), 0.1),
        "hy_w2": nrm((n_odd, HYENA_HIDDEN, HYENA_HIDDEN), HYENA_HIDDEN ** -0.5),
        "hy_b2": nrm((n_odd, HYENA_HIDDEN), 0.1),
        "hy_w3": nrm((n_odd, HYENA_HIDDEN, 2 * HYENA_WIDTH), HYENA_HIDDEN ** -0.5),
        "hy_freq": gain((n_odd, 2, HYENA_HIDDEN)),
        "hy_skip": nrm((n_odd, HYENA_WIDTH), 1.0),
        "mla_cq_gain": gain((n_odd, MLA_Q_RANK)),
        "mla_ckv_gain": gain((n_odd, MLA_KV_RANK)),
        "mla_w_uq": nrm((n_odd, MLA_Q_RANK, MLA_HEADS * MLA_QK), MLA_Q_RANK ** -0.5),
        "mla_w_ukv": nrm((n_odd, MLA_KV_RANK, MLA_HEADS * (MLA_NOPE + MLA_V)), MLA_KV_RANK ** -0.5),
        "mla_q_gain": gain((n_odd, MLA_QK)),
        "mla_k_gain": gain((n_odd, MLA_QK)),
        "router_w": nrm((D, N_EXPERTS), D ** -0.5),
        "router_b": nrm((N_EXPERTS,), 0.01),
        "moe_w_gate": nrm((DEPTH, N_EXPERTS, D, EXPERT_FF), D ** -0.5),
        "moe_w_up": nrm((DEPTH, N_EXPERTS, D, EXPERT_FF), D ** -0.5),
        "moe_w_down": nrm((DEPTH, N_EXPERTS, EXPERT_FF, D), EXPERT_FF ** -0.5),
    }


def reference(x, c, ctx, c_ctx, ada_w, ada_b, norm_g, ev_w_in, ev_w_out, pool_w, pool_scale,
              swa_q_gain, swa_k_gain, swa_sink, od_w_in, od_w_out, hy_conv_w, hy_conv_b,
              hy_w1, hy_b1, hy_w2, hy_b2, hy_w3, hy_freq, hy_skip, mla_cq_gain, mla_ckv_gain,
              mla_w_uq, mla_w_ukv, mla_q_gain, mla_k_gain, router_w, router_b,
              moe_w_gate, moe_w_up, moe_w_down):
    B, S, D = x.shape
    C = ctx.shape[1]
    rope_swa = axial_rope(S, HEAD_DIM)
    rope_mla = axial_rope(S, MLA_ROPE)
    silu_c = jax.nn.silu(c)
    silu_cc = jax.nn.silu(c_ctx)
    xl, xc = x, ctx
    for layer in range(DEPTH):
        need_ctx = layer < DEPTH - 1
        mod_l = (silu_c @ ada_w[layer] + ada_b[layer])[:, None, :]
        mod_c = silu_cc @ ada_w[layer] + ada_b[layer]
        sh1, sc1, g1, sh2, sc2, g2 = jnp.split(mod_l, 6, axis=-1)
        csh1, csc1, cg1, csh2, csc2, cg2 = jnp.split(mod_c, 6, axis=-1)
        hl = modulate(xl, norm_g[layer, 0], sh1, sc1)
        hc = modulate(xc, norm_g[layer, 0], csh1, csc1)
        if layer % 2 == 0:
            i = layer // 2
            ml, mc = even_mixer(hl, hc, ev_w_in[i], ev_w_out[i], pool_w[i], pool_scale[i],
                                swa_q_gain[i], swa_k_gain[i], swa_sink[i], rope_swa, need_ctx)
        else:
            i = layer // 2
            ml, mc = odd_mixer(hl, hc, od_w_in[i], od_w_out[i], hy_conv_w[i], hy_conv_b[i],
                               hy_w1[i], hy_b1[i], hy_w2[i], hy_b2[i], hy_w3[i], hy_freq[i], hy_skip[i],
                               mla_cq_gain[i], mla_ckv_gain[i], mla_w_uq[i], mla_w_ukv[i],
                               mla_q_gain[i], mla_k_gain[i], rope_mla, need_ctx)
        xl = xl + g1 * ml
        hl2 = modulate(xl, norm_g[layer, 1], sh2, sc2).reshape(B * S, D)
        if need_ctx:
            xc = xc + cg1 * mc
            hc2 = modulate(xc, norm_g[layer, 1], csh2, csc2).reshape(B * C, D)
            y = moe(jnp.concatenate([hl2, hc2], axis=0), router_w, router_b,
                    moe_w_gate[layer], moe_w_up[layer], moe_w_down[layer])
            xc = xc + cg2 * y[B * S:].reshape(B, C, D)
            yl = y[:B * S]
        else:
            yl = moe(hl2, router_w, router_b, moe_w_gate[layer], moe_w_up[layer], moe_w_down[layer])
        xl = xl + g2 * yl.reshape(B, S, D)
    return xl
```

```cpp
#include <hip/hip_runtime.h>
#include <cstdio>
#include <cstdint>

#ifndef MK_MULTI
#define MK_MULTI 1
#endif
#ifndef STOP_AFTER
#define STOP_AFTER 99
#endif

#define GAS __attribute__((address_space(1)))
#define LAS __attribute__((address_space(3)))
typedef unsigned short bf16;
typedef unsigned u32x4 __attribute__((ext_vector_type(4)));
typedef unsigned u32x2 __attribute__((ext_vector_type(2)));
typedef float f32x4 __attribute__((ext_vector_type(4)));
typedef float f32x2 __attribute__((ext_vector_type(2)));
typedef float f32x16 __attribute__((ext_vector_type(16)));
typedef short bf16x8 __attribute__((ext_vector_type(8)));
typedef short s16x4 __attribute__((ext_vector_type(4)));

constexpr int D = 1024, NB = 2, S = 16384, CL = 256, DEPTH = 4;
constexpr int TL = NB * S, TC = NB * CL, T = TL + TC;
constexpr int GRID_W = 64;
constexpr float EPS = 1e-6f;
constexpr int EV_N = 1536, OD_N = 2048  , OD_NR = 1952;
constexpr int NE = 16, FF = 512;
constexpr int HYW = 512;
constexpr int MLA_H = 8, MLA_QK = 96, MLA_V = 64, QU_N = 768, KVU_N = 1280  ;
constexpr int MOE_ROWS = 70656;
constexpr float LOG2E = 1.4426950408889634f;

constexpr size_t MiB = 1u << 20;
constexpr size_t WS_CTL = 0, CTL_ZERO_BYTES = 1 * MiB;
constexpr int CW_BAR = 4096;
constexpr int CW_CNT = 65536;
constexpr size_t WS_MISC = 1 * MiB;
constexpr size_t MISC_MOD = 0, MISC_TILEE = 512 * 1024, MISC_RSTD = 600 * 1024  ;
constexpr size_t WS_ROPE = 2 * MiB;
constexpr size_t WS_XC = 8 * MiB;
constexpr size_t WS_ROUTE = 10 * MiB;
constexpr size_t WS_WSM = 13 * MiB;
constexpr size_t W_EIN = 0, W_EOUT = W_EIN + 2 * (size_t)EV_N * D * 2, W_OIN = W_EOUT + 2 * (size_t)D * D * 2, W_OOUT = W_OIN + 2 * (size_t)OD_N * D * 2,
                 W_UQ = W_OOUT + 2 * (size_t)D * D * 2, W_UKV = W_UQ + 2 * (size_t)QU_N * 256 * 2, W_SM_END = W_UKV + 2 * (size_t)KVU_N * 256 * 2;
static_assert(W_SM_END <= 24 * MiB, "small weights");
constexpr size_t WS_WMOE = 37 * MiB;
constexpr size_t WS_H = 85 * MiB;
constexpr size_t WS_ARENA = 150 * MiB;
constexpr size_t A_P = WS_ARENA;
constexpr size_t A_MIX = A_P + 130 * MiB;
constexpr size_t A_KVU = A_MIX + 65 * MiB;
constexpr size_t A_ZY = A_KVU + 82 * MiB;
constexpr size_t A_QU = A_ZY + 32 * MiB;
constexpr size_t A_G = A_QU + 49 * MiB;
constexpr size_t WS_END = A_G + 128 * MiB;
constexpr size_t A_H2S = A_P;
constexpr size_t A_ACT = A_KVU;
constexpr size_t A_YS = A_ZY;
static_assert(A_H2S + (size_t)MOE_ROWS * 2048 <= A_KVU && A_ACT + (size_t)MOE_ROWS * 1024 <= A_ZY && A_YS + (size_t)MOE_ROWS * 2048 <= WS_END, "moe aliases");
static_assert((size_t)T * 2048 * 2 <= 130 * MiB && (size_t)T * 1280 * 2 <= 82 * MiB && (size_t)T * 768 * 2 <= 49 * MiB, "arena");

constexpr int NWAVES = 8, NTHR = 512;
constexpr int RING_BYTES = 139264 + 4096;
constexpr int LDSCTL_OFF = RING_BYTES, MISC_OFF = LDSCTL_OFF + 64;
constexpr int LDS_BYTES = 147456;
static_assert(MISC_OFF + 128 <= LDS_BYTES, "lds");

#define LDS_WAIT() asm volatile("s_waitcnt lgkmcnt(0)" ::: "memory")
#define VM_WAIT() asm volatile("s_waitcnt vmcnt(0)" ::: "memory")
__device__ __forceinline__ unsigned f2bf(float f) { unsigned u = __builtin_bit_cast(unsigned, f); return (u + 0x7fffu + ((u >> 16) & 1u)) >> 16; }
__device__ __forceinline__ unsigned pk2(float lo, float hi) { return f2bf(lo) | (f2bf(hi) << 16); }
__device__ __forceinline__ float bf2f(unsigned short h) { return __builtin_bit_cast(float, (unsigned)h << 16); }
__device__ __forceinline__ float bflo(unsigned w) { return __builtin_bit_cast(float, w << 16); }
__device__ __forceinline__ float bfhi(unsigned w) { return __builtin_bit_cast(float, w & 0xffff0000u); }
__device__ __forceinline__ float wave_sum(float v) {
#pragma unroll
    for (int o = 1; o < 64; o <<= 1) v += __shfl_xor(v, o);
    return v;
}

namespace pg8 {
#define PG8_LAS __attribute__((address_space(3)))
typedef unsigned short bf16_t;
constexpr int BM = 256, BK = 64, HALF = 128, HTB = HALF * BK * 2, STAGE_BYTES = 8 * HTB, NXCD = 8, WGM = 8;
__host__ __device__ __forceinline__ int lds_byte(int r, int c) { const int st = (r >> 4) * 2 + (c >> 5), rr = r & 15, cc = c & 31, ob = rr * 64 + cc * 2; return st * 1024 + (ob ^ (((ob >> 9) & 1) << 5)); }
__host__ __device__ __forceinline__ void stage_rc(int b, int& R, int& C) { const int st = b / 1024, sb = b % 1024, swz = sb ^ (((sb >> 9) & 1) << 5); R = (st >> 1) * 16 + swz / 64; C = (st & 1) * 32 + (swz % 64) / 2; }
__host__ __device__ __forceinline__ int perm32(int rho) { const int n = rho >> 4, i = rho & 15; return 8 * (i >> 2) + 4 * n + (i & 3); }

struct Unit { int pm, pn; };
struct Gemm { const bf16_t* A; const bf16_t* Bt; int lda, K; };

struct StaticOrder {
    int nM, nN, nwg, G, c;
    __host__ __device__ void init(int M, int N, int G_, int c_) { nM = M / BM; nN = N / BM; nwg = nM * nN; G = G_; c = c_; }
    __host__ __device__ bool next(int i, Unit& u) const {
        const long L = (long)i * G + c; if (L >= nwg) return false;
        int wgid = (int)L; { const int q = nwg / NXCD, r = nwg % NXCD, xcd = wgid % NXCD, off = wgid / NXCD; wgid = (xcd < r ? xcd * (q + 1) : r * (q + 1) + (xcd - r) * q) + off; }
        const int nig = WGM * nN, gid = wgid / nig, fm = gid * WGM, gsz = (nM - fm) < WGM ? (nM - fm) : WGM;
        u.pm = fm + ((wgid % nig) % gsz); u.pn = (wgid % nig) / gsz; return true;
    }
    __device__ __forceinline__ size_t b_off(const Unit& u, int K) const { return (size_t)u.pn * BM * K * 2; }
};
struct MoeOrder {
    const int* tile_e; int ntiles, nN, G, c;
    __device__ bool next(int i, Unit& u) const { const long L = (long)i * G + c; if (L >= (long)ntiles * nN) return false; u.pm = (int)(L / nN); u.pn = (int)(L % nN); return true; }
    __device__ __forceinline__ size_t b_off(const Unit& u, int K) const { const int e = __builtin_amdgcn_readfirstlane(tile_e[u.pm]); return ((size_t)e * nN + u.pn) * BM * K * 2; }
};

__device__ __forceinline__ unsigned cvt_pk_bf16(float lo, float hi) { unsigned r; asm volatile("v_cvt_pk_bf16_f32 %0, %1, %2" : "=v"(r) : "v"(lo), "v"(hi)); return r; }

struct EpiStoreBf16 {
    static constexpr bool PERM = true;
    bf16_t* O; int ldc; const float* rowscale;
    __device__ __forceinline__ void operator()(const f32x4 (&acc)[2][2][4][2], const Unit& u, int wr, int wc, int fr, int fq) const {
        const int row0 = u.pm * BM + wr * 64 + fr, col0 = u.pn * BM + wc * 32 + 8 * fq;
#pragma unroll
        for (int ai = 0; ai < 2; ++ai)
#pragma unroll
            for (int m = 0; m < 4; ++m) { const int row = row0 + ai * HALF + m * 16; bf16_t* rowp = O + (size_t)row * ldc + col0; const float sc = rowscale ? rowscale[row] : 1.f;
#pragma unroll
                for (int bj = 0; bj < 2; ++bj) { f32x4 v0 = acc[ai][bj][m][0] * sc, v1 = acc[ai][bj][m][1] * sc;
                    u32x4 w; w.x = cvt_pk_bf16(v0[0], v0[1]); w.y = cvt_pk_bf16(v0[2], v0[3]); w.z = cvt_pk_bf16(v1[0], v1[1]); w.w = cvt_pk_bf16(v1[2], v1[3]);
                    *(u32x4*)(rowp + bj * HALF) = w; } }
    }
};
struct EpiSwiglu {
    static constexpr bool PERM = true;
    bf16_t* O;
    __device__ __forceinline__ void operator()(const f32x4 (&acc)[2][2][4][2], const Unit& u, int wr, int wc, int fr, int fq) const {
        const int row0 = u.pm * BM + wr * 64 + fr, col0 = u.pn * HALF + wc * 32 + 8 * fq;
#pragma unroll
        for (int ai = 0; ai < 2; ++ai)
#pragma unroll
            for (int m = 0; m < 4; ++m) { bf16_t* rowp = O + (size_t)(row0 + ai * HALF + m * 16) * FF + col0; float o[8];
#pragma unroll
                for (int n = 0; n < 2; ++n)
#pragma unroll
                    for (int j = 0; j < 4; ++j) { const float g = acc[ai][0][m][n][j], up = acc[ai][1][m][n][j]; o[4 * n + j] = g * __builtin_amdgcn_rcpf(1.f + __expf(-g)) * up; }
                u32x4 w; w.x = cvt_pk_bf16(o[0], o[1]); w.y = cvt_pk_bf16(o[2], o[3]); w.z = cvt_pk_bf16(o[4], o[5]); w.w = cvt_pk_bf16(o[6], o[7]);
                *(u32x4*)rowp = w; }
    }
};
struct EpiResidual {
    static constexpr bool PERM = false;
    const float* srcL; float* dstL; const float* srcC; float* dstC; const float* gate; float on;
    __device__ __forceinline__ void operator()(const f32x4 (&acc)[2][2][4][2], const Unit& u, int wr, int wc, int fr, int fq) const {
        const int row0 = u.pm * BM + wr * 64 + fr, col0 = u.pn * BM + wc * 32 + 4 * fq;
        const bool lat = (u.pm * BM) < TL; const int mrow = lat ? (u.pm * BM) / S : 2;
        const float* gp = gate + (size_t)mrow * 6 * D + col0;
        f32x4 gv[2][2];
#pragma unroll
        for (int bj = 0; bj < 2; ++bj)
#pragma unroll
            for (int n = 0; n < 2; ++n) gv[bj][n] = *(const f32x4*)(gp + bj * HALF + n * 16) * on;
        const float* sb = lat ? srcL : srcC - (size_t)TL * D; float* db = lat ? dstL : dstC - (size_t)TL * D;
#pragma unroll
        for (int ai = 0; ai < 2; ++ai)
#pragma unroll
            for (int m = 0; m < 4; ++m) { const size_t ro = (size_t)(row0 + ai * HALF + m * 16) * D + col0;
#pragma unroll
                for (int bj = 0; bj < 2; ++bj)
#pragma unroll
                    for (int n = 0; n < 2; ++n) { const f32x4 xv = *(const f32x4*)(sb + ro + bj * HALF + n * 16); *(f32x4*)(db + ro + bj * HALF + n * 16) = xv + gv[bj][n] * acc[ai][bj][m][n]; } }
    }
};

template <class Epi, class Sched, bool ALIGN_EPI = true>
__device__ __forceinline__ void gemm_phase(PG8_LAS unsigned char* lds, const Gemm g, const Sched& S_, const Epi& E, const int tid) {
    const int wid = __builtin_amdgcn_readfirstlane(tid >> 6), lane = tid & 63, wr = wid >> 2, wc = wid & 3, fr = lane & 15, fq = lane >> 4;
    const int K = g.K, lda = g.lda, nt = K / BK;
    unsigned voffA[2], voffB[2];
#pragma unroll
    for (int i = 0; i < 2; ++i) { int R, C; stage_rc(tid * 16 + i * 8192, R, C); const int Rb = Epi::PERM ? ((R & ~31) + perm32(R & 31)) : R;
        voffA[i] = (unsigned)(R * lda + C) * 2u; voffB[i] = (unsigned)(Rb * K + C) * 2u; }
    const size_t kstep = (size_t)(BK * 2);
    const size_t hsA = (size_t)HALF * lda * 2, hsB = (size_t)HALF * K * 2;
    const size_t tstepA = 2 * hsA;
    const unsigned ldsw = (unsigned)wid * 1024u;
    const int aoff = lds_byte(wr * 64 + fr, fq * 8), boff = lds_byte(wc * 32 + fr, fq * 8);
#define PG8_SA(b, h) (((b) * 2 + (h)) * HTB)
#define PG8_SB(b, h) ((4 + (b) * 2 + (h)) * HTB)
#define PG8_STAGE(bufoff, gbase, voff) do { _Pragma("unroll") for (int _i = 0; _i < 2; ++_i) \
        __builtin_amdgcn_global_load_lds((const unsigned*)((const char*)(gbase) + (voff)[_i]), (PG8_LAS unsigned*)(lds + (bufoff) + ldsw + _i * 8192), 16, 0, 0); } while (0)
#define PG8_LDA(dst, b, h) do { _Pragma("unroll") for (int m = 0; m < 4; ++m) _Pragma("unroll") for (int k = 0; k < 2; ++k) dst[m][k] = *(const PG8_LAS bf16x8*)(lds + PG8_SA(b, h) + aoff + m * 2048 + k * 1024); } while (0)
#define PG8_LDB(dst, b, h) do { _Pragma("unroll") for (int n = 0; n < 2; ++n) _Pragma("unroll") for (int k = 0; k < 2; ++k) dst[n][k] = *(const PG8_LAS bf16x8*)(lds + PG8_SB(b, h) + boff + n * 2048 + k * 1024); } while (0)
#define PG8_MMA(ai, bj, At, Bt) do { __builtin_amdgcn_s_setprio(1); _Pragma("unroll") for (int m = 0; m < 4; ++m) _Pragma("unroll") for (int n = 0; n < 2; ++n) _Pragma("unroll") for (int k = 0; k < 2; ++k) \
        acc[ai][bj][m][n] = __builtin_amdgcn_mfma_f32_16x16x32_bf16(Bt[n][k], At[m][k], acc[ai][bj][m][n], 0, 0, 0); __builtin_amdgcn_s_setprio(0); } while (0)
#define PG8_WAIT_V(n) asm volatile("s_waitcnt vmcnt(" #n ")" ::: "memory")
#define PG8_WAIT_L(n) asm volatile("s_waitcnt lgkmcnt(" #n ")" ::: "memory")
#define PG8_BAR __builtin_amdgcn_s_barrier()
#define PG8_SCHED __builtin_amdgcn_sched_barrier(0)
    Unit cur, nxt; int ui = 0;
    if (!S_.next(0, cur)) return;
    f32x4 acc[2][2][4][2];
#pragma unroll
    for (int a = 0; a < 2; ++a)
#pragma unroll
        for (int b = 0; b < 2; ++b)
#pragma unroll
            for (int m = 0; m < 4; ++m)
#pragma unroll
                for (int n = 0; n < 2; ++n) acc[a][b][m][n] = (f32x4){0.f, 0.f, 0.f, 0.f};
    bf16x8 At[4][2], B0[2][2], B1[2][2];
    const char* cA = (const char*)g.A + (size_t)cur.pm * tstepA; const char* cB = (const char*)g.Bt + S_.b_off(cur, K);
    PG8_STAGE(PG8_SB(0, 0), cB, voffB); PG8_STAGE(PG8_SB(0, 1), cB + hsB, voffB); PG8_STAGE(PG8_SA(0, 0), cA, voffA); PG8_STAGE(PG8_SA(0, 1), cA + hsA, voffA);
    if (wr == 1) PG8_BAR;
    PG8_WAIT_V(2); PG8_BAR;
    PG8_STAGE(PG8_SB(1, 0), cB + kstep, voffB); PG8_STAGE(PG8_SA(1, 0), cA + kstep, voffA); PG8_STAGE(PG8_SB(1, 1), cB + hsB + kstep, voffB);
    PG8_WAIT_V(6); PG8_BAR;
    for (;;) {
        const bool has_next = S_.next(ui + 1, nxt);
        const char* nA = has_next ? (const char*)g.A + (size_t)nxt.pm * tstepA : cA; const char* nB = has_next ? (const char*)g.Bt + S_.b_off(nxt, K) : cB;
        for (int t = 0; t < nt; t += 2) {
            const bool last = (t == nt - 2);
            const char* a1 = cA + (size_t)(t + 1) * kstep;
            const char* a2 = last ? nA : cA + (size_t)(t + 2) * kstep; const char* b2 = last ? nB : cB + (size_t)(t + 2) * kstep;
            const char* a3 = a2 + kstep; const char* b3 = b2 + kstep;
            PG8_LDB(B0, 0, 0); PG8_LDB(B1, 0, 1); PG8_SCHED; PG8_LDA(At, 0, 0); PG8_STAGE(PG8_SA(1, 1), a1 + hsA, voffA);
            PG8_WAIT_V(8); PG8_WAIT_L(0); PG8_BAR; PG8_MMA(0, 0, At, B0); PG8_MMA(0, 1, At, B1); PG8_BAR; PG8_SCHED;
            PG8_LDA(At, 0, 1); PG8_STAGE(PG8_SB(0, 0), b2, voffB); PG8_STAGE(PG8_SB(0, 1), b2 + hsB, voffB); PG8_STAGE(PG8_SA(0, 0), a2, voffA);
            PG8_WAIT_V(8); PG8_WAIT_L(0); PG8_BAR; PG8_MMA(1, 0, At, B0); PG8_MMA(1, 1, At, B1); PG8_BAR; PG8_SCHED;
            PG8_LDB(B0, 1, 0); PG8_LDB(B1, 1, 1); PG8_SCHED; PG8_LDA(At, 1, 0); PG8_STAGE(PG8_SA(0, 1), a2 + hsA, voffA);
            PG8_WAIT_V(8); PG8_WAIT_L(0); PG8_BAR; PG8_MMA(0, 0, At, B0); PG8_MMA(0, 1, At, B1); PG8_BAR; PG8_SCHED;
            PG8_LDA(At, 1, 1); PG8_STAGE(PG8_SB(1, 0), b3, voffB); PG8_STAGE(PG8_SB(1, 1), b3 + hsB, voffB); PG8_STAGE(PG8_SA(1, 0), a3, voffA);
            PG8_WAIT_V(8); PG8_WAIT_L(0); PG8_BAR; PG8_MMA(1, 0, At, B0); PG8_MMA(1, 1, At, B1); PG8_BAR; PG8_SCHED;
        }
        if constexpr (ALIGN_EPI) { if (wr == 0) PG8_BAR; }
        E(acc, cur, wr, wc, fr, fq);
        if (!has_next) break;
#pragma unroll
        for (int a = 0; a < 2; ++a)
#pragma unroll
            for (int b = 0; b < 2; ++b)
#pragma unroll
                for (int m = 0; m < 4; ++m)
#pragma unroll
                    for (int n = 0; n < 2; ++n) acc[a][b][m][n] = (f32x4){0.f, 0.f, 0.f, 0.f};
        cur = nxt; cA = nA; cB = nB; ++ui;
        if constexpr (ALIGN_EPI) { if (wr == 1) PG8_BAR; }
    }
    PG8_WAIT_V(0);
    if constexpr (!ALIGN_EPI) { if (wr == 0) PG8_BAR; }
    PG8_BAR;
#undef PG8_SA
#undef PG8_SB
#undef PG8_STAGE
#undef PG8_LDA
#undef PG8_LDB
#undef PG8_MMA
#undef PG8_WAIT_V
#undef PG8_WAIT_L
#undef PG8_BAR
#undef PG8_SCHED
}
}

#define XB_TMO      128
#define XB_XCNT(j)  (256  + 64 * (j))
#define XB_XSUB(j)  (1280 + 64 * (j))
#define XB_XGEN(j)  (2304 + 64 * (j))
#define XB_TOP      3328
#define XB_TOPGEN   3392
#define XCD_BAR_WORDS 3456
#define XB_SPIN_CAP (1u << 20)
__device__ __forceinline__ unsigned xb_ld(unsigned* p)              { return __hip_atomic_load(p, __ATOMIC_RELAXED, __HIP_MEMORY_SCOPE_AGENT); }
__device__ __forceinline__ unsigned xb_add(unsigned* p, unsigned v) { return __hip_atomic_fetch_add(p, v, __ATOMIC_RELAXED, __HIP_MEMORY_SCOPE_AGENT); }
__device__ __forceinline__ unsigned xb_xcc_id() { return (unsigned)__builtin_amdgcn_s_getreg((3 << 11) | 20) & 0xFu; }
#define XB_SPIN(cond, bar) do { unsigned _sp = 0; while (cond) { __builtin_amdgcn_s_sleep(1); \
    if ((++_sp & 255u) == 0u) { if (xb_ld(&(bar)[XB_TMO])) break; if (_sp > XB_SPIN_CAP) { atomicAdd(&(bar)[XB_TMO], 1u); break; } } } } while (0)
struct XcdBarrier { unsigned* bar; unsigned x; volatile LAS unsigned* st; };
__device__ __forceinline__ XcdBarrier xcd_barrier_post(unsigned* bar, volatile LAS unsigned* st) {
    XcdBarrier b; b.bar = bar; b.x = xb_xcc_id(); b.st = st;
    if (threadIdx.x == 0) (void)xb_add(&bar[XB_XCNT(b.x)], 1u);
    return b;
}
__device__ __forceinline__ void xcd_barrier_complete(unsigned* bar, unsigned x, unsigned& nloc, unsigned& nx) {
    const unsigned G = gridDim.x * gridDim.y * gridDim.z;
    unsigned sum, cnt, mine, sp = 0u;
    for (;;) {
        sum = 0u; cnt = 0u; mine = 0u;
#pragma unroll
        for (unsigned j = 0; j < 16; ++j) { const unsigned c = xb_ld(&bar[XB_XCNT(j)]); sum += c; cnt += (c > 0u) ? 1u : 0u; mine = (j == x) ? c : mine; }
        if (sum == G) break;
        __builtin_amdgcn_s_sleep(1);
        if ((++sp & 255u) == 0u) { if (xb_ld(&bar[XB_TMO])) break; if (sp > XB_SPIN_CAP) { atomicAdd(&bar[XB_TMO], 1u); break; } }
    }
    nloc = mine > 0u ? mine : 1u; nx = cnt > 0u ? cnt : 1u;
}
__device__ __forceinline__ void xcd_barrier(const XcdBarrier& b) {
    asm volatile("s_waitcnt vmcnt(0)" ::: "memory");
    __syncthreads();
    if (threadIdx.x == 0) {
        unsigned* bar = b.bar;
        __builtin_amdgcn_s_waitcnt(0);
        unsigned nloc = b.st[0], nx = b.st[1];
        if (nloc == 0u) { xcd_barrier_complete(bar, b.x, nloc, nx); b.st[0] = nloc; b.st[1] = nx; }
        const unsigned old = xb_add(&bar[XB_XSUB(b.x)], 1u);
        const unsigned gen = old / nloc;
        if (old + 1u == (gen + 1u) * nloc) {
            __builtin_amdgcn_fence(__ATOMIC_RELEASE, "agent");
            asm volatile("s_waitcnt vmcnt(0)" ::: "memory");
            const unsigned og = xb_add(&bar[XB_TOP], 1u);
            const unsigned tg = og / nx;
            if (og + 1u == (tg + 1u) * nx) xb_add(&bar[XB_TOPGEN], 1u);
            else XB_SPIN(xb_ld(&bar[XB_TOPGEN]) == tg, bar);
            __builtin_amdgcn_fence(__ATOMIC_ACQUIRE, "agent");
            xb_add(&bar[XB_XGEN(b.x)], 1u);
            asm volatile("s_waitcnt vmcnt(0)" ::: "memory");
        } else {
            XB_SPIN(xb_ld(&bar[XB_XGEN(b.x)]) == gen, bar);
            __builtin_amdgcn_fence(__ATOMIC_ACQUIRE, "agent");
            asm volatile("s_waitcnt vmcnt(0)" ::: "memory");
        }
    }
    __syncthreads();
}

struct Args { const float* in[36]; float* out; unsigned char* ws; int ph_lo, ph_hi; };
struct Frame {
    LAS unsigned char* lds;
    const LAS unsigned long long* in; float* out; unsigned char* ws;
    int tid, lane, wave, vcu, G, gw, NGW, bx;
};
enum { I_X = 0, I_C, I_CTX, I_CCTX, I_ADAW, I_ADAB, I_NORMG, I_EVWIN, I_EVWOUT, I_POOLW, I_POOLS, I_SWAQG, I_SWAKG, I_SINK, I_ODWIN, I_ODWOUT, I_HYCW, I_HYCB,
       I_HYW1, I_HYB1, I_HYW2, I_HYB2, I_HYW3, I_HYFREQ, I_HYSKIP, I_CQG, I_CKVG, I_WUQ, I_WUKV, I_MQG, I_MKG, I_RW, I_RB, I_MG, I_MU, I_MD };

__device__ __forceinline__ const float* inp(const Frame& F, int i) { const unsigned long long v = F.in[i];
    const unsigned lo = __builtin_amdgcn_readfirstlane((unsigned)v), hi = __builtin_amdgcn_readfirstlane((unsigned)(v >> 32)); return (const float*)(((unsigned long long)hi << 32) | lo); }
__device__ __forceinline__ float* mod_ptr(const Frame& F, int l, int m) { return (float*)(F.ws + WS_MISC + MISC_MOD) + ((size_t)l * 3 + m) * 6 * D; }
__device__ __forceinline__ int* tile_e_ptr(const Frame& F, int l) { return (int*)(F.ws + WS_MISC + MISC_TILEE) + l * 288; }
__device__ __forceinline__ unsigned* cnt_ptr(const Frame& F, int l) { return (unsigned*)(F.ws + WS_CTL) + CW_CNT + 64 * l; }
__device__ __forceinline__ const float* xsrc_row(const Frame& F, int l, int r) {
    if (r < TL) return (l == 0 ? inp(F, I_X) : F.out) + (size_t)r * D;
    return (l == 0 ? inp(F, I_CTX) : (const float*)(F.ws + WS_XC)) + (size_t)(r - TL) * D;
}
__device__ __forceinline__ float* xdst_row(const Frame& F, int r) { return r < TL ? F.out + (size_t)r * D : (float*)(F.ws + WS_XC) + (size_t)(r - TL) * D; }

template <class RowMap>
__device__ __forceinline__ void tr_item(const float* W, int N, bf16* WT, int Kd, int k0, int n0, LAS float* scr, int lane, RowMap rm) {
#pragma unroll 8
    for (int i = 0; i < 32; ++i) { const int kk = 2 * i + (lane >> 5); scr[kk * 33 + (lane & 31)] = W[(size_t)(k0 + kk) * N + n0 + (lane & 31)]; }
    LDS_WAIT(); asm volatile("" ::: "memory");
    const int c = lane & 7;
#pragma unroll
    for (int j = 0; j < 4; ++j) { const int n = (lane >> 3) + 8 * j; const LAS float* s = scr + (8 * c) * 33 + n;
        u32x4 o; o.x = pk2(s[0 * 33], s[1 * 33]); o.y = pk2(s[2 * 33], s[3 * 33]); o.z = pk2(s[4 * 33], s[5 * 33]); o.w = pk2(s[6 * 33], s[7 * 33]);
        *(u32x4*)(WT + (size_t)rm(n0 + n) * Kd + k0 + 8 * c) = o; }
    LDS_WAIT(); asm volatile("" ::: "memory");
}
struct RmId { __device__ __forceinline__ int operator()(int n) const { return n; } };
struct RmGate { int add; __device__ __forceinline__ int operator()(int n) const { return 256 * (n >> 7) + add + (n & 127); } };

__device__ __forceinline__ float silu_f(float v) { return v / (1.f + __expf(-v)); }

__device__ __forceinline__ void phase_prologue(Frame& F) {
    LAS float* scr = (LAS float*)(F.lds + F.wave * 16384);
    bf16* wsm = (bf16*)(F.ws + WS_WSM);
    {
        constexpr int I_EI = 16 * 48, I_EO = 16 * 32, I_OI = 16 * 61, I_OO = 16 * 32, PER = I_EI + I_EO + I_OI + I_OO;
        for (int it = F.gw; it < 2 * PER; it += F.NGW) {
            const int i = it / PER; int r = it % PER;
            if (r < I_EI) { tr_item(inp(F, I_EVWIN) + (size_t)i * D * EV_N, EV_N, (bf16*)((char*)wsm + W_EIN) + (size_t)i * EV_N * D, D, 64 * (r / 48), 32 * (r % 48), scr, F.lane, RmId{}); continue; } r -= I_EI;
            if (r < I_EO) { tr_item(inp(F, I_EVWOUT) + (size_t)i * D * D, D, (bf16*)((char*)wsm + W_EOUT) + (size_t)i * D * D, D, 64 * (r / 32), 32 * (r % 32), scr, F.lane, RmId{}); continue; } r -= I_EO;
            if (r < I_OI) { tr_item(inp(F, I_ODWIN) + (size_t)i * D * OD_NR, OD_NR, (bf16*)((char*)wsm + W_OIN) + (size_t)i * OD_N * D, D, 64 * (r / 61), 32 * (r % 61), scr, F.lane, RmId{}); continue; } r -= I_OI;
            tr_item(inp(F, I_ODWOUT) + (size_t)i * D * D, D, (bf16*)((char*)wsm + W_OOUT) + (size_t)i * D * D, D, 64 * (r / 32), 32 * (r % 32), scr, F.lane, RmId{});
        }
    }
    const int gt = F.gw * 64 + F.lane, NGT = F.NGW * 64;
    for (int idx = gt; idx < 2 * 96 * (D / 8); idx += NGT) { const int i = idx / (96 * (D / 8)), r = idx % (96 * (D / 8));
        *(u32x4*)((bf16*)((char*)wsm + W_OIN) + (size_t)i * OD_N * D + (size_t)(OD_NR + r / (D / 8)) * D + 8 * (r % (D / 8))) = (u32x4){0u, 0u, 0u, 0u}; }
    for (int idx = gt; idx < 2 * QU_N * 32; idx += NGT) { const int i = idx / (QU_N * 32), r = idx % (QU_N * 32), n = r / 32, kc = r % 32;
        const float* W = inp(F, I_WUQ) + (size_t)i * 256 * QU_N; const float* gn = inp(F, I_CQG) + i * 256; float v[8];
#pragma unroll
        for (int j = 0; j < 8; ++j) v[j] = W[(size_t)(8 * kc + j) * QU_N + n] * gn[8 * kc + j];
        *(u32x4*)((bf16*)((char*)wsm + W_UQ) + (size_t)i * QU_N * 256 + (size_t)n * 256 + 8 * kc) = (u32x4){pk2(v[0], v[1]), pk2(v[2], v[3]), pk2(v[4], v[5]), pk2(v[6], v[7])}; }
    for (int idx = gt; idx < 2 * KVU_N * 32; idx += NGT) { const int i = idx / (KVU_N * 32), r = idx % (KVU_N * 32), n = r / 32, kc = r % 32, h = n / 160, j = n % 160;
        const float* W = inp(F, I_WUKV) + (size_t)i * 128 * 1024; const float* gn = inp(F, I_CKVG) + i * 128; float v[8];
        const bool z = (kc >= 16) || (j >= 64 && j < 96); const int col = h * 128 + (j < 64 ? j : j - 32);
#pragma unroll
        for (int jj = 0; jj < 8; ++jj) v[jj] = z ? 0.f : W[(size_t)(8 * kc + jj) * 1024 + col] * gn[8 * kc + jj];
        *(u32x4*)((bf16*)((char*)wsm + W_UKV) + (size_t)i * KVU_N * 256 + (size_t)n * 256 + 8 * kc) = (u32x4){pk2(v[0], v[1]), pk2(v[2], v[3]), pk2(v[4], v[5]), pk2(v[6], v[7])}; }
    { f32x2* r64 = (f32x2*)(F.ws + WS_ROPE); f32x2* r32 = r64 + (size_t)S * 32;
      for (int idx = gt; idx < S * 32; idx += NGT) { const int s = idx >> 5, i = idx & 31; const float pos = (float)(i < 16 ? s / GRID_W : s % GRID_W);
          const float inv = powf(10000.f, -(float)(i & 15) / 16.f); float sn, cs; sincosf(pos * inv, &sn, &cs); r64[idx] = (f32x2){cs, sn}; }
      for (int idx = gt; idx < S * 16; idx += NGT) { const int s = idx >> 4, i = idx & 15; const float pos = (float)(i < 8 ? s / GRID_W : s % GRID_W);
          const float inv = powf(10000.f, -(float)(i & 7) / 8.f); float sn, cs; sincosf(pos * inv, &sn, &cs); r32[idx] = (f32x2){cs, sn}; } }
    if (F.bx < 96) {
        __syncthreads();
        LAS float* sl = (LAS float*)(F.lds);
        LAS float* red = (LAS float*)(F.lds + 16384);
        for (int i = F.tid; i < 3 * D; i += NTHR) { const int m = i / D, k = i % D; sl[i] = silu_f(m < 2 ? inp(F, I_C)[m * D + k] : inp(F, I_CCTX)[k]); }
        __syncthreads();
        const int l = F.bx / 24, j0 = (F.bx % 24) * 256 + 4 * F.lane;
        const float* W = inp(F, I_ADAW) + (size_t)l * D * 6 * D + j0;
        f32x4 a0 = {0.f, 0.f, 0.f, 0.f}, a1 = a0, a2 = a0;
#pragma unroll 8
        for (int k = F.wave * 128; k < F.wave * 128 + 128; ++k) { const f32x4 w = *(const f32x4*)(W + (size_t)k * 6 * D); a0 += w * sl[k]; a1 += w * sl[D + k]; a2 += w * sl[2 * D + k]; }
        *(LAS f32x4*)(red + (F.wave * 3 + 0) * 256 + 4 * F.lane) = a0; *(LAS f32x4*)(red + (F.wave * 3 + 1) * 256 + 4 * F.lane) = a1; *(LAS f32x4*)(red + (F.wave * 3 + 2) * 256 + 4 * F.lane) = a2;
        __syncthreads();
        for (int i = F.tid; i < 3 * 256; i += NTHR) { const int m = i / 256, jj = i % 256; float s = inp(F, I_ADAB)[l * 6 * D + (F.bx % 24) * 256 + jj];
#pragma unroll
            for (int w = 0; w < 8; ++w) s += red[(w * 3 + m) * 256 + jj];
            mod_ptr(F, l, m)[(F.bx % 24) * 256 + jj] = s; }
        __syncthreads();
    }
}

__device__ __forceinline__ void moe_weight_convert(Frame& F, int l) {
    LAS float* scr = (LAS float*)(F.lds + F.wave * 16384);
    bf16* wgu = (bf16*)(F.ws + WS_WMOE); bf16* wd = wgu + (size_t)NE * 1024 * 1024;
    for (int it = F.gw; it < NE * 3 * 256; it += F.NGW) {
        const int e = it / 768, r = it % 768, which = r / 256, q = r % 256;
        if (which == 0)      tr_item(inp(F, I_MG) + ((size_t)l * NE + e) * D * FF, FF, wgu + (size_t)e * 1024 * 1024, D, 64 * (q / 16), 32 * (q % 16), scr, F.lane, RmGate{0});
        else if (which == 1) tr_item(inp(F, I_MU) + ((size_t)l * NE + e) * D * FF, FF, wgu + (size_t)e * 1024 * 1024, D, 64 * (q / 16), 32 * (q % 16), scr, F.lane, RmGate{128});
        else                 tr_item(inp(F, I_MD) + ((size_t)l * NE + e) * FF * D, D, wd + (size_t)e * 1024 * FF, FF, 64 * (q / 32), 32 * (q % 32), scr, F.lane, RmId{});
    }
}

__device__ __forceinline__ void moe_combine_row(const Frame& F, int lp, int r, f32x4 (&v)[4]) {
    const int2 pos = ((const int2*)(F.ws + WS_ROUTE + 1 * MiB))[r]; const f32x2 w = ((const f32x2*)(F.ws + WS_ROUTE + 600 * 1024))[r];
    const bf16* ys = (const bf16*)(F.ws + A_YS); const float* g2 = mod_ptr(F, lp, r < TL ? r / S : 2) + 5 * D;
#pragma unroll
    for (int j = 0; j < 4; ++j) { const int c = 4 * F.lane + 256 * j;
        const u32x2 y0 = *(const u32x2*)(ys + (size_t)pos.x * D + c), y1 = *(const u32x2*)(ys + (size_t)pos.y * D + c); const f32x4 g = *(const f32x4*)(g2 + c);
        v[j].x += g.x * (w.x * bflo(y0.x) + w.y * bflo(y1.x)); v[j].y += g.y * (w.x * bfhi(y0.x) + w.y * bfhi(y1.x));
        v[j].z += g.z * (w.x * bflo(y0.y) + w.y * bflo(y1.y)); v[j].w += g.w * (w.x * bfhi(y0.y) + w.y * bfhi(y1.y)); }
}
__device__ __forceinline__ float row_rstd(const f32x4 (&v)[4]) {
    float s = 0.f;
#pragma unroll
    for (int j = 0; j < 4; ++j) s += (v[j].x * v[j].x + v[j].y * v[j].y) + (v[j].z * v[j].z + v[j].w * v[j].w);
    return 1.f / sqrtf(wave_sum(s) * (1.f / D) + EPS);
}
__device__ __forceinline__ void modulate_row(const Frame& F, int l, int which, int r, const f32x4 (&v)[4], float rstd, f32x4 (&h)[4]) {
    const float* gn = inp(F, I_NORMG) + ((size_t)l * 2 + which) * D; const float* mp = mod_ptr(F, l, r < TL ? r / S : 2) + (which ? 3 : 0) * D;
#pragma unroll
    for (int j = 0; j < 4; ++j) { const int c = 4 * F.lane + 256 * j; const f32x4 g = *(const f32x4*)(gn + c), sh = *(const f32x4*)(mp + c), sc = *(const f32x4*)(mp + D + c);
        h[j] = v[j] * rstd * g * (sc + 1.f) + sh; }
}
__device__ __forceinline__ void store_row_bf16(bf16* dst, int lane, const f32x4 (&h)[4]) {
#pragma unroll
    for (int j = 0; j < 4; ++j) *(u32x2*)(dst + 4 * lane + 256 * j) = (u32x2){pk2(h[j].x, h[j].y), pk2(h[j].z, h[j].w)};
}
__device__ __forceinline__ void phase_norm1(Frame& F, int l) {
    bf16* H = (bf16*)(F.ws + WS_H);
    for (int r = F.gw; r < T; r += F.NGW) {
        const float* xs = xsrc_row(F, l, r); f32x4 v[4];
#pragma unroll
        for (int j = 0; j < 4; ++j) v[j] = *(const f32x4*)(xs + 4 * F.lane + 256 * j);
        if (l > 0) { if (STOP_AFTER >= 2 * l) moe_combine_row(F, l - 1, r, v); float* xd = xdst_row(F, r);
#pragma unroll
            for (int j = 0; j < 4; ++j) *(f32x4*)(xd + 4 * F.lane + 256 * j) = v[j]; }
        const float rstd = row_rstd(v); f32x4 h[4]; modulate_row(F, l, 0, r, v, rstd, h);
        store_row_bf16(H + (size_t)r * D, F.lane, h);
    }
}
__device__ __forceinline__ void phase_final(Frame& F) {
    for (int r = F.gw; r < TL; r += F.NGW) {
        float* xd = F.out + (size_t)r * D; f32x4 v[4];
#pragma unroll
        for (int j = 0; j < 4; ++j) v[j] = *(const f32x4*)(xd + 4 * F.lane + 256 * j);
        if (STOP_AFTER >= 8) moe_combine_row(F, 3, r, v);
#pragma unroll
        for (int j = 0; j < 4; ++j) *(f32x4*)(xd + 4 * F.lane + 256 * j) = v[j];
    }
}

__device__ __forceinline__ void phase_norm2_route(Frame& F, int l) {
    bf16* H = (bf16*)(F.ws + WS_H);
    LAS float* rw = (LAS float*)F.lds;
    for (int i = F.tid; i < D * NE; i += NTHR) { const int k = i / NE, e = i % NE; rw[e * D + k] = inp(F, I_RW)[i]; }
    __syncthreads();
    const int Tm = (l < DEPTH - 1) ? T : TL;
    unsigned* cnt = cnt_ptr(F, l);
    int4* route_i = (int4*)(F.ws + WS_ROUTE); f32x2* route_w = (f32x2*)(F.ws + WS_ROUTE + 600 * 1024);
    for (int r = F.gw; r < Tm; r += F.NGW) {
        const float* xs = xdst_row(F, r); f32x4 v[4];
#pragma unroll
        for (int j = 0; j < 4; ++j) v[j] = *(const f32x4*)(xs + 4 * F.lane + 256 * j);
        const float rstd = row_rstd(v); f32x4 h[4]; modulate_row(F, l, 1, r, v, rstd, h);
        store_row_bf16(H + (size_t)r * D, F.lane, h);
        float lg[NE];
#pragma unroll
        for (int e = 0; e < NE; ++e) { float s = 0.f; asm volatile("" ::: "memory");
#pragma unroll
            for (int j = 0; j < 4; ++j) { const f32x4 w = *(const LAS f32x4*)(rw + e * D + 4 * F.lane + 256 * j); s += (h[j].x * w.x + h[j].y * w.y) + (h[j].z * w.z + h[j].w * w.w); }
            lg[e] = wave_sum(s); }
        float sc[NE], bi[NE];
#pragma unroll
        for (int e = 0; e < NE; ++e) { sc[e] = 1.f / (1.f + expf(-lg[e])); bi[e] = sc[e] + inp(F, I_RB)[e]; }
        int sel = 0; float best = -INFINITY;
#pragma unroll
        for (int g = 0; g < 4; ++g) { float m1 = -INFINITY, m2 = -INFINITY;
#pragma unroll
            for (int i = 0; i < 4; ++i) { const float b = bi[4 * g + i]; if (b > m1) { m2 = m1; m1 = b; } else if (b > m2) m2 = b; }
            const float gs = m1 + m2; if (gs > best) { best = gs; sel = g; } }
        float b4[4], s4[4];
#pragma unroll
        for (int i = 0; i < 4; ++i) { b4[i] = bi[0 + i]; s4[i] = sc[0 + i]; }
#pragma unroll
        for (int g = 1; g < 4; ++g) if (sel == g) {
#pragma unroll
            for (int i = 0; i < 4; ++i) { b4[i] = bi[4 * g + i]; s4[i] = sc[4 * g + i]; } }
        int i0 = 0; float v0 = b4[0], w0 = s4[0];
#pragma unroll
        for (int i = 1; i < 4; ++i) if (b4[i] > v0) { v0 = b4[i]; w0 = s4[i]; i0 = i; }
        int i1 = 0; float v1 = -INFINITY, w1 = 0.f;
#pragma unroll
        for (int i = 0; i < 4; ++i) if (i != i0 && b4[i] > v1) { v1 = b4[i]; w1 = s4[i]; i1 = i; }
        const float ws_ = 1.f / (w0 + w1);
        if (F.lane == 0) { const int e0 = 4 * sel + i0, e1 = 4 * sel + i1;
            const int r0 = (int)atomicAdd(&cnt[e0], 1u), r1 = (int)atomicAdd(&cnt[e1], 1u);
            route_i[r] = make_int4(e0, r0, e1, r1); route_w[r] = (f32x2){w0 * ws_, w1 * ws_}; }
    }
    __syncthreads();
}
__device__ __forceinline__ int moe_offsets(const Frame& F, int l, int (&off)[NE]) {
    const unsigned* cnt = cnt_ptr(F, l); int acc = 0;
#pragma unroll
    for (int e = 0; e < NE; ++e) { off[e] = acc; const int c = (int)__builtin_amdgcn_readfirstlane(__hip_atomic_load(cnt + e, __ATOMIC_RELAXED, __HIP_MEMORY_SCOPE_AGENT)); acc += ((c + 255) >> 8) << 8; }
    return acc >> 8;
}
__device__ __forceinline__ void phase_moe_permute(Frame& F, int l) {
    int off[NE]; const int ntiles = moe_offsets(F, l, off);
    const bf16* H = (const bf16*)(F.ws + WS_H); bf16* h2s = (bf16*)(F.ws + A_H2S);
    const int4* route_i = (const int4*)(F.ws + WS_ROUTE); int2* pos = (int2*)(F.ws + WS_ROUTE + 1 * MiB);
    if (F.bx == 0) { int* te = tile_e_ptr(F, l);
        for (int t = F.tid; t < ntiles; t += NTHR) { int e = 0;
#pragma unroll
            for (int k = 1; k < NE; ++k) if (t * 256 >= off[k]) e = k;
            te[t] = e; } }
    const int Tm = (l < DEPTH - 1) ? T : TL;
    for (int r = F.gw; r < Tm; r += F.NGW) {
        const int4 ri = route_i[r]; int p0 = 0, p1 = 0;
#pragma unroll
        for (int e = 0; e < NE; ++e) { if (ri.x == e) p0 = off[e] + ri.y; if (ri.z == e) p1 = off[e] + ri.w; }
        const u32x4 a = *(const u32x4*)(H + (size_t)r * D + 8 * F.lane), b = *(const u32x4*)(H + (size_t)r * D + 512 + 8 * F.lane);
        *(u32x4*)(h2s + (size_t)p0 * D + 8 * F.lane) = a; *(u32x4*)(h2s + (size_t)p0 * D + 512 + 8 * F.lane) = b;
        *(u32x4*)(h2s + (size_t)p1 * D + 8 * F.lane) = a; *(u32x4*)(h2s + (size_t)p1 * D + 512 + 8 * F.lane) = b;
        if (F.lane == 0) pos[r] = make_int2(p0, p1);
    }
}

namespace att {
#define SBAR() __builtin_amdgcn_sched_barrier(0)
__device__ __forceinline__ int crow(int r, int hi) { return (r & 3) + 8 * (r >> 2) + 4 * hi; }
__device__ __forceinline__ unsigned cvtpk(float lo, float hi) { unsigned r; asm volatile("v_cvt_pk_bf16_f32 %0, %1, %2" : "=v"(r) : "v"(lo), "v"(hi)); return r; }
constexpr float THRL = 8.f;
__device__ __forceinline__ void partialSM(f32x16& p0, f32x16& p1, float& m_reg, float& alpha) {
    float pmax = p0[0];
#pragma unroll
    for (int r = 1; r < 16; ++r) pmax = fmaxf(pmax, p0[r]);
#pragma unroll
    for (int r = 0; r < 16; ++r) pmax = fmaxf(pmax, p1[r]);
    { auto rr = __builtin_amdgcn_permlane32_swap(__float_as_uint(pmax), __float_as_uint(pmax), false, false); pmax = fmaxf(__uint_as_float(rr[0]), __uint_as_float(rr[1])); }
    float mn;
    if (__builtin_expect(__all(pmax - m_reg <= THRL), 1)) { mn = m_reg; alpha = 1.f; }
    else { mn = fmaxf(m_reg, pmax); alpha = __builtin_amdgcn_exp2f(m_reg - mn); m_reg = mn; }
#pragma unroll
    for (int r = 0; r < 16; ++r) p0[r] = __builtin_amdgcn_exp2f(p0[r] - mn);
#pragma unroll
    for (int r = 0; r < 16; ++r) p1[r] = p1[r] - mn;
}
__device__ __forceinline__ void finishSM(f32x16& p0, f32x16& p1, float alpha, float& l_reg, bf16x8& pa0, bf16x8& pa1, bf16x8& pa2, bf16x8& pa3) {
#pragma unroll
    for (int r = 0; r < 16; ++r) p1[r] = __builtin_amdgcn_exp2f(p1[r]);
    float ps = 0;
#pragma unroll
    for (int r = 0; r < 16; ++r) ps += p0[r];
#pragma unroll
    for (int r = 0; r < 16; ++r) ps += p1[r];
    { auto rr = __builtin_amdgcn_permlane32_swap(__float_as_uint(ps), __float_as_uint(ps), false, false); ps = __uint_as_float(rr[0]) + __uint_as_float(rr[1]); }
    l_reg = l_reg * alpha + ps;
#define PK4(P, BASE, OUT) do { unsigned a0 = cvtpk(P[BASE + 0], P[BASE + 1]), a1 = cvtpk(P[BASE + 2], P[BASE + 3]);   \
    unsigned b0 = cvtpk(P[BASE + 4], P[BASE + 5]), b1 = cvtpk(P[BASE + 6], P[BASE + 7]);                              \
    auto r0 = __builtin_amdgcn_permlane32_swap(a0, b0, false, false); auto r1 = __builtin_amdgcn_permlane32_swap(a1, b1, false, false); \
    u32x4 w = {r0[0], r1[0], r0[1], r1[1]}; OUT = *reinterpret_cast<bf16x8*>(&w); } while (0)
    PK4(p0, 0, pa0); PK4(p0, 8, pa1); PK4(p1, 0, pa2); PK4(p1, 8, pa3);
#undef PK4
}
template <int DK> __device__ __forceinline__ void qkt(f32x16& p0, f32x16& p1, const LAS char* Ks, const bf16x8* qr, int r32, int hi) {
    constexpr int KS = 2 * DK + 16;
    p0 = f32x16{}; p1 = f32x16{};
#pragma unroll
    for (int d0 = 0; d0 < DK / 16; ++d0) { const int cb = (d0 * 16 + hi * 8) * 2;
        const bf16x8 b0 = *(const LAS bf16x8*)(Ks + r32 * KS + cb);
        const bf16x8 b1 = *(const LAS bf16x8*)(Ks + (32 + r32) * KS + cb);
        p0 = __builtin_amdgcn_mfma_f32_32x32x16_bf16(b0, qr[d0], p0, 0, 0, 0);
        p1 = __builtin_amdgcn_mfma_f32_32x32x16_bf16(b1, qr[d0], p1, 0, 0, 0); }
}
__device__ __forceinline__ int v_st(int k, int c) { const int kk = (k & ~0xC) | ((k & 4) << 1) | ((k & 8) >> 1); return ((kk >> 3) * 2 + (c >> 5)) * 512 + ((kk & 7) * 32 + (c & 31)) * 2; }
__device__ __forceinline__ int v_rd_base(int lane) { return ((lane & 3) << 3) | (((lane >> 2) & 3) << 6) | (((lane >> 4) & 1) << 5) | (((lane >> 5) & 1) << 8); }
constexpr int v_rd_off(int d0, int ks, int half) { return d0 * 512 + ks * 2048 + half * 1024; }
template <int OFF> __device__ __forceinline__ s16x4 tr_read(int vb) { s16x4 r; asm volatile("ds_read_b64_tr_b16 %0, %1 offset:%2" : "=&v"(r) : "v"(vb), "i"(OFF) : "memory"); return r; }
template <int D0> __device__ __forceinline__ void pv_one(f32x16& od, int vb, bf16x8 pa0, bf16x8 pa1, bf16x8 pa2, bf16x8 pa3) {
    const s16x4 l0 = tr_read<v_rd_off(D0, 0, 0)>(vb), h0 = tr_read<v_rd_off(D0, 0, 1)>(vb), l1 = tr_read<v_rd_off(D0, 1, 0)>(vb), h1 = tr_read<v_rd_off(D0, 1, 1)>(vb);
    const s16x4 l2 = tr_read<v_rd_off(D0, 2, 0)>(vb), h2 = tr_read<v_rd_off(D0, 2, 1)>(vb), l3 = tr_read<v_rd_off(D0, 3, 0)>(vb), h3 = tr_read<v_rd_off(D0, 3, 1)>(vb);
    asm volatile("s_waitcnt lgkmcnt(0)" ::: "memory"); SBAR();
#define PK(L, H) (bf16x8){L[0], L[1], L[2], L[3], H[0], H[1], H[2], H[3]}
    od = __builtin_amdgcn_mfma_f32_32x32x16_bf16(pa0, PK(l0, h0), od, 0, 0, 0);
    od = __builtin_amdgcn_mfma_f32_32x32x16_bf16(pa1, PK(l1, h1), od, 0, 0, 0);
    od = __builtin_amdgcn_mfma_f32_32x32x16_bf16(pa2, PK(l2, h2), od, 0, 0, 0);
    od = __builtin_amdgcn_mfma_f32_32x32x16_bf16(pa3, PK(l3, h3), od, 0, 0, 0);
#undef PK
}
struct Unit {
    const bf16* Q; int ldq;
    const bf16* K; const bf16* V; int ldk;
    int nA, rowA, nB, rowB, rlo, rhi;
    int mask;
    int kb0, q0;
    float sink; int has_sink;
    bf16* O; int ldo;
};
template <int DK> __device__ __forceinline__ void attn_unit(const Unit& U, LAS char* lds, const int tid) {
    constexpr int KS = 2 * DK + 16, SHM_V = 8192, SHM_K = 64 * KS, NKP = DK / 8;
    const int wid = __builtin_amdgcn_readfirstlane(tid >> 6), lane = tid & 63, r32 = lane & 31, hi = lane >> 5;
    LAS char* V_lds = lds; LAS char* K_lds = lds + 2 * SHM_V;
    LAS float* ws = (LAS float*)(lds + 2 * SHM_V + 2 * SHM_K) + wid * 64; LAS float* li_l = ws; LAS float* al_l = ws + 32;
    float m_reg = -1e30f, l_reg = 0; f32x16 o[2] = {}; bf16x8 qr[DK / 16];
    const bf16* Qw = U.Q + (size_t)(wid * 32 + r32) * U.ldq + hi * 8;
#pragma unroll
    for (int d0 = 0; d0 < DK / 16; ++d0) qr[d0] = *(const bf16x8*)(Qw + d0 * 16);
    const int vkey = tid >> 3, vc = (tid & 7) * 8, vst = v_st(vkey, vc);
    const int k0key = tid / NKP, k0ch = tid % NKP, k1key = (512 + tid) / NKP, k1ch = (512 + tid) % NKP;
    const bool k1on = (DK == 96) && (tid < 256);
    const int vb0 = (int)(uintptr_t)V_lds + v_rd_base(lane);
    const int NT = U.nA + U.nB;
    auto tile_row = [&](int j) -> int { if (j < U.nA) return U.rowA + 64 * j; int r = U.rowB + 64 * (j - U.nA); r = r < U.rlo ? U.rlo : r; return r > U.rhi ? U.rhi : r; };
    struct Slot { bf16x8 v, k0, k1; };
    Slot sE, sO;
#define SLOAD(sl, j) do { const int _row = tile_row(j); sl.v = *(const bf16x8*)(U.V + (size_t)(_row + vkey) * U.ldk + vc); sl.k0 = *(const bf16x8*)(U.K + (size_t)(_row + k0key) * U.ldk + k0ch * 8); \
        if (k1on) sl.k1 = *(const bf16x8*)(U.K + (size_t)(_row + k1key) * U.ldk + k1ch * 8); } while (0)
#define SWRITE(b, sl) do { *(LAS bf16x8*)(V_lds + (b) * SHM_V + vst) = sl.v; *(LAS bf16x8*)(K_lds + (b) * SHM_K + k0key * KS + k0ch * 16) = sl.k0; \
        if (k1on) *(LAS bf16x8*)(K_lds + (b) * SHM_K + k1key * KS + k1ch * 16) = sl.k1; } while (0)
#define RESC(a) do { if (__any((a) < 1.f)) { if (hi == 0) al_l[r32] = (a); asm volatile("s_waitcnt lgkmcnt(0)" ::: "memory"); \
        _Pragma("unroll") for (int d = 0; d < 2; ++d) _Pragma("unroll") for (int r = 0; r < 16; ++r) o[d][r] *= al_l[crow(r, hi)]; } } while (0)
#define MASK(P0, P1, j) do { if (U.mask && (j) >= U.nA) { const int kb = U.kb0 + 64 * ((j) - U.nA), dq = wid * 32 + r32; \
        _Pragma("unroll") for (int r = 0; r < 16; ++r) { const int k0_ = kb + crow(r, hi), k1_ = k0_ + 32; \
            const bool ok0 = (k0_ - dq <= 128) && (dq - k0_ <= 128) && ((unsigned)(U.q0 + k0_) < (unsigned)S); \
            const bool ok1 = (k1_ - dq <= 128) && (dq - k1_ <= 128) && ((unsigned)(U.q0 + k1_) < (unsigned)S); \
            P0[r] = ok0 ? P0[r] : -INFINITY; P1[r] = ok1 ? P1[r] : -INFINITY; } } } while (0)
    f32x16 pA0, pA1, pB0, pB1; float alA, alB; bf16x8 pa0, pa1, pa2, pa3;
    __syncthreads();
    SLOAD(sE, 0); SWRITE(0, sE); __syncthreads();
    qkt<DK>(pA0, pA1, K_lds, qr, r32, hi); MASK(pA0, pA1, 0); partialSM(pA0, pA1, m_reg, alA);
    SLOAD(sO, 1); if (2 < NT) SLOAD(sE, 2);
    SWRITE(1, sO); __syncthreads();
    for (int j = 1; j + 1 < NT; j += 2) {
        SBAR(); qkt<DK>(pB0, pB1, K_lds + SHM_K, qr, r32, hi); MASK(pB0, pB1, j);
        finishSM(pA0, pA1, alA, l_reg, pa0, pa1, pa2, pa3); SBAR();
        SLOAD(sO, j + 2); SBAR();
        pv_one<0>(o[0], vb0, pa0, pa1, pa2, pa3); pv_one<1>(o[1], vb0, pa0, pa1, pa2, pa3); partialSM(pB0, pB1, m_reg, alB);
        __syncthreads(); SWRITE(0, sE);
        RESC(alB); __syncthreads();
        SBAR(); qkt<DK>(pA0, pA1, K_lds, qr, r32, hi); MASK(pA0, pA1, j + 1);
        finishSM(pB0, pB1, alB, l_reg, pa0, pa1, pa2, pa3); SBAR();
        if (j + 3 < NT) SLOAD(sE, j + 3); SBAR();
        pv_one<0>(o[0], vb0 + SHM_V, pa0, pa1, pa2, pa3); pv_one<1>(o[1], vb0 + SHM_V, pa0, pa1, pa2, pa3); partialSM(pA0, pA1, m_reg, alA);
        __syncthreads(); SWRITE(1, sO);
        RESC(alA); __syncthreads();
    }
    SBAR(); qkt<DK>(pB0, pB1, K_lds + SHM_K, qr, r32, hi); MASK(pB0, pB1, NT - 1);
    finishSM(pA0, pA1, alA, l_reg, pa0, pa1, pa2, pa3); SBAR();
    pv_one<0>(o[0], vb0, pa0, pa1, pa2, pa3); pv_one<1>(o[1], vb0, pa0, pa1, pa2, pa3); partialSM(pB0, pB1, m_reg, alB);
    __syncthreads(); RESC(alB);
    finishSM(pB0, pB1, alB, l_reg, pa0, pa1, pa2, pa3); SBAR();
    pv_one<0>(o[0], vb0 + SHM_V, pa0, pa1, pa2, pa3); pv_one<1>(o[1], vb0 + SHM_V, pa0, pa1, pa2, pa3);
    if (U.has_sink) l_reg += __builtin_amdgcn_exp2f(U.sink * LOG2E - m_reg);
    if (hi == 0) li_l[r32] = l_reg; asm volatile("s_waitcnt lgkmcnt(0)" ::: "memory");
    float rli[16];
#pragma unroll
    for (int r = 0; r < 16; ++r) rli[r] = __builtin_amdgcn_rcpf(li_l[crow(r, hi)]);
    bf16* Ow = U.O + (size_t)(wid * 32) * U.ldo;
#pragma unroll
    for (int r = 0; r < 16; ++r) { const int orow = crow(r, hi);
#pragma unroll
        for (int d0 = 0; d0 < 2; ++d0) Ow[(size_t)orow * U.ldo + d0 * 32 + r32] = (bf16)f2bf(o[d0][r] * rli[r]); }
#undef SLOAD
#undef SWRITE
#undef RESC
#undef MASK
}
}

constexpr float SWA_C2 = 0.125f * LOG2E;
__device__ __forceinline__ void phase_even_prep(Frame& F, int li) {
    bf16* P = (bf16*)(F.ws + A_P); bf16* MIX = (bf16*)(F.ws + A_MIX);
    const f32x2* r64 = (const f32x2*)(F.ws + WS_ROPE);
    {
        const int head = F.lane >> 2, qt = F.lane & 3;
        const float* gain = (head < 12 ? inp(F, I_SWAQG) : inp(F, I_SWAKG)) + li * 64 + 16 * qt;
        float gn[16];
#pragma unroll
        for (int j = 0; j < 16; ++j) gn[j] = gain[j] * (head < 12 ? SWA_C2 : 1.f);
        for (int r = F.gw; r < T; r += F.NGW) {
            bf16* p = P + (size_t)r * EV_N + 256 + 64 * head + 16 * qt;
            const u32x4 a = *(const u32x4*)p, b = *(const u32x4*)(p + 8);
            float v[16] = {bflo(a.x), bfhi(a.x), bflo(a.y), bfhi(a.y), bflo(a.z), bfhi(a.z), bflo(a.w), bfhi(a.w), bflo(b.x), bfhi(b.x), bflo(b.y), bfhi(b.y), bflo(b.z), bfhi(b.z), bflo(b.w), bfhi(b.w)};
            float ss = 0.f;
#pragma unroll
            for (int j = 0; j < 16; ++j) ss += v[j] * v[j];
            ss += __shfl_xor(ss, 1); ss += __shfl_xor(ss, 2);
            const float rstd = 1.f / sqrtf(ss * (1.f / 64.f) + EPS);
#pragma unroll
            for (int j = 0; j < 16; ++j) v[j] = v[j] * rstd * gn[j];
            if (r < TL) { const int s = r % S; const f32x2* cs = r64 + (size_t)s * 32 + 16 * (qt & 1);
#pragma unroll
                for (int j = 0; j < 16; ++j) { const float pr = __shfl_xor(v[j], 2); const f32x2 c = cs[j]; v[j] = (qt < 2) ? v[j] * c.x - pr * c.y : v[j] * c.x + pr * c.y; } }
            *(u32x4*)p = (u32x4){pk2(v[0], v[1]), pk2(v[2], v[3]), pk2(v[4], v[5]), pk2(v[6], v[7])};
            *(u32x4*)(p + 8) = (u32x4){pk2(v[8], v[9]), pk2(v[10], v[11]), pk2(v[12], v[13]), pk2(v[14], v[15])};
        }
    }
    {
        __syncthreads();
        LAS float* la = (LAS float*)F.lds;
        LAS float* lp = la + 48 * 256;
        const float* pw = inp(F, I_POOLW) + (size_t)li * 4 * 64 * 64;
        const int d = F.tid & 255, g = d >> 6, hh = F.tid >> 8;
        const float psc = inp(F, I_POOLS)[li * 256 + d];
        for (int tile = F.vcu; tile < T / 32; tile += F.G) {
            const int r0 = tile * 32; const bool lat = r0 < TL; const int L = lat ? S : CL, seq0 = lat ? (r0 / S) * S : TL + ((r0 - TL) / CL) * CL, t0 = r0 - seq0;
            __syncthreads();
            for (int i = F.tid; i < 48 * 32; i += NTHR) { const int rr = i >> 5, c8 = (i & 31) * 8, t = t0 - 8 + rr;
                u32x4 w = {0u, 0u, 0u, 0u}; if (t >= 0 && t < L) w = *(const u32x4*)(P + (size_t)(seq0 + t) * EV_N + c8);
                LAS float* dst = la + rr * 256 + c8; dst[0] = bflo(w.x); dst[1] = bfhi(w.x); dst[2] = bflo(w.y); dst[3] = bfhi(w.y); dst[4] = bflo(w.z); dst[5] = bfhi(w.z); dst[6] = bflo(w.w); dst[7] = bfhi(w.w); }
            __syncthreads();
            { const int hw = 1 << g;
              for (int rr = hh * 16; rr < hh * 16 + 16; ++rr) { const int t = t0 + rr; int lo = t - hw, hi_ = t + hw; lo = lo < 0 ? 0 : lo; hi_ = hi_ > L ? L : hi_;
                  float s = 0.f; for (int u = lo; u < hi_; ++u) s += la[(u - t0 + 8) * 256 + d];
                  lp[rr * 256 + d] = s / (float)(hi_ - lo) - la[(rr + 8) * 256 + d]; } }
            __syncthreads();
            { float acc[16];
#pragma unroll
              for (int i = 0; i < 16; ++i) acc[i] = 0.f;
              for (int c = 0; c < 64; ++c) { const float w = pw[(g * 64 + c) * 64 + (d & 63)];
#pragma unroll
                  for (int i = 0; i < 16; ++i) acc[i] += lp[(hh * 16 + i) * 256 + g * 64 + c] * w; }
#pragma unroll
              for (int i = 0; i < 16; ++i) MIX[(size_t)(r0 + hh * 16 + i) * D + d] = (bf16)f2bf(acc[i] * psc); }
        }
        __syncthreads();
    }
}

__device__ __forceinline__ void phase_swa(Frame& F, int li, bool need_ctx) {
    const bf16* P = (const bf16*)(F.ws + A_P); bf16* MIX = (bf16*)(F.ws + A_MIX);
    const int nlat = NB * 12 * (S / 256), nctx = need_ctx ? NB * 12 : 0;
    for (int u = F.vcu; u < nlat + nctx; u += F.G) {
        att::Unit U; U.ldq = EV_N; U.ldk = EV_N; U.ldo = D; U.has_sink = 1;
        if (u < nlat) { const int qb = u % (S / 256), qh = (u / (S / 256)) % 12, b = u / (12 * (S / 256)), kvh = qh / 3, row0 = b * S + qb * 256;
            U.Q = P + (size_t)row0 * EV_N + 256 + 64 * qh; U.K = P + 1024 + 64 * kvh; U.V = P + 1280 + 64 * kvh;
            U.nA = 4; U.rowA = TL + b * CL; U.nB = 8; U.rowB = row0 - 128; U.rlo = b * S; U.rhi = b * S + S - 64; U.mask = 1; U.kb0 = -128; U.q0 = qb * 256;
            U.sink = inp(F, I_SINK)[li * 12 + qh]; U.O = MIX + (size_t)row0 * D + 256 + 64 * qh; }
        else { const int uu = u - nlat, qh = uu % 12, b = uu / 12, kvh = qh / 3, row0 = TL + b * CL;
            U.Q = P + (size_t)row0 * EV_N + 256 + 64 * qh; U.K = P + 1024 + 64 * kvh; U.V = P + 1280 + 64 * kvh;
            U.nA = 4; U.rowA = row0; U.nB = 0; U.rowB = 0; U.rlo = 0; U.rhi = 0; U.mask = 0; U.kb0 = 0; U.q0 = 0;
            U.sink = inp(F, I_SINK)[li * 12 + qh]; U.O = MIX + (size_t)row0 * D + 256 + 64 * qh; }
        att::attn_unit<64>(U, (LAS char*)F.lds, F.tid);
    }
    __syncthreads();
}

namespace fft {
constexpr int N = 16384, IMG_BYTES = 17408 * 8;
__device__ __forceinline__ int phys(int i) { return i + 4 * (i >> 6); }
__device__ __forceinline__ f32x2 cmul(f32x2 a, f32x2 b) { return (f32x2){a.x * b.x - a.y * b.y, a.x * b.y + a.y * b.x}; }
__device__ __forceinline__ f32x2 cconj(f32x2 a) { return (f32x2){a.x, -a.y}; }
__device__ __forceinline__ void init_tables(LAS f32x2* tw, int tid) {
    if (tid < 384) { const int m = tid < 256 ? 128 * tid : tid - 256; float s, c; sincospif(-(float)m * (1.f / 16384.f), &s, &c); tw[tid] = (f32x2){c, s}; }
}
__device__ __forceinline__ f32x2 tw32k(const LAS f32x2* tw, int m) { return cmul(tw[(m >> 7) & 255], tw[256 + (m & 127)]); }
__device__ __forceinline__ void dft4(f32x2& x0, f32x2& x1, f32x2& x2, f32x2& x3) {
    const f32x2 a = x0 + x2, b = x0 - x2, c = x1 + x3, d = x1 - x3;
    x0 = a + c; x2 = a - c; x1 = (f32x2){b.x + d.y, b.y - d.x}; x3 = (f32x2){b.x - d.y, b.y + d.x};
}
__device__ __forceinline__ void dft16(f32x2 (&v)[16]) {
#pragma unroll
    for (int b = 0; b < 4; ++b) dft4(v[b], v[4 + b], v[8 + b], v[12 + b]);
    const float C1 = 0.92387953251128674f, S1 = 0.38268343236508977f, R2 = 0.70710678118654752f;
    const f32x2 W1 = {C1, -S1}, W2 = {R2, -R2}, W3 = {S1, -C1}, W4 = {0.f, -1.f}, W6 = {-R2, -R2}, W9 = {-C1, S1};
    v[4 * 1 + 1] = cmul(v[4 * 1 + 1], W1); v[4 * 1 + 2] = cmul(v[4 * 1 + 2], W2); v[4 * 1 + 3] = cmul(v[4 * 1 + 3], W3);
    v[4 * 2 + 1] = cmul(v[4 * 2 + 1], W2); v[4 * 2 + 2] = cmul(v[4 * 2 + 2], W4); v[4 * 2 + 3] = cmul(v[4 * 2 + 3], W6);
    v[4 * 3 + 1] = cmul(v[4 * 3 + 1], W3); v[4 * 3 + 2] = cmul(v[4 * 3 + 2], W6); v[4 * 3 + 3] = cmul(v[4 * 3 + 3], W9);
    f32x2 o[16];
#pragma unroll
    for (int c = 0; c < 4; ++c) { f32x2 y0 = v[4 * c], y1 = v[4 * c + 1], y2 = v[4 * c + 2], y3 = v[4 * c + 3]; dft4(y0, y1, y2, y3); o[c] = y0; o[c + 4] = y1; o[c + 8] = y2; o[c + 12] = y3; }
#pragma unroll
    for (int r = 0; r < 16; ++r) v[r] = o[r];
}
template <bool INV> __device__ __forceinline__ void pass16(LAS f32x2* X, const LAS f32x2* tw, int Sd, int tid) {
#pragma unroll 1
    for (int q = 0; q < 2; ++q) {
        const int g = tid + 512 * q, blk = (g / Sd) * (16 * Sd), j = g % Sd; f32x2 v[16];
#pragma unroll
        for (int k = 0; k < 16; ++k) v[k] = X[phys(blk + j + Sd * k)];
        const f32x2 w1 = tw32k(tw, 2 * j * (1024 / Sd));
        const f32x2 w2 = cmul(w1, w1), w3 = cmul(w2, w1), w4 = cmul(w2, w2), w5 = cmul(w4, w1), w6 = cmul(w4, w2), w7 = cmul(w4, w3), w8 = cmul(w4, w4);
        const f32x2 w9 = cmul(w8, w1), w10 = cmul(w8, w2), w11 = cmul(w8, w3), w12 = cmul(w8, w4), w13 = cmul(w8, w5), w14 = cmul(w8, w6), w15 = cmul(w8, w7);
#define TWALL(OP) OP(1, w1) OP(2, w2) OP(3, w3) OP(4, w4) OP(5, w5) OP(6, w6) OP(7, w7) OP(8, w8) OP(9, w9) OP(10, w10) OP(11, w11) OP(12, w12) OP(13, w13) OP(14, w14) OP(15, w15)
#define TWMUL(r, w) v[r] = cmul(v[r], w);
        if (INV) {
#pragma unroll
            for (int k = 0; k < 16; ++k) v[k] = cconj(v[k]);
            TWALL(TWMUL)
            dft16(v);
#pragma unroll
            for (int k = 0; k < 16; ++k) v[k] = cconj(v[k]);
        } else { dft16(v); TWALL(TWMUL) }
#undef TWMUL
#undef TWALL
#pragma unroll
        for (int k = 0; k < 16; ++k) X[phys(blk + j + Sd * k)] = v[k];
    }
}
template <bool INV> __device__ __forceinline__ void pass4(LAS f32x2* X, int tid) {
#pragma unroll 1
    for (int q = 0; q < 8; ++q) {
        const int g = tid + 512 * q; LAS f32x2* p = X + phys(4 * g);
        f32x2 a = p[0], b = p[1], c = p[2], d = p[3];
        if (INV) { a = cconj(a); b = cconj(b); c = cconj(c); d = cconj(d); }
        dft4(a, b, c, d);
        if (INV) { a = cconj(a); b = cconj(b); c = cconj(c); d = cconj(d); }
        p[0] = a; p[1] = b; p[2] = c; p[3] = d;
    }
}
__device__ __forceinline__ void fwd(LAS f32x2* X, const LAS f32x2* tw, int tid) {
    __syncthreads(); pass16<false>(X, tw, 1024, tid); __syncthreads(); pass16<false>(X, tw, 64, tid); __syncthreads(); pass16<false>(X, tw, 4, tid); __syncthreads(); pass4<false>(X, tid); __syncthreads();
}
__device__ __forceinline__ void inv(LAS f32x2* X, const LAS f32x2* tw, int tid) {
    __syncthreads(); pass4<true>(X, tid); __syncthreads(); pass16<true>(X, tw, 4, tid); __syncthreads(); pass16<true>(X, tw, 64, tid); __syncthreads(); pass16<true>(X, tw, 1024, tid); __syncthreads();
}
}

__device__ __forceinline__ void hyena_filter_task(Frame& F, int i, int L, int n0, float* gh) {
    LAS float* lz = (LAS float*)F.lds;
    LAS float* l1 = lz + 64 * 33;
    LAS float* l2 = l1 + 64 * 64;
    const float* w1 = inp(F, I_HYW1) + i * 33 * 64; const float* b1 = inp(F, I_HYB1) + i * 64; const float* w2 = inp(F, I_HYW2) + i * 64 * 64; const float* b2 = inp(F, I_HYB2) + i * 64;
    const float* w3 = inp(F, I_HYW3) + (size_t)i * 64 * 1024; const float* fq = inp(F, I_HYFREQ) + i * 128;
    __syncthreads();
    for (int idx = F.tid; idx < 64 * 33; idx += NTHR) { const int p = idx / 33, e = idx % 33; const float pos = (float)(n0 + p);
        float val;
        if (e == 0) val = pos / (float)(L - 1);
        else { const int jj = (e - 1) & 15; const float fr = 1e-4f + (float)jj * ((15.f - 1e-4f) / 15.f); const float ang = (6.283185307179586f / (float)L) * pos * fr; val = e <= 16 ? cosf(ang) : -sinf(ang); }
        lz[idx] = val; }
    __syncthreads();
    { const int k = F.tid & 63, pg = F.tid >> 6;
      for (int p = pg * 8; p < pg * 8 + 8; ++p) { float s = b1[k]; for (int e = 0; e < 33; ++e) s += lz[p * 33 + e] * w1[e * 64 + k]; l1[p * 64 + k] = sinf(fq[k] * s); } }
    __syncthreads();
    { const int k = F.tid & 63, pg = F.tid >> 6;
      for (int p = pg * 8; p < pg * 8 + 8; ++p) { float s = b2[k]; for (int e = 0; e < 64; ++e) s += l1[p * 64 + e] * w2[e * 64 + k]; l2[p * 64 + k] = sinf(fq[64 + k] * s); } }
    __syncthreads();
    { const int p = F.tid & 63, cg = __builtin_amdgcn_readfirstlane(F.tid >> 6); float h2[64];
#pragma unroll
      for (int e = 0; e < 64; ++e) h2[e] = l2[p * 64 + e];
      const float t = (float)(n0 + p) / (float)(L - 1);
      const float d0 = logf(1e-2f) / 0.3f, d1 = logf(1e-2f) / 1.5f;
      for (int cc = 0; cc < 128; ++cc) { const int col = cg * 128 + cc, c = col & 511, dir = col >> 9; float s = 0.f;
#pragma unroll
          for (int e = 0; e < 64; ++e) s += h2[e] * w3[e * 1024 + col];
          const float delta = fabsf(d0 + (d1 - d0) * ((float)c / 511.f));
          gh[((size_t)dir * 512 + c) * L + n0 + p] = s * expf(-t * delta); } }
    __syncthreads();
}

constexpr size_t GHC_OFF = 12 * MiB;
constexpr size_t ZC_OFF = 10 * MiB + 1536 * 1024;
__device__ __forceinline__ float sconv(const bf16* P, int seq0, int L, int t, int col, float w0, float w1, float w2, float bias) {
    const bf16* p = P + (size_t)(seq0 + t) * OD_N + col;
    float s = bias + w1 * bf2f(p[0]);
    if (t > 0) s += w0 * bf2f(p[-OD_N]);
    if (t + 1 < L) s += w2 * bf2f(p[OD_N]);
    return s;
}
__device__ __forceinline__ void hyena_z_tile(Frame& F, int li, int seq0, int L, int t0, int c0, bf16* Zrow0  , int Lz) {
    LAS bf16* l1 = (LAS bf16*)F.lds;
    LAS bf16* l2 = l1 + 130 * 64;
    const bf16* P = (const bf16*)(F.ws + A_P);
    __syncthreads();
    for (int i = F.tid; i < 130 * 8 * 2; i += NTHR) { const int which = i / (130 * 8), r = (i % (130 * 8)) / 8, c8 = (i % 8) * 8, t = t0 - 1 + r;
        u32x4 w = {0u, 0u, 0u, 0u}; if (t >= 0 && t < L) w = *(const u32x4*)(P + (size_t)(seq0 + t) * OD_N + (which ? 1024 : 512) + c0 + c8);
        *(LAS u32x4*)((which ? l2 : l1) + r * 64 + c8) = w; }
    __syncthreads();
    const int c = F.tid & 63, tc = F.tid >> 6;
    const float* cw = inp(F, I_HYCW) + (size_t)li * 3 * 1536; const float* cb = inp(F, I_HYCB) + (size_t)li * 1536;
    const int ca = 512 + c0 + c, cv = 1024 + c0 + c;
    const float a0 = cw[ca], a1 = cw[1536 + ca], a2 = cw[3072 + ca], ab = cb[ca], v0 = cw[cv], v1 = cw[1536 + cv], v2 = cw[3072 + cv], vb = cb[cv];
    unsigned o[8];
#pragma unroll
    for (int i = 0; i < 16; i += 2) { float z[2];
#pragma unroll
        for (int k = 0; k < 2; ++k) { const int r = tc * 16 + i + k + 1;
            const float x1 = ab + a0 * bf2f(l1[(r - 1) * 64 + c]) + a1 * bf2f(l1[r * 64 + c]) + a2 * bf2f(l1[(r + 1) * 64 + c]);
            const float vv = vb + v0 * bf2f(l2[(r - 1) * 64 + c]) + v1 * bf2f(l2[r * 64 + c]) + v2 * bf2f(l2[(r + 1) * 64 + c]);
            z[k] = x1 * vv; }
        o[i / 2] = pk2(z[0], z[1]); }
    bf16* dst = Zrow0 + (size_t)(c0 + c) * Lz + t0 + tc * 16;
    *(u32x4*)dst = (u32x4){o[0], o[1], o[2], o[3]}; *(u32x4*)(dst + 8) = (u32x4){o[4], o[5], o[6], o[7]};
}
__device__ __forceinline__ void hyena_filter_fft_unit(Frame& F, int c, int par) {
    LAS f32x2* X = (LAS f32x2*)F.lds; LAS f32x2* tw = (LAS f32x2*)(F.lds + fft::IMG_BYTES); LAS float* red = (LAS float*)(F.lds + fft::IMG_BYTES + 3072);
    const float* hf = (const float*)(F.ws + A_KVU) + (size_t)c * S; const float* hb = hf + (size_t)512 * S;
    __syncthreads();
    fft::init_tables(tw, F.tid);
    __syncthreads();
    float an = 0.f;
    for (int n = F.tid; n < S; n += NTHR) { const float f = hf[n], g = n ? hb[S - n] : 0.f; an += fabsf(f) + fabsf(g);
        f32x2 v; if (par == 0) v = (f32x2){f + g, 0.f}; else { const f32x2 t = fft::tw32k(tw, n); v = (f32x2){(f - g) * t.x, (f - g) * t.y}; }
        X[fft::phys(n)] = v; }
    an = wave_sum(an); if (F.lane == 0) red[F.wave] = an;
    fft::fwd(X, tw, F.tid);
    float nrm = 0.f;
#pragma unroll
    for (int w = 0; w < 8; ++w) nrm += red[w];
    const float sc = 1.f / (nrm * 2.f * (float)S);
    f32x2* G = (f32x2*)(F.ws + A_G) + ((size_t)c * 2 + par) * S;
    for (int p = F.tid; p < S; p += NTHR) { const f32x2 v = X[fft::phys(p)]; G[p] = (f32x2){v.x * sc, v.y * sc}; }
}
__device__ __forceinline__ void hyena_conv_unit(Frame& F, int c) {
    LAS f32x2* X = (LAS f32x2*)F.lds; LAS f32x2* tw = (LAS f32x2*)(F.lds + fft::IMG_BYTES);
    bf16* z0 = (bf16*)(F.ws + A_ZY) + (size_t)c * S; bf16* z1 = z0 + (size_t)512 * S;
    const f32x2* G = (const f32x2*)(F.ws + A_G) + (size_t)c * 2 * S;
    __syncthreads();
    fft::init_tables(tw, F.tid);
    __syncthreads();
    f32x2* yeg = (f32x2*)(F.ws + WS_H) + (size_t)F.bx * S;
#pragma unroll 1
    for (int par = 0; par < 2; ++par) {
        __syncthreads();
#pragma unroll 1
        for (int q = 0; q < 4; ++q) { const int n0 = 4096 * q + 8 * F.tid; const u32x4 a = *(const u32x4*)(z0 + n0), b = *(const u32x4*)(z1 + n0);
            const float re[8] = {bflo(a.x), bfhi(a.x), bflo(a.y), bfhi(a.y), bflo(a.z), bfhi(a.z), bflo(a.w), bfhi(a.w)}, im[8] = {bflo(b.x), bfhi(b.x), bflo(b.y), bfhi(b.y), bflo(b.z), bfhi(b.z), bflo(b.w), bfhi(b.w)};
#pragma unroll
            for (int i = 0; i < 8; ++i) { f32x2 v = {re[i], im[i]}; if (par) v = fft::cmul(v, fft::tw32k(tw, n0 + i)); X[fft::phys(n0 + i)] = v; } }
        fft::fwd(X, tw, F.tid);
        for (int p = F.tid; p < S; p += NTHR) { const int pp = fft::phys(p); X[pp] = fft::cmul(X[pp], G[(size_t)par * S + p]); }
        fft::inv(X, tw, F.tid);
        if (par == 0) {
            for (int p = F.tid; p < S; p += NTHR) yeg[p] = X[fft::phys(p)];
        } else {
#pragma unroll 1
            for (int q = 0; q < 4; ++q) { const int n0 = 4096 * q + 8 * F.tid; float re[8], im[8];
#pragma unroll
                for (int i = 0; i < 8; ++i) { const f32x2 v = fft::cmul(X[fft::phys(n0 + i)], fft::cconj(fft::tw32k(tw, n0 + i))); const f32x2 e = yeg[n0 + i]; re[i] = e.x + v.x; im[i] = e.y + v.y; }
                *(u32x4*)(z0 + n0) = (u32x4){pk2(re[0], re[1]), pk2(re[2], re[3]), pk2(re[4], re[5]), pk2(re[6], re[7])};
                *(u32x4*)(z1 + n0) = (u32x4){pk2(im[0], im[1]), pk2(im[2], im[3]), pk2(im[4], im[5]), pk2(im[6], im[7])}; }
        }
    }
}
__device__ __forceinline__ void hyena_ctx_conv_unit(Frame& F, int g8) {
    LAS float* lf = (LAS float*)F.lds; LAS float* lb = lf + 256; LAS float* lz = lb + 256; LAS float* red = lz + 512;
    const float* ghc = (const float*)(F.ws + GHC_OFF); bf16* zc = (bf16*)(F.ws + ZC_OFF);
    const int t = F.tid & 255, b = F.tid >> 8;
    for (int c = g8 * 8; c < g8 * 8 + 8; ++c) {
        __syncthreads();
        float an = 0.f;
        if (F.tid < 256) { const float f = ghc[(size_t)c * CL + t], g = ghc[((size_t)512 + c) * CL + t]; lf[t] = f; lb[t] = g; an = fabsf(f) + (t ? fabsf(g) : 0.f); }
        lz[b * 256 + t] = bf2f(zc[((size_t)b * 512 + c) * CL + t]);
        an = wave_sum(an); if (F.lane == 0) red[F.wave] = an;
        __syncthreads();
        float nrm = 0.f;
#pragma unroll
        for (int w = 0; w < 8; ++w) nrm += red[w];
        float y = 0.f;
        for (int s = 0; s <= t; ++s) y += lf[t - s] * lz[b * 256 + s];
        for (int s = t + 1; s < CL; ++s) y += lb[s - t] * lz[b * 256 + s];
        __syncthreads();
        zc[((size_t)b * 512 + c) * CL + t] = (bf16)f2bf(y / nrm);
    }
}
__device__ __forceinline__ void hyena_gate_tile(Frame& F, int li, int seq0, int L, int t0, int c0, const bf16* Yrow0, int Lz) {
    LAS bf16* l0 = (LAS bf16*)F.lds; LAS bf16* l1 = l0 + 130 * 64; LAS bf16* l2 = l1 + 130 * 64;
    const bf16* P = (const bf16*)(F.ws + A_P); bf16* MIX = (bf16*)(F.ws + A_MIX);
    __syncthreads();
    for (int i = F.tid; i < 130 * 8 * 3; i += NTHR) { const int which = i / (130 * 8), r = (i % (130 * 8)) / 8, c8 = (i % 8) * 8, t = t0 - 1 + r;
        u32x4 w = {0u, 0u, 0u, 0u}; if (t >= 0 && t < L) w = *(const u32x4*)(P + (size_t)(seq0 + t) * OD_N + which * 512 + c0 + c8);
        *(LAS u32x4*)((which == 0 ? l0 : which == 1 ? l1 : l2) + r * 64 + c8) = w; }
    __syncthreads();
    const int c = F.tid & 63, tc = F.tid >> 6;
    const float* cw = inp(F, I_HYCW) + (size_t)li * 3 * 1536; const float* cb = inp(F, I_HYCB) + (size_t)li * 1536;
    const int c0_ = c0 + c, ca = 512 + c0 + c, cv = 1024 + c0 + c;
    const float x0w0 = cw[c0_], x0w1 = cw[1536 + c0_], x0w2 = cw[3072 + c0_], x0b = cb[c0_];
    const float a0 = cw[ca], a1 = cw[1536 + ca], a2 = cw[3072 + ca], ab = cb[ca], v0 = cw[cv], v1 = cw[1536 + cv], v2 = cw[3072 + cv], vb = cb[cv];
    const float skip = inp(F, I_HYSKIP)[li * 512 + c0_];
    const bf16* ysrc = Yrow0 + (size_t)c0_ * Lz + t0 + tc * 16;
    const u32x4 ya = *(const u32x4*)ysrc, yb = *(const u32x4*)(ysrc + 8);
    const float yv[16] = {bflo(ya.x), bfhi(ya.x), bflo(ya.y), bfhi(ya.y), bflo(ya.z), bfhi(ya.z), bflo(ya.w), bfhi(ya.w), bflo(yb.x), bfhi(yb.x), bflo(yb.y), bfhi(yb.y), bflo(yb.z), bfhi(yb.z), bflo(yb.w), bfhi(yb.w)};
#pragma unroll
    for (int i = 0; i < 16; ++i) { const int r = tc * 16 + i + 1;
        const float x0 = x0b + x0w0 * bf2f(l0[(r - 1) * 64 + c]) + x0w1 * bf2f(l0[r * 64 + c]) + x0w2 * bf2f(l0[(r + 1) * 64 + c]);
        const float x1 = ab + a0 * bf2f(l1[(r - 1) * 64 + c]) + a1 * bf2f(l1[r * 64 + c]) + a2 * bf2f(l1[(r + 1) * 64 + c]);
        const float vv = vb + v0 * bf2f(l2[(r - 1) * 64 + c]) + v1 * bf2f(l2[r * 64 + c]) + v2 * bf2f(l2[(r + 1) * 64 + c]);
        const float z = x1 * vv;
        MIX[(size_t)(seq0 + t0 + tc * 16 + i) * D + c0_] = (bf16)f2bf(x0 * (yv[i] + skip * z)); }
}

__device__ __forceinline__ void phase_odd_prep(Frame& F, int li, bool need_ctx) {
    const bf16* P = (const bf16*)(F.ws + A_P); float* rs = (float*)(F.ws + WS_MISC + MISC_RSTD);
    for (int r = F.gw; r < T; r += F.NGW) {
        const bf16* p = P + (size_t)r * OD_N + 1536; const u32x2 a = *(const u32x2*)(p + 4 * F.lane); const unsigned b = *(const unsigned*)(p + 256 + 2 * F.lane);
        float s1 = bflo(a.x) * bflo(a.x) + bfhi(a.x) * bfhi(a.x) + bflo(a.y) * bflo(a.y) + bfhi(a.y) * bfhi(a.y), s2 = bflo(b) * bflo(b) + bfhi(b) * bfhi(b);
        s1 = wave_sum(s1); s2 = wave_sum(s2);
        if (F.lane == 0) { rs[r] = 1.f / sqrtf(s1 * (1.f / 256.f) + EPS); rs[T + r] = 1.f / sqrtf(s2 * (1.f / 128.f) + EPS); }
    }
    const int nz = 2048 + (need_ctx ? 32 : 0);
    for (int u = F.vcu; u < nz; u += F.G) {
        if (u < 2048) { const int cc = u & 7, tt = (u >> 3) & 127, b = u >> 10; hyena_z_tile(F, li, b * S, S, tt * 128, cc * 64, (bf16*)(F.ws + A_ZY) + (size_t)b * 512 * S, S); }
        else { const int uu = u - 2048, cc = uu & 7, tt = (uu >> 3) & 1, b = uu >> 4; hyena_z_tile(F, li, TL + b * CL, CL, tt * 128, cc * 64, (bf16*)(F.ws + ZC_OFF) + (size_t)b * 512 * CL, CL); }
    }
    for (int u = F.vcu; u < 1024; u += F.G) hyena_filter_fft_unit(F, u >> 1, u & 1);
    __syncthreads();
}
constexpr float MLA_C2 = 0.10206207261596577f * LOG2E;
__device__ __forceinline__ void phase_mla_prep(Frame& F, int li) {
    const bf16* P = (const bf16*)(F.ws + A_P); bf16* QU = (bf16*)(F.ws + A_QU); bf16* KVU = (bf16*)(F.ws + A_KVU);
    const f32x2* r32t = (const f32x2*)(F.ws + WS_ROPE) + (size_t)S * 32;
    const int hd = F.lane >> 2, qt = F.lane & 3, isk = hd >= 8, h = hd & 7;
    const float* gain = (isk ? inp(F, I_MKG) : inp(F, I_MQG)) + li * 96 + 24 * qt;
    float gn[24];
#pragma unroll
    for (int j = 0; j < 24; ++j) gn[j] = gain[j] * (isk ? 1.f : MLA_C2);
    for (int r = F.gw; r < T; r += F.NGW) {
        bf16* base = isk ? KVU + (size_t)r * KVU_N + 160 * h : QU + (size_t)r * QU_N + 96 * h;
        float v[24];
#pragma unroll
        for (int j8 = 0; j8 < 3; ++j8) { const int e0 = 24 * qt + 8 * j8;
            u32x4 w;
            if (isk && e0 >= 64) w = *(const u32x4*)(P + (size_t)r * OD_N + 1920 + (e0 - 64)); else w = *(const u32x4*)(base + e0);
            v[8 * j8 + 0] = bflo(w.x); v[8 * j8 + 1] = bfhi(w.x); v[8 * j8 + 2] = bflo(w.y); v[8 * j8 + 3] = bfhi(w.y); v[8 * j8 + 4] = bflo(w.z); v[8 * j8 + 5] = bfhi(w.z); v[8 * j8 + 6] = bflo(w.w); v[8 * j8 + 7] = bfhi(w.w); }
        float ss = 0.f;
#pragma unroll
        for (int j = 0; j < 24; ++j) ss += v[j] * v[j];
        ss += __shfl_xor(ss, 1); ss += __shfl_xor(ss, 2);
        const float rstd = 1.f / sqrtf(ss * (1.f / 96.f) + EPS);
#pragma unroll
        for (int j = 0; j < 24; ++j) v[j] *= rstd * gn[j];
        if (r < TL) {
            const int s = r % S; const f32x2* cs = r32t + (size_t)s * 16;
            float x2lo[8], x1lo[8];
#pragma unroll
            for (int i = 0; i < 8; ++i) { x2lo[i] = __shfl_xor(v[8 + i], 1); x1lo[i] = __shfl_xor(v[16 + i], 1); }
            if (qt == 2) {
#pragma unroll
                for (int i = 0; i < 8; ++i) { const f32x2 c = cs[i]; v[16 + i] = v[16 + i] * c.x - x2lo[i] * c.y; }
            } else if (qt == 3) {
#pragma unroll
                for (int i = 0; i < 8; ++i) { const f32x2 c = cs[i]; const float x2 = v[8 + i]; v[8 + i] = x2 * c.x + x1lo[i] * c.y; }
#pragma unroll
                for (int i = 0; i < 8; ++i) { const f32x2 c = cs[8 + i]; const float x1 = v[i], x2 = v[16 + i]; v[i] = x1 * c.x - x2 * c.y; v[16 + i] = x2 * c.x + x1 * c.y; }
            }
        }
#pragma unroll
        for (int j8 = 0; j8 < 3; ++j8) *(u32x4*)(base + 24 * qt + 8 * j8) = (u32x4){pk2(v[8 * j8], v[8 * j8 + 1]), pk2(v[8 * j8 + 2], v[8 * j8 + 3]), pk2(v[8 * j8 + 4], v[8 * j8 + 5]), pk2(v[8 * j8 + 6], v[8 * j8 + 7])};
    }
}
__device__ __forceinline__ void phase_mla(Frame& F, int li, bool need_ctx) {
    const bf16* QU = (const bf16*)(F.ws + A_QU); const bf16* KVU = (const bf16*)(F.ws + A_KVU); bf16* MIX = (bf16*)(F.ws + A_MIX);
    const int nlat = NB * MLA_H * (S / 256), nctx = need_ctx ? NB * MLA_H : 0;
    for (int u = F.vcu; u < nlat + nctx; u += F.G) {
        att::Unit U; U.ldq = QU_N; U.ldk = KVU_N; U.ldo = D; U.has_sink = 0; U.sink = 0.f; U.mask = 0; U.kb0 = 0; U.q0 = 0; U.rlo = 0; U.rhi = T;
        if (u < nlat) { const int qb = u % (S / 256), h = (u / (S / 256)) % MLA_H, b = u / (MLA_H * (S / 256)), row0 = b * S + qb * 256;
            U.Q = QU + (size_t)row0 * QU_N + 96 * h; U.K = KVU + 160 * h; U.V = KVU + 160 * h + 96;
            U.nA = S / 64; U.rowA = b * S; U.nB = CL / 64; U.rowB = TL + b * CL; U.O = MIX + (size_t)row0 * D + 512 + 64 * h; }
        else { const int uu = u - nlat, h = uu % MLA_H, b = uu / MLA_H, row0 = TL + b * CL;
            U.Q = QU + (size_t)row0 * QU_N + 96 * h; U.K = KVU + 160 * h; U.V = KVU + 160 * h + 96;
            U.nA = CL / 64; U.rowA = row0; U.nB = 0; U.rowB = 0; U.O = MIX + (size_t)row0 * D + 512 + 64 * h; }
        att::attn_unit<96>(U, (LAS char*)F.lds, F.tid);
    }
    __syncthreads();
}
__device__ __forceinline__ void phase_hyena_conv(Frame& F, int li, bool need_ctx) {
    for (int c = F.vcu; c < 512; c += F.G) hyena_conv_unit(F, c);
    __syncthreads();
}
__device__ __forceinline__ void phase_hyena_ctx_conv(Frame& F, int li, bool need_ctx) {
    if (need_ctx) for (int g8 = F.vcu; g8 < 64; g8 += F.G) hyena_ctx_conv_unit(F, g8);
    __syncthreads();
}
__device__ __forceinline__ void phase_hyena_gate(Frame& F, int li, bool need_ctx) {
    const int nz = 2048 + (need_ctx ? 32 : 0);
    for (int u = F.vcu; u < nz; u += F.G) {
        if (u < 2048) { const int cc = u & 7, tt = (u >> 3) & 127, b = u >> 10; hyena_gate_tile(F, li, b * S, S, tt * 128, cc * 64, (const bf16*)(F.ws + A_ZY) + (size_t)b * 512 * S, S); }
        else { const int uu = u - 2048, cc = uu & 7, tt = (uu >> 3) & 1, b = uu >> 4; hyena_gate_tile(F, li, TL + b * CL, CL, tt * 128, cc * 64, (const bf16*)(F.ws + ZC_OFF) + (size_t)b * 512 * CL, CL); }
    }
    __syncthreads();
}


__device__ __forceinline__ void ph_gemm_store(Frame& F, const bf16* A, const bf16* Bt, int lda, int K, int M, int N, bf16* O, int ldc, const float* rowscale) {
    asm volatile("" : "+s"(K), "+s"(lda)); pg8::Gemm g{A, Bt, lda, K}; pg8::StaticOrder So; So.init(M, N, F.G, F.bx); pg8::EpiStoreBf16 E{O, ldc, rowscale}; pg8::gemm_phase(F.lds, g, So, E, F.tid);
}
__device__ __forceinline__ void ph_gemm_res(Frame& F, const bf16* A, const bf16* Bt, int M, const float* srcL, float* dstL, const float* srcC, float* dstC, const float* gate, float on) {
    pg8::Gemm g{A, Bt, D, D}; pg8::StaticOrder So; So.init(M, D, F.G, F.bx); pg8::EpiResidual E{srcL, dstL, srcC, dstC, gate, on}; pg8::gemm_phase(F.lds, g, So, E, F.tid);
}
__device__ __forceinline__ void ph_gemm_moe_gu(Frame& F, int l) {
    int off[NE]; const int ntiles = moe_offsets(F, l, off); pg8::Gemm g{(const bf16*)(F.ws + A_H2S), (const bf16*)(F.ws + WS_WMOE), D, D};
    pg8::MoeOrder So{tile_e_ptr(F, l), ntiles, 4, F.G, F.vcu}; pg8::EpiSwiglu E{(bf16*)(F.ws + A_ACT)}; pg8::gemm_phase(F.lds, g, So, E, F.tid);
}
__device__ __forceinline__ void ph_gemm_moe_down(Frame& F, int l) {
    int off[NE]; const int ntiles = moe_offsets(F, l, off); pg8::Gemm g{(const bf16*)(F.ws + A_ACT), (const bf16*)(F.ws + WS_WMOE) + (size_t)NE * 1024 * 1024, FF, FF};
    pg8::MoeOrder So{tile_e_ptr(F, l), ntiles, 4, F.G, F.vcu}; pg8::EpiStoreBf16 E{(bf16*)(F.ws + A_YS), D, nullptr}; pg8::gemm_phase(F.lds, g, So, E, F.tid);
}

__global__ void __launch_bounds__(NTHR, 2) mk_fwd(Args args) {
    extern __shared__ __attribute__((aligned(16))) unsigned char lds_raw[];
    Frame F;
    F.lds = (LAS unsigned char*)lds_raw; F.in = (const LAS unsigned long long*)(F.lds + LDSCTL_OFF + 512); F.out = args.out; F.ws = args.ws;
    F.tid = threadIdx.x; F.lane = F.tid & 63; F.wave = __builtin_amdgcn_readfirstlane(F.tid >> 6);
    F.G = gridDim.x; F.bx = blockIdx.x; F.vcu = F.bx; F.gw = 0; F.NGW = F.G * NWAVES;
    volatile LAS unsigned* MISC = (volatile LAS unsigned*)(F.lds + MISC_OFF);
    for (int u = F.tid; u < (LDS_BYTES - LDSCTL_OFF) / 4; u += NTHR) ((LAS unsigned*)(F.lds + LDSCTL_OFF))[u] = 0u;
    __syncthreads();
    if (F.tid == 0) { LAS unsigned long long* tab = (LAS unsigned long long*)(F.lds + LDSCTL_OFF + 512);
#pragma unroll
        for (int i = 0; i < 36; ++i) tab[i] = (unsigned long long)args.in[i]; }
    __syncthreads();
    const int lo = args.ph_lo, hi = args.ph_hi;
    XcdBarrier bar; bar.bar = (unsigned*)(F.ws + WS_CTL) + CW_BAR; bar.x = 0; bar.st = nullptr;
    if (hi - lo > 1) bar = xcd_barrier_post((unsigned*)(F.ws + WS_CTL) + CW_BAR, MISC + 8);
    int k = 0;
#define PH_BEGIN if (lo <= k && k < hi) { { int t_ = threadIdx.x; asm volatile("" : "+v"(t_)); F.tid = t_; F.lane = t_ & 63; F.wave = __builtin_amdgcn_readfirstlane(t_ >> 6); \
        int b_ = blockIdx.x; asm volatile("" : "+s"(b_)); F.bx = b_; F.vcu = (F.G % 8 == 0) ? (b_ % 8) * (F.G / 8) + b_ / 8 : b_; F.gw = F.vcu * NWAVES + F.wave; \
        unsigned char* w_ = args.ws; asm volatile("" : "+s"(w_)); F.ws = w_; float* o_ = args.out; asm volatile("" : "+s"(o_)); F.out = o_; int g_ = gridDim.x; asm volatile("" : "+s"(g_)); F.G = g_; F.NGW = g_ * NWAVES; }
#define PH_END if (k + 1 < hi) xcd_barrier(bar); } ++k;
#define PH_END_NOBAR __syncthreads(); }
    LAS unsigned char* glds = F.lds;
#define wsm ((bf16*)(F.ws + WS_WSM))
#define H ((bf16*)(F.ws + WS_H))
#define P ((bf16*)(F.ws + A_P))
#define MIX ((bf16*)(F.ws + A_MIX))
#define XC ((float*)(F.ws + WS_XC))

    PH_BEGIN phase_prologue(F); PH_END

#pragma unroll 1
    for (int lp = 0; lp < 2; ++lp) {
        {
            const int l = 2 * lp, li = lp; const bool need_ctx = true;
            PH_BEGIN phase_norm1(F, l); __syncthreads(); moe_weight_convert(F, l); PH_END
            PH_BEGIN ph_gemm_store(F, H, (const bf16*)((const char*)wsm + W_EIN) + (size_t)li * EV_N * D, D, D, T, EV_N, P, EV_N, nullptr); PH_END
            PH_BEGIN phase_even_prep(F, li); PH_END
            PH_BEGIN phase_swa(F, li, need_ctx); PH_END
            PH_BEGIN ph_gemm_res(F, MIX, (const bf16*)((const char*)wsm + W_EOUT) + (size_t)li * D * D, T, l == 0 ? inp(F, I_X) : F.out, F.out, l == 0 ? inp(F, I_CTX) : XC, XC, mod_ptr(F, l, 0) + 2 * D, (STOP_AFTER >= 2 * l + 1) ? 1.f : 0.f); PH_END
            PH_BEGIN phase_norm2_route(F, l); PH_END
            PH_BEGIN phase_moe_permute(F, l); PH_END
            PH_BEGIN ph_gemm_moe_gu(F, l); PH_END
            PH_BEGIN ph_gemm_moe_down(F, l); PH_END
        }
        {
            const int l = 2 * lp + 1, li = lp; const bool need_ctx = (l < DEPTH - 1); const int Mx = need_ctx ? T : TL;
            PH_BEGIN phase_norm1(F, l); __syncthreads(); moe_weight_convert(F, l);
                for (int t = F.vcu; t < S / 64 + (need_ctx ? CL / 64 : 0); t += F.G) { if (t < S / 64) hyena_filter_task(F, li, S, t * 64, (float*)(F.ws + A_KVU)); else hyena_filter_task(F, li, CL, (t - S / 64) * 64, (float*)(F.ws + GHC_OFF)); }
            PH_END
            PH_BEGIN ph_gemm_store(F, H, (const bf16*)((const char*)wsm + W_OIN) + (size_t)li * OD_N * D, D, D, T, OD_N, P, OD_N, nullptr); PH_END
            PH_BEGIN phase_odd_prep(F, li, need_ctx); PH_END
            PH_BEGIN ph_gemm_store(F, P + 1536, (const bf16*)((const char*)wsm + W_UQ) + (size_t)li * QU_N * 256, OD_N, 256, T, QU_N, (bf16*)(F.ws + A_QU), QU_N, (const float*)(F.ws + WS_MISC + MISC_RSTD)); PH_END_NOBAR
            PH_BEGIN ph_gemm_store(F, P + 1792, (const bf16*)((const char*)wsm + W_UKV) + (size_t)li * KVU_N * 256, OD_N, 256, T, KVU_N, (bf16*)(F.ws + A_KVU), KVU_N, (const float*)(F.ws + WS_MISC + MISC_RSTD) + T); PH_END
            PH_BEGIN phase_mla_prep(F, li); PH_END
            PH_BEGIN phase_mla(F, li, need_ctx); PH_END_NOBAR
            PH_BEGIN phase_hyena_conv(F, li, need_ctx); PH_END_NOBAR
            PH_BEGIN phase_hyena_ctx_conv(F, li, need_ctx); PH_END
            PH_BEGIN phase_hyena_gate(F, li, need_ctx); PH_END
            PH_BEGIN ph_gemm_res(F, MIX, (const bf16*)((const char*)wsm + W_OOUT) + (size_t)li * D * D, Mx, F.out, F.out, XC, XC, mod_ptr(F, l, 0) + 2 * D, (STOP_AFTER >= 2 * l + 1) ? 1.f : 0.f); PH_END
            PH_BEGIN phase_norm2_route(F, l); PH_END
            PH_BEGIN phase_moe_permute(F, l); PH_END
            PH_BEGIN ph_gemm_moe_gu(F, l); PH_END
            PH_BEGIN ph_gemm_moe_down(F, l); PH_END
        }
    }
    PH_BEGIN phase_final(F); PH_END
#undef PH_BEGIN
#undef PH_END
#undef PH_END_NOBAR
#undef wsm
#undef H
#undef P
#undef MIX
#undef XC
}
constexpr int N_PHASES = 1 + 2 * (9 + 12) + 1;

extern "C" void kernel_launch(void* const* d_in, const int* in_sizes, int n_in, void* d_out, int out_size, void* d_ws, size_t ws_size, hipStream_t stream) {
    static int grid = 0;
    if (grid == 0) {
        if (n_in != 36 || out_size != TL * D || ws_size < WS_END) { fprintf(stderr, "kernel_launch: shape mismatch: n_in %d out %d ws %zu (need %zu)\n", n_in, out_size, ws_size, (size_t)WS_END); grid = -1; return; }
        int dev = 0, cus = 0, per_cu = 0;
        if (hipGetDevice(&dev) != hipSuccess || hipDeviceGetAttribute(&cus, hipDeviceAttributeMultiprocessorCount, dev) != hipSuccess) { grid = -1; return; }
        if (hipFuncSetAttribute((const void*)mk_fwd, hipFuncAttributeMaxDynamicSharedMemorySize, LDS_BYTES) != hipSuccess) { fprintf(stderr, "kernel_launch: hipFuncSetAttribute failed\n"); grid = -1; return; }
        if (hipOccupancyMaxActiveBlocksPerMultiprocessor(&per_cu, (const void*)mk_fwd, NTHR, LDS_BYTES) != hipSuccess || per_cu < 1) fprintf(stderr, "kernel_launch: occupancy query says %d\n", per_cu);
        (void)hipGetLastError();
        grid = cus;
    }
    if (grid < 0) return;
    if (hipMemsetAsync((char*)d_ws + WS_CTL, 0, CTL_ZERO_BYTES, stream) != hipSuccess) return;
    Args a{};
    for (int i = 0; i < 36; ++i) a.in[i] = (const float*)d_in[i];
    a.out = (float*)d_out; a.ws = (unsigned char*)d_ws;
#if MK_MULTI
    for (int p = 0; p < N_PHASES; ++p) { a.ph_lo = p; a.ph_hi = p + 1; hipLaunchKernelGGL(mk_fwd, dim3(grid), dim3(NTHR), LDS_BYTES, stream, a); }
#else
    a.ph_lo = 0; a.ph_hi = N_PHASES; hipLaunchKernelGGL(mk_fwd, dim3(grid), dim3(NTHR), LDS_BYTES, stream, a);
#endif
    const hipError_t le = hipPeekAtLastError();
    if (le != hipSuccess) fprintf(stderr, "kernel_launch: launch failed: %s\n", hipGetErrorName(le));
}
```

```cpp
#include <hip/hip_runtime.h>
#include <cstdio>
#include <cstdint>

#ifndef MK_MULTI
#define MK_MULTI 0
#endif
#ifndef STOP_AFTER
#define STOP_AFTER 99
#endif

#define GAS __attribute__((address_space(1)))
#define LAS __attribute__((address_space(3)))
typedef unsigned short bf16;
typedef unsigned u32x4 __attribute__((ext_vector_type(4)));
typedef unsigned u32x2 __attribute__((ext_vector_type(2)));
typedef float f32x4 __attribute__((ext_vector_type(4)));
typedef float f32x2 __attribute__((ext_vector_type(2)));
typedef float f32x16 __attribute__((ext_vector_type(16)));
typedef short bf16x8 __attribute__((ext_vector_type(8)));
typedef short s16x4 __attribute__((ext_vector_type(4)));

constexpr int D = 1024, NB = 2, S = 16384, CL = 256, DEPTH = 4;
constexpr int TL = NB * S, TC = NB * CL, T = TL + TC;
constexpr int GRID_W = 64;
constexpr float EPS = 1e-6f;
constexpr int EV_N = 1536, OD_N = 2048  , OD_NR = 1952;
constexpr int NE = 16, FF = 512;
constexpr int HYW = 512;
constexpr int MLA_H = 8, MLA_QK = 96, MLA_V = 64, QU_N = 768, KVU_N = 1280  ;
constexpr int MOE_ROWS = 70656;
constexpr float LOG2E = 1.4426950408889634f;

constexpr size_t MiB = 1u << 20;
constexpr size_t WS_CTL = 0, CTL_ZERO_BYTES = 1 * MiB;
constexpr int CW_BAR = 4096;
constexpr int CW_CNT = 65536;
constexpr size_t WS_MISC = 1 * MiB;
constexpr size_t MISC_MOD = 0, MISC_TILEE = 512 * 1024, MISC_RSTD = 600 * 1024  ;
constexpr size_t WS_ROPE = 2 * MiB;
constexpr size_t WS_XC = 8 * MiB;
constexpr size_t WS_ROUTE = 10 * MiB;
constexpr size_t WS_WSM = 13 * MiB;
constexpr size_t W_EIN = 0, W_EOUT = W_EIN + 2 * (size_t)EV_N * D * 2, W_OIN = W_EOUT + 2 * (size_t)D * D * 2, W_OOUT = W_OIN + 2 * (size_t)OD_N * D * 2,
                 W_UQ = W_OOUT + 2 * (size_t)D * D * 2, W_UKV = W_UQ + 2 * (size_t)QU_N * 256 * 2, W_SM_END = W_UKV + 2 * (size_t)KVU_N * 256 * 2;
static_assert(W_SM_END <= 24 * MiB, "small weights");
constexpr size_t WS_WMOE = 37 * MiB;
constexpr size_t WS_H = 85 * MiB;
constexpr size_t WS_ARENA = 150 * MiB;
constexpr size_t A_P = WS_ARENA;
constexpr size_t A_MIX = A_P + 130 * MiB;
constexpr size_t A_KVU = A_MIX + 65 * MiB;
constexpr size_t A_ZY = A_KVU + 82 * MiB;
constexpr size_t A_QU = A_ZY + 32 * MiB;
constexpr size_t A_G = A_QU + 49 * MiB;
constexpr size_t WS_END = A_G + 128 * MiB;
constexpr size_t A_H2S = A_P;
constexpr size_t A_ACT = A_KVU;
constexpr size_t A_YS = A_ZY;
static_assert(A_H2S + (size_t)MOE_ROWS * 2048 <= A_KVU && A_ACT + (size_t)MOE_ROWS * 1024 <= A_ZY && A_YS + (size_t)MOE_ROWS * 2048 <= WS_END, "moe aliases");
static_assert((size_t)T * 2048 * 2 <= 130 * MiB && (size_t)T * 1280 * 2 <= 82 * MiB && (size_t)T * 768 * 2 <= 49 * MiB, "arena");

constexpr int NWAVES = 8, NTHR = 512;
constexpr int RING_BYTES = 139264 + 4096;
constexpr int LDSCTL_OFF = RING_BYTES, MISC_OFF = LDSCTL_OFF + 64;
constexpr int LDS_BYTES = 147456;
static_assert(MISC_OFF + 128 <= LDS_BYTES, "lds");

#define LDS_WAIT() asm volatile("s_waitcnt lgkmcnt(0)" ::: "memory")
#define VM_WAIT() asm volatile("s_waitcnt vmcnt(0)" ::: "memory")
__device__ __forceinline__ unsigned f2bf(float f) { unsigned u = __builtin_bit_cast(unsigned, f); return (u + 0x7fffu + ((u >> 16) & 1u)) >> 16; }
__device__ __forceinline__ unsigned pk2(float lo, float hi) { return f2bf(lo) | (f2bf(hi) << 16); }
__device__ __forceinline__ float bf2f(unsigned short h) { return __builtin_bit_cast(float, (unsigned)h << 16); }
__device__ __forceinline__ float bflo(unsigned w) { return __builtin_bit_cast(float, w << 16); }
__device__ __forceinline__ float bfhi(unsigned w) { return __builtin_bit_cast(float, w & 0xffff0000u); }
__device__ __forceinline__ float wave_sum(float v) {
#pragma unroll
    for (int o = 1; o < 64; o <<= 1) v += __shfl_xor(v, o);
    return v;
}

namespace pg8 {
#define PG8_LAS __attribute__((address_space(3)))
typedef unsigned short bf16_t;
constexpr int BM = 256, BK = 64, HALF = 128, HTB = HALF * BK * 2, STAGE_BYTES = 8 * HTB, NXCD = 8, WGM = 8;
__host__ __device__ __forceinline__ int lds_byte(int r, int c) { const int st = (r >> 4) * 2 + (c >> 5), rr = r & 15, cc = c & 31, ob = rr * 64 + cc * 2; return st * 1024 + (ob ^ (((ob >> 9) & 1) << 5)); }
__host__ __device__ __forceinline__ void stage_rc(int b, int& R, int& C) { const int st = b / 1024, sb = b % 1024, swz = sb ^ (((sb >> 9) & 1) << 5); R = (st >> 1) * 16 + swz / 64; C = (st & 1) * 32 + (swz % 64) / 2; }
__host__ __device__ __forceinline__ int perm32(int rho) { const int n = rho >> 4, i = rho & 15; return 8 * (i >> 2) + 4 * n + (i & 3); }

struct Unit { int pm, pn; };
struct Gemm { const bf16_t* A; const bf16_t* Bt; int lda, K; };

struct StaticOrder {
    int nM, nN, nwg, G, c;
    __host__ __device__ void init(int M, int N, int G_, int c_) { nM = M / BM; nN = N / BM; nwg = nM * nN; G = G_; c = c_; }
    __host__ __device__ bool next(int i, Unit& u) const {
        const long L = (long)i * G + c; if (L >= nwg) return false;
        int wgid = (int)L; { const int q = nwg / NXCD, r = nwg % NXCD, xcd = wgid % NXCD, off = wgid / NXCD; wgid = (xcd < r ? xcd * (q + 1) : r * (q + 1) + (xcd - r) * q) + off; }
        const int nig = WGM * nN, gid = wgid / nig, fm = gid * WGM, gsz = (nM - fm) < WGM ? (nM - fm) : WGM;
        u.pm = fm + ((wgid % nig) % gsz); u.pn = (wgid % nig) / gsz; return true;
    }
    __device__ __forceinline__ size_t b_off(const Unit& u, int K) const { return (size_t)u.pn * BM * K * 2; }
};
struct MoeOrder {
    const int* tile_e; int ntiles, nN, G, c;
    __device__ bool next(int i, Unit& u) const { const long L = (long)i * G + c; if (L >= (long)ntiles * nN) return false; u.pm = (int)(L / nN); u.pn = (int)(L % nN); return true; }
    __device__ __forceinline__ size_t b_off(const Unit& u, int K) const { const int e = __builtin_amdgcn_readfirstlane(tile_e[u.pm]); return ((size_t)e * nN + u.pn) * BM * K * 2; }
};

__device__ __forceinline__ unsigned cvt_pk_bf16(float lo, float hi) { unsigned r; asm volatile("v_cvt_pk_bf16_f32 %0, %1, %2" : "=v"(r) : "v"(lo), "v"(hi)); return r; }

struct EpiStoreBf16 {
    static constexpr bool PERM = true;
    bf16_t* O; int ldc; const float* rowscale;
    __device__ __forceinline__ void operator()(const f32x4 (&acc)[2][2][4][2], const Unit& u, int wr, int wc, int fr, int fq) const {
        const int row0 = u.pm * BM + wr * 64 + fr, col0 = u.pn * BM + wc * 32 + 8 * fq;
#pragma unroll
        for (int ai = 0; ai < 2; ++ai)
#pragma unroll
            for (int m = 0; m < 4; ++m) { const int row = row0 + ai * HALF + m * 16; bf16_t* rowp = O + (size_t)row * ldc + col0; const float sc = rowscale ? rowscale[row] : 1.f;
#pragma unroll
                for (int bj = 0; bj < 2; ++bj) { f32x4 v0 = acc[ai][bj][m][0] * sc, v1 = acc[ai][bj][m][1] * sc;
                    u32x4 w; w.x = cvt_pk_bf16(v0[0], v0[1]); w.y = cvt_pk_bf16(v0[2], v0[3]); w.z = cvt_pk_bf16(v1[0], v1[1]); w.w = cvt_pk_bf16(v1[2], v1[3]);
                    *(u32x4*)(rowp + bj * HALF) = w; } }
    }
};
struct EpiSwiglu {
    static constexpr bool PERM = true;
    bf16_t* O;
    __device__ __forceinline__ void operator()(const f32x4 (&acc)[2][2][4][2], const Unit& u, int wr, int wc, int fr, int fq) const {
        const int row0 = u.pm * BM + wr * 64 + fr, col0 = u.pn * HALF + wc * 32 + 8 * fq;
#pragma unroll
        for (int ai = 0; ai < 2; ++ai)
#pragma unroll
            for (int m = 0; m < 4; ++m) { bf16_t* rowp = O + (size_t)(row0 + ai * HALF + m * 16) * FF + col0; float o[8];
#pragma unroll
                for (int n = 0; n < 2; ++n)
#pragma unroll
                    for (int j = 0; j < 4; ++j) { const float g = acc[ai][0][m][n][j], up = acc[ai][1][m][n][j]; o[4 * n + j] = g * __builtin_amdgcn_rcpf(1.f + __expf(-g)) * up; }
                u32x4 w; w.x = cvt_pk_bf16(o[0], o[1]); w.y = cvt_pk_bf16(o[2], o[3]); w.z = cvt_pk_bf16(o[4], o[5]); w.w = cvt_pk_bf16(o[6], o[7]);
                *(u32x4*)rowp = w; }
    }
};
struct EpiResidual {
    static constexpr bool PERM = false;
    const float* srcL; float* dstL; const float* srcC; float* dstC; const float* gate; float on;
    __device__ __forceinline__ void operator()(const f32x4 (&acc)[2][2][4][2], const Unit& u, int wr, int wc, int fr, int fq) const {
        const int row0 = u.pm * BM + wr * 64 + fr, col0 = u.pn * BM + wc * 32 + 4 * fq;
        const bool lat = (u.pm * BM) < TL; const int mrow = lat ? (u.pm * BM) / S : 2;
        const float* gp = gate + (size_t)mrow * 6 * D + col0;
        f32x4 gv[2][2];
#pragma unroll
        for (int bj = 0; bj < 2; ++bj)
#pragma unroll
            for (int n = 0; n < 2; ++n) gv[bj][n] = *(const f32x4*)(gp + bj * HALF + n * 16) * on;
        const float* sb = lat ? srcL : srcC - (size_t)TL * D; float* db = lat ? dstL : dstC - (size_t)TL * D;
#pragma unroll
        for (int ai = 0; ai < 2; ++ai)
#pragma unroll
            for (int m = 0; m < 4; ++m) { const size_t ro = (size_t)(row0 + ai * HALF + m * 16) * D + col0;
#pragma unroll
                for (int bj = 0; bj < 2; ++bj)
#pragma unroll
                    for (int n = 0; n < 2; ++n) { const f32x4 xv = *(const f32x4*)(sb + ro + bj * HALF + n * 16); *(f32x4*)(db + ro + bj * HALF + n * 16) = xv + gv[bj][n] * acc[ai][bj][m][n]; } }
    }
};

template <class Epi, class Sched, bool ALIGN_EPI = true>
__device__ __forceinline__ void gemm_phase(PG8_LAS unsigned char* lds, const Gemm g, const Sched& S_, const Epi& E, const int tid) {
    const int wid = __builtin_amdgcn_readfirstlane(tid >> 6), lane = tid & 63, wr = wid >> 2, wc = wid & 3, fr = lane & 15, fq = lane >> 4;
    const int K = g.K, lda = g.lda, nt = K / BK;
    unsigned voffA[2], voffB[2];
#pragma unroll
    for (int i = 0; i < 2; ++i) { int R, C; stage_rc(tid * 16 + i * 8192, R, C); const int Rb = Epi::PERM ? ((R & ~31) + perm32(R & 31)) : R;
        voffA[i] = (unsigned)(R * lda + C) * 2u; voffB[i] = (unsigned)(Rb * K + C) * 2u; }
    const size_t kstep = (size_t)(BK * 2);
    const size_t hsA = (size_t)HALF * lda * 2, hsB = (size_t)HALF * K * 2;
    const size_t tstepA = 2 * hsA;
    const unsigned ldsw = (unsigned)wid * 1024u;
    const int aoff = lds_byte(wr * 64 + fr, fq * 8), boff = lds_byte(wc * 32 + fr, fq * 8);
#define PG8_SA(b, h) (((b) * 2 + (h)) * HTB)
#define PG8_SB(b, h) ((4 + (b) * 2 + (h)) * HTB)
#define PG8_STAGE(bufoff, gbase, voff) do { _Pragma("unroll") for (int _i = 0; _i < 2; ++_i) \
        __builtin_amdgcn_global_load_lds((const unsigned*)((const char*)(gbase) + (voff)[_i]), (PG8_LAS unsigned*)(lds + (bufoff) + ldsw + _i * 8192), 16, 0, 0); } while (0)
#define PG8_LDA(dst, b, h) do { _Pragma("unroll") for (int m = 0; m < 4; ++m) _Pragma("unroll") for (int k = 0; k < 2; ++k) dst[m][k] = *(const PG8_LAS bf16x8*)(lds + PG8_SA(b, h) + aoff + m * 2048 + k * 1024); } while (0)
#define PG8_LDB(dst, b, h) do { _Pragma("unroll") for (int n = 0; n < 2; ++n) _Pragma("unroll") for (int k = 0; k < 2; ++k) dst[n][k] = *(const PG8_LAS bf16x8*)(lds + PG8_SB(b, h) + boff + n * 2048 + k * 1024); } while (0)
#define PG8_MMA(ai, bj, At, Bt) do { __builtin_amdgcn_s_setprio(1); _Pragma("unroll") for (int m = 0; m < 4; ++m) _Pragma("unroll") for (int n = 0; n < 2; ++n) _Pragma("unroll") for (int k = 0; k < 2; ++k) \
        acc[ai][bj][m][n] = __builtin_amdgcn_mfma_f32_16x16x32_bf16(Bt[n][k], At[m][k], acc[ai][bj][m][n], 0, 0, 0); __builtin_amdgcn_s_setprio(0); } while (0)
#define PG8_WAIT_V(n) asm volatile("s_waitcnt vmcnt(" #n ")" ::: "memory")
#define PG8_WAIT_L(n) asm volatile("s_waitcnt lgkmcnt(" #n ")" ::: "memory")
#define PG8_BAR __builtin_amdgcn_s_barrier()
#define PG8_SCHED __builtin_amdgcn_sched_barrier(0)
    Unit cur, nxt; int ui = 0;
    if (!S_.next(0, cur)) return;
    f32x4 acc[2][2][4][2];
#pragma unroll
    for (int a = 0; a < 2; ++a)
#pragma unroll
        for (int b = 0; b < 2; ++b)
#pragma unroll
            for (int m = 0; m < 4; ++m)
#pragma unroll
                for (int n = 0; n < 2; ++n) acc[a][b][m][n] = (f32x4){0.f, 0.f, 0.f, 0.f};
    bf16x8 At[4][2], B0[2][2], B1[2][2];
    const char* cA = (const char*)g.A + (size_t)cur.pm * tstepA; const char* cB = (const char*)g.Bt + S_.b_off(cur, K);
    PG8_STAGE(PG8_SB(0, 0), cB, voffB); PG8_STAGE(PG8_SB(0, 1), cB + hsB, voffB); PG8_STAGE(PG8_SA(0, 0), cA, voffA); PG8_STAGE(PG8_SA(0, 1), cA + hsA, voffA);
    if (wr == 1) PG8_BAR;
    PG8_WAIT_V(2); PG8_BAR;
    PG8_STAGE(PG8_SB(1, 0), cB + kstep, voffB); PG8_STAGE(PG8_SA(1, 0), cA + kstep, voffA); PG8_STAGE(PG8_SB(1, 1), cB + hsB + kstep, voffB);
    PG8_WAIT_V(6); PG8_BAR;
    for (;;) {
        const bool has_next = S_.next(ui + 1, nxt);
        const char* nA = has_next ? (const char*)g.A + (size_t)nxt.pm * tstepA : cA; const char* nB = has_next ? (const char*)g.Bt + S_.b_off(nxt, K) : cB;
        for (int t = 0; t < nt; t += 2) {
            const bool last = (t == nt - 2);
            const char* a1 = cA + (size_t)(t + 1) * kstep;
            const char* a2 = last ? nA : cA + (size_t)(t + 2) * kstep; const char* b2 = last ? nB : cB + (size_t)(t + 2) * kstep;
            const char* a3 = a2 + kstep; const char* b3 = b2 + kstep;
            PG8_LDB(B0, 0, 0); PG8_LDB(B1, 0, 1); PG8_SCHED; PG8_LDA(At, 0, 0); PG8_STAGE(PG8_SA(1, 1), a1 + hsA, voffA);
            PG8_WAIT_V(8); PG8_WAIT_L(0); PG8_BAR; PG8_MMA(0, 0, At, B0); PG8_MMA(0, 1, At, B1); PG8_BAR; PG8_SCHED;
            PG8_LDA(At, 0, 1); PG8_STAGE(PG8_SB(0, 0), b2, voffB); PG8_STAGE(PG8_SB(0, 1), b2 + hsB, voffB); PG8_STAGE(PG8_SA(0, 0), a2, voffA);
            PG8_WAIT_V(8); PG8_WAIT_L(0); PG8_BAR; PG8_MMA(1, 0, At, B0); PG8_MMA(1, 1, At, B1); PG8_BAR; PG8_SCHED;
            PG8_LDB(B0, 1, 0); PG8_LDB(B1, 1, 1); PG8_SCHED; PG8_LDA(At, 1, 0); PG8_STAGE(PG8_SA(0, 1), a2 + hsA, voffA);
            PG8_WAIT_V(8); PG8_WAIT_L(0); PG8_BAR; PG8_MMA(0, 0, At, B0); PG8_MMA(0, 1, At, B1); PG8_BAR; PG8_SCHED;
            PG8_LDA(At, 1, 1); PG8_STAGE(PG8_SB(1, 0), b3, voffB); PG8_STAGE(PG8_SB(1, 1), b3 + hsB, voffB); PG8_STAGE(PG8_SA(1, 0), a3, voffA);
            PG8_WAIT_V(8); PG8_WAIT_L(0); PG8_BAR; PG8_MMA(1, 0, At, B0); PG8_MMA(1, 1, At, B1); PG8_BAR; PG8_SCHED;
        }
        if constexpr (ALIGN_EPI) { if (wr == 0) PG8_BAR; }
        E(acc, cur, wr, wc, fr, fq);
        if (!has_next) break;
#pragma unroll
        for (int a = 0; a < 2; ++a)
#pragma unroll
            for (int b = 0; b < 2; ++b)
#pragma unroll
                for (int m = 0; m < 4; ++m)
#pragma unroll
                    for (int n = 0; n < 2; ++n) acc[a][b][m][n] = (f32x4){0.f, 0.f, 0.f, 0.f};
        cur = nxt; cA = nA; cB = nB; ++ui;
        if constexpr (ALIGN_EPI) { if (wr == 1) PG8_BAR; }
    }
    PG8_WAIT_V(0);
    if constexpr (!ALIGN_EPI) { if (wr == 0) PG8_BAR; }
    PG8_BAR;
#undef PG8_SA
#undef PG8_SB
#undef PG8_STAGE
#undef PG8_LDA
#undef PG8_LDB
#undef PG8_MMA
#undef PG8_WAIT_V
#undef PG8_WAIT_L
#undef PG8_BAR
#undef PG8_SCHED
}
}

#define XB_TMO      128
#define XB_XCNT(j)  (256  + 64 * (j))
#define XB_XSUB(j)  (1280 + 64 * (j))
#define XB_XGEN(j)  (2304 + 64 * (j))
#define XB_TOP      3328
#define XB_TOPGEN   3392
#define XCD_BAR_WORDS 3456
#define XB_SPIN_CAP (1u << 20)
__device__ __forceinline__ unsigned xb_ld(unsigned* p)              { return __hip_atomic_load(p, __ATOMIC_RELAXED, __HIP_MEMORY_SCOPE_AGENT); }
__device__ __forceinline__ unsigned xb_add(unsigned* p, unsigned v) { return __hip_atomic_fetch_add(p, v, __ATOMIC_RELAXED, __HIP_MEMORY_SCOPE_AGENT); }
__device__ __forceinline__ unsigned xb_xcc_id() { return (unsigned)__builtin_amdgcn_s_getreg((3 << 11) | 20) & 0xFu; }
#define XB_SPIN(cond, bar) do { unsigned _sp = 0; while (cond) { __builtin_amdgcn_s_sleep(1); \
    if ((++_sp & 255u) == 0u) { if (xb_ld(&(bar)[XB_TMO])) break; if (_sp > XB_SPIN_CAP) { atomicAdd(&(bar)[XB_TMO], 1u); break; } } } } while (0)
struct XcdBarrier { unsigned* bar; unsigned x; volatile LAS unsigned* st; };
__device__ __forceinline__ XcdBarrier xcd_barrier_post(unsigned* bar, volatile LAS unsigned* st) {
    XcdBarrier b; b.bar = bar; b.x = xb_xcc_id(); b.st = st;
    if (threadIdx.x == 0) (void)xb_add(&bar[XB_XCNT(b.x)], 1u);
    return b;
}
__device__ __forceinline__ void xcd_barrier_complete(unsigned* bar, unsigned x, unsigned& nloc, unsigned& nx) {
    const unsigned G = gridDim.x * gridDim.y * gridDim.z;
    unsigned sum, cnt, mine, sp = 0u;
    for (;;) {
        sum = 0u; cnt = 0u; mine = 0u;
#pragma unroll
        for (unsigned j = 0; j < 16; ++j) { const unsigned c = xb_ld(&bar[XB_XCNT(j)]); sum += c; cnt += (c > 0u) ? 1u : 0u; mine = (j == x) ? c : mine; }
        if (sum == G) break;
        __builtin_amdgcn_s_sleep(1);
        if ((++sp & 255u) == 0u) { if (xb_ld(&bar[XB_TMO])) break; if (sp > XB_SPIN_CAP) { atomicAdd(&bar[XB_TMO], 1u); break; } }
    }
    nloc = mine > 0u ? mine : 1u; nx = cnt > 0u ? cnt : 1u;
}
__device__ __forceinline__ void xcd_barrier(const XcdBarrier& b) {
    asm volatile("s_waitcnt vmcnt(0)" ::: "memory");
    __syncthreads();
    if (threadIdx.x == 0) {
        unsigned* bar = b.bar;
        __builtin_amdgcn_s_waitcnt(0);
        unsigned nloc = b.st[0], nx = b.st[1];
        if (nloc == 0u) { xcd_barrier_complete(bar, b.x, nloc, nx); b.st[0] = nloc; b.st[1] = nx; }
        const unsigned old = xb_add(&bar[XB_XSUB(b.x)], 1u);
        const unsigned gen = old / nloc;
        if (old + 1u == (gen + 1u) * nloc) {
            __builtin_amdgcn_fence(__ATOMIC_RELEASE, "agent");
            asm volatile("s_waitcnt vmcnt(0)" ::: "memory");
            const unsigned og = xb_add(&bar[XB_TOP], 1u);
            const unsigned tg = og / nx;
            if (og + 1u == (tg + 1u) * nx) xb_add(&bar[XB_TOPGEN], 1u);
            else XB_SPIN(xb_ld(&bar[XB_TOPGEN]) == tg, bar);
            __builtin_amdgcn_fence(__ATOMIC_ACQUIRE, "agent");
            xb_add(&bar[XB_XGEN(b.x)], 1u);
            asm volatile("s_waitcnt vmcnt(0)" ::: "memory");
        } else {
            XB_SPIN(xb_ld(&bar[XB_XGEN(b.x)]) == gen, bar);
            __builtin_amdgcn_fence(__ATOMIC_ACQUIRE, "agent");
            asm volatile("s_waitcnt vmcnt(0)" ::: "memory");
        }
    }
    __syncthreads();
}

struct Args { const float* in[36]; float* out; unsigned char* ws; int ph_lo, ph_hi; };
struct Frame {
    LAS unsigned char* lds;
    const LAS unsigned long long* in; float* out; unsigned char* ws;
    int tid, lane, wave, vcu, G, gw, NGW, bx;
};
enum { I_X = 0, I_C, I_CTX, I_CCTX, I_ADAW, I_ADAB, I_NORMG, I_EVWIN, I_EVWOUT, I_POOLW, I_POOLS, I_SWAQG, I_SWAKG, I_SINK, I_ODWIN, I_ODWOUT, I_HYCW, I_HYCB,
       I_HYW1, I_HYB1, I_HYW2, I_HYB2, I_HYW3, I_HYFREQ, I_HYSKIP, I_CQG, I_CKVG, I_WUQ, I_WUKV, I_MQG, I_MKG, I_RW, I_RB, I_MG, I_MU, I_MD };

__device__ __forceinline__ const float* inp(const Frame& F, int i) { const unsigned long long v = F.in[i];
    const unsigned lo = __builtin_amdgcn_readfirstlane((unsigned)v), hi = __builtin_amdgcn_readfirstlane((unsigned)(v >> 32)); return (const float*)(((unsigned long long)hi << 32) | lo); }
__device__ __forceinline__ float* mod_ptr(const Frame& F, int l, int m) { return (float*)(F.ws + WS_MISC + MISC_MOD) + ((size_t)l * 3 + m) * 6 * D; }
__device__ __forceinline__ int* tile_e_ptr(const Frame& F, int l) { return (int*)(F.ws + WS_MISC + MISC_TILEE) + l * 288; }
__device__ __forceinline__ unsigned* cnt_ptr(const Frame& F, int l) { return (unsigned*)(F.ws + WS_CTL) + CW_CNT + 64 * l; }
__device__ __forceinline__ const float* xsrc_row(const Frame& F, int l, int r) {
    if (r < TL) return (l == 0 ? inp(F, I_X) : F.out) + (size_t)r * D;
    return (l == 0 ? inp(F, I_CTX) : (const float*)(F.ws + WS_XC)) + (size_t)(r - TL) * D;
}
__device__ __forceinline__ float* xdst_row(const Frame& F, int r) { return r < TL ? F.out + (size_t)r * D : (float*)(F.ws + WS_XC) + (size_t)(r - TL) * D; }

template <class RowMap>
__device__ __forceinline__ void tr_item(const float* W, int N, bf16* WT, int Kd, int k0, int n0, LAS float* scr, int lane, RowMap rm) {
#pragma unroll 8
    for (int i = 0; i < 32; ++i) { const int kk = 2 * i + (lane >> 5); scr[kk * 33 + (lane & 31)] = W[(size_t)(k0 + kk) * N + n0 + (lane & 31)]; }
    LDS_WAIT(); asm volatile("" ::: "memory");
    const int c = lane & 7;
#pragma unroll
    for (int j = 0; j < 4; ++j) { const int n = (lane >> 3) + 8 * j; const LAS float* s = scr + (8 * c) * 33 + n;
        u32x4 o; o.x = pk2(s[0 * 33], s[1 * 33]); o.y = pk2(s[2 * 33], s[3 * 33]); o.z = pk2(s[4 * 33], s[5 * 33]); o.w = pk2(s[6 * 33], s[7 * 33]);
        *(u32x4*)(WT + (size_t)rm(n0 + n) * Kd + k0 + 8 * c) = o; }
    LDS_WAIT(); asm volatile("" ::: "memory");
}
struct RmId { __device__ __forceinline__ int operator()(int n) const { return n; } };
struct RmGate { int add; __device__ __forceinline__ int operator()(int n) const { return 256 * (n >> 7) + add + (n & 127); } };

__device__ __forceinline__ float silu_f(float v) { return v / (1.f + __expf(-v)); }

__device__ __forceinline__ void phase_prologue(Frame& F) {
    LAS float* scr = (LAS float*)(F.lds + F.wave * 16384);
    bf16* wsm = (bf16*)(F.ws + WS_WSM);
    {
        constexpr int I_EI = 16 * 48, I_EO = 16 * 32, I_OI = 16 * 61, I_OO = 16 * 32, PER = I_EI + I_EO + I_OI + I_OO;
        for (int it = F.gw; it < 2 * PER; it += F.NGW) {
            const int i = it / PER; int r = it % PER;
            if (r < I_EI) { tr_item(inp(F, I_EVWIN) + (size_t)i * D * EV_N, EV_N, (bf16*)((char*)wsm + W_EIN) + (size_t)i * EV_N * D, D, 64 * (r / 48), 32 * (r % 48), scr, F.lane, RmId{}); continue; } r -= I_EI;
            if (r < I_EO) { tr_item(inp(F, I_EVWOUT) + (size_t)i * D * D, D, (bf16*)((char*)wsm + W_EOUT) + (size_t)i * D * D, D, 64 * (r / 32), 32 * (r % 32), scr, F.lane, RmId{}); continue; } r -= I_EO;
            if (r < I_OI) { tr_item(inp(F, I_ODWIN) + (size_t)i * D * OD_NR, OD_NR, (bf16*)((char*)wsm + W_OIN) + (size_t)i * OD_N * D, D, 64 * (r / 61), 32 * (r % 61), scr, F.lane, RmId{}); continue; } r -= I_OI;
            tr_item(inp(F, I_ODWOUT) + (size_t)i * D * D, D, (bf16*)((char*)wsm + W_OOUT) + (size_t)i * D * D, D, 64 * (r / 32), 32 * (r % 32), scr, F.lane, RmId{});
        }
    }
    const int gt = F.gw * 64 + F.lane, NGT = F.NGW * 64;
    for (int idx = gt; idx < 2 * 96 * (D / 8); idx += NGT) { const int i = idx / (96 * (D / 8)), r = idx % (96 * (D / 8));
        *(u32x4*)((bf16*)((char*)wsm + W_OIN) + (size_t)i * OD_N * D + (size_t)(OD_NR + r / (D / 8)) * D + 8 * (r % (D / 8))) = (u32x4){0u, 0u, 0u, 0u}; }
    for (int idx = gt; idx < 2 * QU_N * 32; idx += NGT) { const int i = idx / (QU_N * 32), r = idx % (QU_N * 32), n = r / 32, kc = r % 32;
        const float* W = inp(F, I_WUQ) + (size_t)i * 256 * QU_N; const float* gn = inp(F, I_CQG) + i * 256; float v[8];
#pragma unroll
        for (int j = 0; j < 8; ++j) v[j] = W[(size_t)(8 * kc + j) * QU_N + n] * gn[8 * kc + j];
        *(u32x4*)((bf16*)((char*)wsm + W_UQ) + (size_t)i * QU_N * 256 + (size_t)n * 256 + 8 * kc) = (u32x4){pk2(v[0], v[1]), pk2(v[2], v[3]), pk2(v[4], v[5]), pk2(v[6], v[7])}; }
    for (int idx = gt; idx < 2 * KVU_N * 32; idx += NGT) { const int i = idx / (KVU_N * 32), r = idx % (KVU_N * 32), n = r / 32, kc = r % 32, h = n / 160, j = n % 160;
        const float* W = inp(F, I_WUKV) + (size_t)i * 128 * 1024; const float* gn = inp(F, I_CKVG) + i * 128; float v[8];
        const bool z = (kc >= 16) || (j >= 64 && j < 96); const int col = h * 128 + (j < 64 ? j : j - 32);
#pragma unroll
        for (int jj = 0; jj < 8; ++jj) v[jj] = z ? 0.f : W[(size_t)(8 * kc + jj) * 1024 + col] * gn[8 * kc + jj];
        *(u32x4*)((bf16*)((char*)wsm + W_UKV) + (size_t)i * KVU_N * 256 + (size_t)n * 256 + 8 * kc) = (u32x4){pk2(v[0], v[1]), pk2(v[2], v[3]), pk2(v[4], v[5]), pk2(v[6], v[7])}; }
    { f32x2* r64 = (f32x2*)(F.ws + WS_ROPE); f32x2* r32 = r64 + (size_t)S * 32;
      for (int idx = gt; idx < S * 32; idx += NGT) { const int s = idx >> 5, i = idx & 31; const float pos = (float)(i < 16 ? s / GRID_W : s % GRID_W);
          const float inv = powf(10000.f, -(float)(i & 15) / 16.f); float sn, cs; sincosf(pos * inv, &sn, &cs); r64[idx] = (f32x2){cs, sn}; }
      for (int idx = gt; idx < S * 16; idx += NGT) { const int s = idx >> 4, i = idx & 15; const float pos = (float)(i < 8 ? s / GRID_W : s % GRID_W);
          const float inv = powf(10000.f, -(float)(i & 7) / 8.f); float sn, cs; sincosf(pos * inv, &sn, &cs); r32[idx] = (f32x2){cs, sn}; } }
    if (F.bx < 96) {
        __syncthreads();
        LAS float* sl = (LAS float*)(F.lds);
        LAS float* red = (LAS float*)(F.lds + 16384);
        for (int i = F.tid; i < 3 * D; i += NTHR) { const int m = i / D, k = i % D; sl[i] = silu_f(m < 2 ? inp(F, I_C)[m * D + k] : inp(F, I_CCTX)[k]); }
        __syncthreads();
        const int l = F.bx / 24, j0 = (F.bx % 24) * 256 + 4 * F.lane;
        const float* W = inp(F, I_ADAW) + (size_t)l * D * 6 * D + j0;
        f32x4 a0 = {0.f, 0.f, 0.f, 0.f}, a1 = a0, a2 = a0;
#pragma unroll 8
        for (int k = F.wave * 128; k < F.wave * 128 + 128; ++k) { const f32x4 w = *(const f32x4*)(W + (size_t)k * 6 * D); a0 += w * sl[k]; a1 += w * sl[D + k]; a2 += w * sl[2 * D + k]; }
        *(LAS f32x4*)(red + (F.wave * 3 + 0) * 256 + 4 * F.lane) = a0; *(LAS f32x4*)(red + (F.wave * 3 + 1) * 256 + 4 * F.lane) = a1; *(LAS f32x4*)(red + (F.wave * 3 + 2) * 256 + 4 * F.lane) = a2;
        __syncthreads();
        for (int i = F.tid; i < 3 * 256; i += NTHR) { const int m = i / 256, jj = i % 256; float s = inp(F, I_ADAB)[l * 6 * D + (F.bx % 24) * 256 + jj];
#pragma unroll
            for (int w = 0; w < 8; ++w) s += red[(w * 3 + m) * 256 + jj];
            mod_ptr(F, l, m)[(F.bx % 24) * 256 + jj] = s; }
        __syncthreads();
    }
}

__device__ __forceinline__ void moe_weight_convert(Frame& F, int l) {
    LAS float* scr = (LAS float*)(F.lds + F.wave * 16384);
    bf16* wgu = (bf16*)(F.ws + WS_WMOE); bf16* wd = wgu + (size_t)NE * 1024 * 1024;
    for (int it = F.gw; it < NE * 3 * 256; it += F.NGW) {
        const int e = it / 768, r = it % 768, which = r / 256, q = r % 256;
        if (which == 0)      tr_item(inp(F, I_MG) + ((size_t)l * NE + e) * D * FF, FF, wgu + (size_t)e * 1024 * 1024, D, 64 * (q / 16), 32 * (q % 16), scr, F.lane, RmGate{0});
        else if (which == 1) tr_item(inp(F, I_MU) + ((size_t)l * NE + e) * D * FF, FF, wgu + (size_t)e * 1024 * 1024, D, 64 * (q / 16), 32 * (q % 16), scr, F.lane, RmGate{128});
        else                 tr_item(inp(F, I_MD) + ((size_t)l * NE + e) * FF * D, D, wd + (size_t)e * 1024 * FF, FF, 64 * (q / 32), 32 * (q % 32), scr, F.lane, RmId{});
    }
}

__device__ __forceinline__ void moe_combine_row(const Frame& F, int lp, int r, f32x4 (&v)[4]) {
    const int2 pos = ((const int2*)(F.ws + WS_ROUTE + 1 * MiB))[r]; const f32x2 w = ((const f32x2*)(F.ws + WS_ROUTE + 600 * 1024))[r];
    const bf16* ys = (const bf16*)(F.ws + A_YS); const float* g2 = mod_ptr(F, lp, r < TL ? r / S : 2) + 5 * D;
#pragma unroll
    for (int j = 0; j < 4; ++j) { const int c = 4 * F.lane + 256 * j;
        const u32x2 y0 = *(const u32x2*)(ys + (size_t)pos.x * D + c), y1 = *(const u32x2*)(ys + (size_t)pos.y * D + c); const f32x4 g = *(const f32x4*)(g2 + c);
        v[j].x += g.x * (w.x * bflo(y0.x) + w.y * bflo(y1.x)); v[j].y += g.y * (w.x * bfhi(y0.x) + w.y * bfhi(y1.x));
        v[j].z += g.z * (w.x * bflo(y0.y) + w.y * bflo(y1.y)); v[j].w += g.w * (w.x * bfhi(y0.y) + w.y * bfhi(y1.y)); }
}
__device__ __forceinline__ float row_rstd(const f32x4 (&v)[4]) {
    float s = 0.f;
#pragma unroll
    for (int j = 0; j < 4; ++j) s += (v[j].x * v[j].x + v[j].y * v[j].y) + (v[j].z * v[j].z + v[j].w * v[j].w);
    return 1.f / sqrtf(wave_sum(s) * (1.f / D) + EPS);
}
__device__ __forceinline__ void modulate_row(const Frame& F, int l, int which, int r, const f32x4 (&v)[4], float rstd, f32x4 (&h)[4]) {
    const float* gn = inp(F, I_NORMG) + ((size_t)l * 2 + which) * D; const float* mp = mod_ptr(F, l, r < TL ? r / S : 2) + (which ? 3 : 0) * D;
#pragma unroll
    for (int j = 0; j < 4; ++j) { const int c = 4 * F.lane + 256 * j; const f32x4 g = *(const f32x4*)(gn + c), sh = *(const f32x4*)(mp + c), sc = *(const f32x4*)(mp + D + c);
        h[j] = v[j] * rstd * g * (sc + 1.f) + sh; }
}
__device__ __forceinline__ void store_row_bf16(bf16* dst, int lane, const f32x4 (&h)[4]) {
#pragma unroll
    for (int j = 0; j < 4; ++j) *(u32x2*)(dst + 4 * lane + 256 * j) = (u32x2){pk2(h[j].x, h[j].y), pk2(h[j].z, h[j].w)};
}
__device__ __forceinline__ void phase_norm1(Frame& F, int l) {
    bf16* H = (bf16*)(F.ws + WS_H);
    for (int r = F.gw; r < T; r += F.NGW) {
        const float* xs = xsrc_row(F, l, r); f32x4 v[4];
#pragma unroll
        for (int j = 0; j < 4; ++j) v[j] = *(const f32x4*)(xs + 4 * F.lane + 256 * j);
        if (l > 0) { if (STOP_AFTER >= 2 * l) moe_combine_row(F, l - 1, r, v); float* xd = xdst_row(F, r);
#pragma unroll
            for (int j = 0; j < 4; ++j) *(f32x4*)(xd + 4 * F.lane + 256 * j) = v[j]; }
        const float rstd = row_rstd(v); f32x4 h[4]; modulate_row(F, l, 0, r, v, rstd, h);
        store_row_bf16(H + (size_t)r * D, F.lane, h);
    }
}
__device__ __forceinline__ void phase_final(Frame& F) {
    for (int r = F.gw; r < TL; r += F.NGW) {
        float* xd = F.out + (size_t)r * D; f32x4 v[4];
#pragma unroll
        for (int j = 0; j < 4; ++j) v[j] = *(const f32x4*)(xd + 4 * F.lane + 256 * j);
        if (STOP_AFTER >= 8) moe_combine_row(F, 3, r, v);
#pragma unroll
        for (int j = 0; j < 4; ++j) *(f32x4*)(xd + 4 * F.lane + 256 * j) = v[j];
    }
}

__device__ __forceinline__ void phase_norm2_route(Frame& F, int l) {
    bf16* H = (bf16*)(F.ws + WS_H);
    LAS float* rw = (LAS float*)F.lds;
    for (int i = F.tid; i < D * NE; i += NTHR) { const int k = i / NE, e = i % NE; rw[e * D + k] = inp(F, I_RW)[i]; }
    __syncthreads();
    const int Tm = (l < DEPTH - 1) ? T : TL;
    unsigned* cnt = cnt_ptr(F, l);
    int4* route_i = (int4*)(F.ws + WS_ROUTE); f32x2* route_w = (f32x2*)(F.ws + WS_ROUTE + 600 * 1024);
    for (int r = F.gw; r < Tm; r += F.NGW) {
        const float* xs = xdst_row(F, r); f32x4 v[4];
#pragma unroll
        for (int j = 0; j < 4; ++j) v[j] = *(const f32x4*)(xs + 4 * F.lane + 256 * j);
        const float rstd = row_rstd(v); f32x4 h[4]; modulate_row(F, l, 1, r, v, rstd, h);
        store_row_bf16(H + (size_t)r * D, F.lane, h);
        float lg[NE];
#pragma unroll
        for (int e = 0; e < NE; ++e) { float s = 0.f; asm volatile("" ::: "memory");
#pragma unroll
            for (int j = 0; j < 4; ++j) { const f32x4 w = *(const LAS f32x4*)(rw + e * D + 4 * F.lane + 256 * j); s += (h[j].x * w.x + h[j].y * w.y) + (h[j].z * w.z + h[j].w * w.w); }
            lg[e] = wave_sum(s); }
        float sc[NE], bi[NE];
#pragma unroll
        for (int e = 0; e < NE; ++e) { sc[e] = 1.f / (1.f + expf(-lg[e])); bi[e] = sc[e] + inp(F, I_RB)[e]; }
        int sel = 0; float best = -INFINITY;
#pragma unroll
        for (int g = 0; g < 4; ++g) { float m1 = -INFINITY, m2 = -INFINITY;
#pragma unroll
            for (int i = 0; i < 4; ++i) { const float b = bi[4 * g + i]; if (b > m1) { m2 = m1; m1 = b; } else if (b > m2) m2 = b; }
            const float gs = m1 + m2; if (gs > best) { best = gs; sel = g; } }
        float b4[4], s4[4];
#pragma unroll
        for (int i = 0; i < 4; ++i) { b4[i] = bi[0 + i]; s4[i] = sc[0 + i]; }
#pragma unroll
        for (int g = 1; g < 4; ++g) if (sel == g) {
#pragma unroll
            for (int i = 0; i < 4; ++i) { b4[i] = bi[4 * g + i]; s4[i] = sc[4 * g + i]; } }
        int i0 = 0; float v0 = b4[0], w0 = s4[0];
#pragma unroll
        for (int i = 1; i < 4; ++i) if (b4[i] > v0) { v0 = b4[i]; w0 = s4[i]; i0 = i; }
        int i1 = 0; float v1 = -INFINITY, w1 = 0.f;
#pragma unroll
        for (int i = 0; i < 4; ++i) if (i != i0 && b4[i] > v1) { v1 = b4[i]; w1 = s4[i]; i1 = i; }
        const float ws_ = 1.f / (w0 + w1);
        if (F.lane == 0) { const int e0 = 4 * sel + i0, e1 = 4 * sel + i1;
            const int r0 = (int)atomicAdd(&cnt[e0], 1u), r1 = (int)atomicAdd(&cnt[e1], 1u);
            route_i[r] = make_int4(e0, r0, e1, r1); route_w[r] = (f32x2){w0 * ws_, w1 * ws_}; }
    }
    __syncthreads();
}
__device__ __forceinline__ int moe_offsets(const Frame& F, int l, int (&off)[NE]) {
    const unsigned* cnt = cnt_ptr(F, l); int acc = 0;
#pragma unroll
    for (int e = 0; e < NE; ++e) { off[e] = acc; const int c = (int)__builtin_amdgcn_readfirstlane(__hip_atomic_load(cnt + e, __ATOMIC_RELAXED, __HIP_MEMORY_SCOPE_AGENT)); acc += ((c + 255) >> 8) << 8; }
    return acc >> 8;
}
__device__ __forceinline__ void phase_moe_permute(Frame& F, int l) {
    int off[NE]; const int ntiles = moe_offsets(F, l, off);
    const bf16* H = (const bf16*)(F.ws + WS_H); bf16* h2s = (bf16*)(F.ws + A_H2S);
    const int4* route_i = (const int4*)(F.ws + WS_ROUTE); int2* pos = (int2*)(F.ws + WS_ROUTE + 1 * MiB);
    if (F.bx == 0) { int* te = tile_e_ptr(F, l);
        for (int t = F.tid; t < ntiles; t += NTHR) { int e = 0;
#pragma unroll
            for (int k = 1; k < NE; ++k) if (t * 256 >= off[k]) e = k;
            te[t] = e; } }
    const int Tm = (l < DEPTH - 1) ? T : TL;
    for (int r = F.gw; r < Tm; r += F.NGW) {
        const int4 ri = route_i[r]; int p0 = 0, p1 = 0;
#pragma unroll
        for (int e = 0; e < NE; ++e) { if (ri.x == e) p0 = off[e] + ri.y; if (ri.z == e) p1 = off[e] + ri.w; }
        const u32x4 a = *(const u32x4*)(H + (size_t)r * D + 8 * F.lane), b = *(const u32x4*)(H + (size_t)r * D + 512 + 8 * F.lane);
        *(u32x4*)(h2s + (size_t)p0 * D + 8 * F.lane) = a; *(u32x4*)(h2s + (size_t)p0 * D + 512 + 8 * F.lane) = b;
        *(u32x4*)(h2s + (size_t)p1 * D + 8 * F.lane) = a; *(u32x4*)(h2s + (size_t)p1 * D + 512 + 8 * F.lane) = b;
        if (F.lane == 0) pos[r] = make_int2(p0, p1);
    }
}

namespace att {
#define SBAR() __builtin_amdgcn_sched_barrier(0)
__device__ __forceinline__ int crow(int r, int hi) { return (r & 3) + 8 * (r >> 2) + 4 * hi; }
__device__ __forceinline__ unsigned cvtpk(float lo, float hi) { unsigned r; asm volatile("v_cvt_pk_bf16_f32 %0, %1, %2" : "=v"(r) : "v"(lo), "v"(hi)); return r; }
constexpr float THRL = 8.f;
__device__ __forceinline__ void partialSM(f32x16& p0, f32x16& p1, float& m_reg, float& alpha) {
    float pmax = p0[0];
#pragma unroll
    for (int r = 1; r < 16; ++r) pmax = fmaxf(pmax, p0[r]);
#pragma unroll
    for (int r = 0; r < 16; ++r) pmax = fmaxf(pmax, p1[r]);
    { auto rr = __builtin_amdgcn_permlane32_swap(__float_as_uint(pmax), __float_as_uint(pmax), false, false); pmax = fmaxf(__uint_as_float(rr[0]), __uint_as_float(rr[1])); }
    float mn;
    if (__builtin_expect(__all(pmax - m_reg <= THRL), 1)) { mn = m_reg; alpha = 1.f; }
    else { mn = fmaxf(m_reg, pmax); alpha = __builtin_amdgcn_exp2f(m_reg - mn); m_reg = mn; }
#pragma unroll
    for (int r = 0; r < 16; ++r) p0[r] = __builtin_amdgcn_exp2f(p0[r] - mn);
#pragma unroll
    for (int r = 0; r < 16; ++r) p1[r] = p1[r] - mn;
}
__device__ __forceinline__ void finishSM(f32x16& p0, f32x16& p1, float alpha, float& l_reg, bf16x8& pa0, bf16x8& pa1, bf16x8& pa2, bf16x8& pa3) {
#pragma unroll
    for (int r = 0; r < 16; ++r) p1[r] = __builtin_amdgcn_exp2f(p1[r]);
    float ps = 0;
#pragma unroll
    for (int r = 0; r < 16; ++r) ps += p0[r];
#pragma unroll
    for (int r = 0; r < 16; ++r) ps += p1[r];
    { auto rr = __builtin_amdgcn_permlane32_swap(__float_as_uint(ps), __float_as_uint(ps), false, false); ps = __uint_as_float(rr[0]) + __uint_as_float(rr[1]); }
    l_reg = l_reg * alpha + ps;
#define PK4(P, BASE, OUT) do { unsigned a0 = cvtpk(P[BASE + 0], P[BASE + 1]), a1 = cvtpk(P[BASE + 2], P[BASE + 3]);   \
    unsigned b0 = cvtpk(P[BASE + 4], P[BASE + 5]), b1 = cvtpk(P[BASE + 6], P[BASE + 7]);                              \
    auto r0 = __builtin_amdgcn_permlane32_swap(a0, b0, false, false); auto r1 = __builtin_amdgcn_permlane32_swap(a1, b1, false, false); \
    u32x4 w = {r0[0], r1[0], r0[1], r1[1]}; OUT = *reinterpret_cast<bf16x8*>(&w); } while (0)
    PK4(p0, 0, pa0); PK4(p0, 8, pa1); PK4(p1, 0, pa2); PK4(p1, 8, pa3);
#undef PK4
}
template <int DK> __device__ __forceinline__ void qkt(f32x16& p0, f32x16& p1, const LAS char* Ks, const bf16x8* qr, int r32, int hi) {
    constexpr int KS = 2 * DK + 16;
    p0 = f32x16{}; p1 = f32x16{};
#pragma unroll
    for (int d0 = 0; d0 < DK / 16; ++d0) { const int cb = (d0 * 16 + hi * 8) * 2;
        const bf16x8 b0 = *(const LAS bf16x8*)(Ks + r32 * KS + cb);
        const bf16x8 b1 = *(const LAS bf16x8*)(Ks + (32 + r32) * KS + cb);
        p0 = __builtin_amdgcn_mfma_f32_32x32x16_bf16(b0, qr[d0], p0, 0, 0, 0);
        p1 = __builtin_amdgcn_mfma_f32_32x32x16_bf16(b1, qr[d0], p1, 0, 0, 0); }
}
__device__ __forceinline__ int v_st(int k, int c) { const int kk = (k & ~0xC) | ((k & 4) << 1) | ((k & 8) >> 1); return ((kk >> 3) * 2 + (c >> 5)) * 512 + ((kk & 7) * 32 + (c & 31)) * 2; }
__device__ __forceinline__ int v_rd_base(int lane) { return ((lane & 3) << 3) | (((lane >> 2) & 3) << 6) | (((lane >> 4) & 1) << 5) | (((lane >> 5) & 1) << 8); }
constexpr int v_rd_off(int d0, int ks, int half) { return d0 * 512 + ks * 2048 + half * 1024; }
template <int OFF> __device__ __forceinline__ s16x4 tr_read(int vb) { s16x4 r; asm volatile("ds_read_b64_tr_b16 %0, %1 offset:%2" : "=&v"(r) : "v"(vb), "i"(OFF) : "memory"); return r; }
template <int D0> __device__ __forceinline__ void pv_one(f32x16& od, int vb, bf16x8 pa0, bf16x8 pa1, bf16x8 pa2, bf16x8 pa3) {
    const s16x4 l0 = tr_read<v_rd_off(D0, 0, 0)>(vb), h0 = tr_read<v_rd_off(D0, 0, 1)>(vb), l1 = tr_read<v_rd_off(D0, 1, 0)>(vb), h1 = tr_read<v_rd_off(D0, 1, 1)>(vb);
    const s16x4 l2 = tr_read<v_rd_off(D0, 2, 0)>(vb), h2 = tr_read<v_rd_off(D0, 2, 1)>(vb), l3 = tr_read<v_rd_off(D0, 3, 0)>(vb), h3 = tr_read<v_rd_off(D0, 3, 1)>(vb);
    asm volatile("s_waitcnt lgkmcnt(0)" ::: "memory"); SBAR();
#define PK(L, H) (bf16x8){L[0], L[1], L[2], L[3], H[0], H[1], H[2], H[3]}
    od = __builtin_amdgcn_mfma_f32_32x32x16_bf16(pa0, PK(l0, h0), od, 0, 0, 0);
    od = __builtin_amdgcn_mfma_f32_32x32x16_bf16(pa1, PK(l1, h1), od, 0, 0, 0);
    od = __builtin_amdgcn_mfma_f32_32x32x16_bf16(pa2, PK(l2, h2), od, 0, 0, 0);
    od = __builtin_amdgcn_mfma_f32_32x32x16_bf16(pa3, PK(l3, h3), od, 0, 0, 0);
#undef PK
}
struct Unit {
    const bf16* Q; int ldq;
    const bf16* K; const bf16* V; int ldk;
    int nA, rowA, nB, rowB, rlo, rhi;
    int mask;
    int kb0, q0;
    float sink; int has_sink;
    bf16* O; int ldo;
};
template <int DK> __device__ __forceinline__ void attn_unit(const Unit& U, LAS char* lds, const int tid) {
    constexpr int KS = 2 * DK + 16, SHM_V = 8192, SHM_K = 64 * KS, NKP = DK / 8;
    const int wid = __builtin_amdgcn_readfirstlane(tid >> 6), lane = tid & 63, r32 = lane & 31, hi = lane >> 5;
    LAS char* V_lds = lds; LAS char* K_lds = lds + 2 * SHM_V;
    LAS float* ws = (LAS float*)(lds + 2 * SHM_V + 2 * SHM_K) + wid * 64; LAS float* li_l = ws; LAS float* al_l = ws + 32;
    float m_reg = -1e30f, l_reg = 0; f32x16 o[2] = {}; bf16x8 qr[DK / 16];
    const bf16* Qw = U.Q + (size_t)(wid * 32 + r32) * U.ldq + hi * 8;
#pragma unroll
    for (int d0 = 0; d0 < DK / 16; ++d0) qr[d0] = *(const bf16x8*)(Qw + d0 * 16);
    const int vkey = tid >> 3, vc = (tid & 7) * 8, vst = v_st(vkey, vc);
    const int k0key = tid / NKP, k0ch = tid % NKP, k1key = (512 + tid) / NKP, k1ch = (512 + tid) % NKP;
    const bool k1on = (DK == 96) && (tid < 256);
    const int vb0 = (int)(uintptr_t)V_lds + v_rd_base(lane);
    const int NT = U.nA + U.nB;
    auto tile_row = [&](int j) -> int { if (j < U.nA) return U.rowA + 64 * j; int r = U.rowB + 64 * (j - U.nA); r = r < U.rlo ? U.rlo : r; return r > U.rhi ? U.rhi : r; };
    struct Slot { bf16x8 v, k0, k1; };
    Slot sE, sO;
#define SLOAD(sl, j) do { const int _row = tile_row(j); sl.v = *(const bf16x8*)(U.V + (size_t)(_row + vkey) * U.ldk + vc); sl.k0 = *(const bf16x8*)(U.K + (size_t)(_row + k0key) * U.ldk + k0ch * 8); \
        if (k1on) sl.k1 = *(const bf16x8*)(U.K + (size_t)(_row + k1key) * U.ldk + k1ch * 8); } while (0)
#define SWRITE(b, sl) do { *(LAS bf16x8*)(V_lds + (b) * SHM_V + vst) = sl.v; *(LAS bf16x8*)(K_lds + (b) * SHM_K + k0key * KS + k0ch * 16) = sl.k0; \
        if (k1on) *(LAS bf16x8*)(K_lds + (b) * SHM_K + k1key * KS + k1ch * 16) = sl.k1; } while (0)
#define RESC(a) do { if (__any((a) < 1.f)) { if (hi == 0) al_l[r32] = (a); asm volatile("s_waitcnt lgkmcnt(0)" ::: "memory"); \
        _Pragma("unroll") for (int d = 0; d < 2; ++d) _Pragma("unroll") for (int r = 0; r < 16; ++r) o[d][r] *= al_l[crow(r, hi)]; } } while (0)
#define MASK(P0, P1, j) do { if (U.mask && (j) >= U.nA) { const int kb = U.kb0 + 64 * ((j) - U.nA), dq = wid * 32 + r32; \
        _Pragma("unroll") for (int r = 0; r < 16; ++r) { const int k0_ = kb + crow(r, hi), k1_ = k0_ + 32; \
            const bool ok0 = (k0_ - dq <= 128) && (dq - k0_ <= 128) && ((unsigned)(U.q0 + k0_) < (unsigned)S); \
            const bool ok1 = (k1_ - dq <= 128) && (dq - k1_ <= 128) && ((unsigned)(U.q0 + k1_) < (unsigned)S); \
            P0[r] = ok0 ? P0[r] : -INFINITY; P1[r] = ok1 ? P1[r] : -INFINITY; } } } while (0)
    f32x16 pA0, pA1, pB0, pB1; float alA, alB; bf16x8 pa0, pa1, pa2, pa3;
    __syncthreads();
    SLOAD(sE, 0); SWRITE(0, sE); __syncthreads();
    qkt<DK>(pA0, pA1, K_lds, qr, r32, hi); MASK(pA0, pA1, 0); partialSM(pA0, pA1, m_reg, alA);
    SLOAD(sO, 1); if (2 < NT) SLOAD(sE, 2);
    SWRITE(1, sO); __syncthreads();
    for (int j = 1; j + 1 < NT; j += 2) {
        SBAR(); qkt<DK>(pB0, pB1, K_lds + SHM_K, qr, r32, hi); MASK(pB0, pB1, j);
        finishSM(pA0, pA1, alA, l_reg, pa0, pa1, pa2, pa3); SBAR();
        SLOAD(sO, j + 2); SBAR();
        pv_one<0>(o[0], vb0, pa0, pa1, pa2, pa3); pv_one<1>(o[1], vb0, pa0, pa1, pa2, pa3); partialSM(pB0, pB1, m_reg, alB);
        __syncthreads(); SWRITE(0, sE);
        RESC(alB); __syncthreads();
        SBAR(); qkt<DK>(pA0, pA1, K_lds, qr, r32, hi); MASK(pA0, pA1, j + 1);
        finishSM(pB0, pB1, alB, l_reg, pa0, pa1, pa2, pa3); SBAR();
        if (j + 3 < NT) SLOAD(sE, j + 3); SBAR();
        pv_one<0>(o[0], vb0 + SHM_V, pa0, pa1, pa2, pa3); pv_one<1>(o[1], vb0 + SHM_V, pa0, pa1, pa2, pa3); partialSM(pA0, pA1, m_reg, alA);
        __syncthreads(); SWRITE(1, sO);
        RESC(alA); __syncthreads();
    }
    SBAR(); qkt<DK>(pB0, pB1, K_lds + SHM_K, qr, r32, hi); MASK(pB0, pB1, NT - 1);
    finishSM(pA0, pA1, alA, l_reg, pa0, pa1, pa2, pa3); SBAR();
    pv_one<0>(o[0], vb0, pa0, pa1, pa2, pa3); pv_one<1>(o[1], vb0, pa0, pa1, pa2, pa3); partialSM(pB0, pB1, m_reg, alB);
    __syncthreads(); RESC(alB);
    finishSM(pB0, pB1, alB, l_reg, pa0, pa1, pa2, pa3); SBAR();
    pv_one<0>(o[0], vb0 + SHM_V, pa0, pa1, pa2, pa3); pv_one<1>(o[1], vb0 + SHM_V, pa0, pa1, pa2, pa3);
    if (U.has_sink) l_reg += __builtin_amdgcn_exp2f(U.sink * LOG2E - m_reg);
    if (hi == 0) li_l[r32] = l_reg; asm volatile("s_waitcnt lgkmcnt(0)" ::: "memory");
    float rli[16];
#pragma unroll
    for (int r = 0; r < 16; ++r) rli[r] = __builtin_amdgcn_rcpf(li_l[crow(r, hi)]);
    bf16* Ow = U.O + (size_t)(wid * 32) * U.ldo;
#pragma unroll
    for (int r = 0; r < 16; ++r) { const int orow = crow(r, hi);
#pragma unroll
        for (int d0 = 0; d0 < 2; ++d0) Ow[(size_t)orow * U.ldo + d0 * 32 + r32] = (bf16)f2bf(o[d0][r] * rli[r]); }
#undef SLOAD
#undef SWRITE
#undef RESC
#undef MASK
}
}

constexpr float SWA_C2 = 0.125f * LOG2E;
__device__ __forceinline__ void phase_even_prep(Frame& F, int li) {
    bf16* P = (bf16*)(F.ws + A_P); bf16* MIX = (bf16*)(F.ws + A_MIX);
    const f32x2* r64 = (const f32x2*)(F.ws + WS_ROPE);
    {
        const int head = F.lane >> 2, qt = F.lane & 3;
        const float* gain = (head < 12 ? inp(F, I_SWAQG) : inp(F, I_SWAKG)) + li * 64 + 16 * qt;
        float gn[16];
#pragma unroll
        for (int j = 0; j < 16; ++j) gn[j] = gain[j] * (head < 12 ? SWA_C2 : 1.f);
        for (int r = F.gw; r < T; r += F.NGW) {
            bf16* p = P + (size_t)r * EV_N + 256 + 64 * head + 16 * qt;
            const u32x4 a = *(const u32x4*)p, b = *(const u32x4*)(p + 8);
            float v[16] = {bflo(a.x), bfhi(a.x), bflo(a.y), bfhi(a.y), bflo(a.z), bfhi(a.z), bflo(a.w), bfhi(a.w), bflo(b.x), bfhi(b.x), bflo(b.y), bfhi(b.y), bflo(b.z), bfhi(b.z), bflo(b.w), bfhi(b.w)};
            float ss = 0.f;
#pragma unroll
            for (int j = 0; j < 16; ++j) ss += v[j] * v[j];
            ss += __shfl_xor(ss, 1); ss += __shfl_xor(ss, 2);
            const float rstd = 1.f / sqrtf(ss * (1.f / 64.f) + EPS);
#pragma unroll
            for (int j = 0; j < 16; ++j) v[j] = v[j] * rstd * gn[j];
            if (r < TL) { const int s = r % S; const f32x2* cs = r64 + (size_t)s * 32 + 16 * (qt & 1);
#pragma unroll
                for (int j = 0; j < 16; ++j) { const float pr = __shfl_xor(v[j], 2); const f32x2 c = cs[j]; v[j] = (qt < 2) ? v[j] * c.x - pr * c.y : v[j] * c.x + pr * c.y; } }
            *(u32x4*)p = (u32x4){pk2(v[0], v[1]), pk2(v[2], v[3]), pk2(v[4], v[5]), pk2(v[6], v[7])};
            *(u32x4*)(p + 8) = (u32x4){pk2(v[8], v[9]), pk2(v[10], v[11]), pk2(v[12], v[13]), pk2(v[14], v[15])};
        }
    }
    {
        __syncthreads();
        LAS float* la = (LAS float*)F.lds;
        LAS float* lp = la + 48 * 256;
        const float* pw = inp(F, I_POOLW) + (size_t)li * 4 * 64 * 64;
        const int d = F.tid & 255, g = d >> 6, hh = F.tid >> 8;
        const float psc = inp(F, I_POOLS)[li * 256 + d];
        for (int tile = F.vcu; tile < T / 32; tile += F.G) {
            const int r0 = tile * 32; const bool lat = r0 < TL; const int L = lat ? S : CL, seq0 = lat ? (r0 / S) * S : TL + ((r0 - TL) / CL) * CL, t0 = r0 - seq0;
            __syncthreads();
            for (int i = F.tid; i < 48 * 32; i += NTHR) { const int rr = i >> 5, c8 = (i & 31) * 8, t = t0 - 8 + rr;
                u32x4 w = {0u, 0u, 0u, 0u}; if (t >= 0 && t < L) w = *(const u32x4*)(P + (size_t)(seq0 + t) * EV_N + c8);
                LAS float* dst = la + rr * 256 + c8; dst[0] = bflo(w.x); dst[1] = bfhi(w.x); dst[2] = bflo(w.y); dst[3] = bfhi(w.y); dst[4] = bflo(w.z); dst[5] = bfhi(w.z); dst[6] = bflo(w.w); dst[7] = bfhi(w.w); }
            __syncthreads();
            { const int hw = 1 << g;
              for (int rr = hh * 16; rr < hh * 16 + 16; ++rr) { const int t = t0 + rr; int lo = t - hw, hi_ = t + hw; lo = lo < 0 ? 0 : lo; hi_ = hi_ > L ? L : hi_;
                  float s = 0.f; for (int u = lo; u < hi_; ++u) s += la[(u - t0 + 8) * 256 + d];
                  lp[rr * 256 + d] = s / (float)(hi_ - lo) - la[(rr + 8) * 256 + d]; } }
            __syncthreads();
            { float acc[16];
#pragma unroll
              for (int i = 0; i < 16; ++i) acc[i] = 0.f;
              for (int c = 0; c < 64; ++c) { const float w = pw[(g * 64 + c) * 64 + (d & 63)];
#pragma unroll
                  for (int i = 0; i < 16; ++i) acc[i] += lp[(hh * 16 + i) * 256 + g * 64 + c] * w; }
#pragma unroll
              for (int i = 0; i < 16; ++i) MIX[(size_t)(r0 + hh * 16 + i) * D + d] = (bf16)f2bf(acc[i] * psc); }
        }
        __syncthreads();
    }
}

__device__ __forceinline__ void phase_swa(Frame& F, int li, bool need_ctx) {
    const bf16* P = (const bf16*)(F.ws + A_P); bf16* MIX = (bf16*)(F.ws + A_MIX);
    const int nlat = NB * 12 * (S / 256), nctx = need_ctx ? NB * 12 : 0;
    for (int u = F.vcu; u < nlat + nctx; u += F.G) {
        att::Unit U; U.ldq = EV_N; U.ldk = EV_N; U.ldo = D; U.has_sink = 1;
        if (u < nlat) { const int qb = u % (S / 256), qh = (u / (S / 256)) % 12, b = u / (12 * (S / 256)), kvh = qh / 3, row0 = b * S + qb * 256;
            U.Q = P + (size_t)row0 * EV_N + 256 + 64 * qh; U.K = P + 1024 + 64 * kvh; U.V = P + 1280 + 64 * kvh;
            U.nA = 4; U.rowA = TL + b * CL; U.nB = 8; U.rowB = row0 - 128; U.rlo = b * S; U.rhi = b * S + S - 64; U.mask = 1; U.kb0 = -128; U.q0 = qb * 256;
            U.sink = inp(F, I_SINK)[li * 12 + qh]; U.O = MIX + (size_t)row0 * D + 256 + 64 * qh; }
        else { const int uu = u - nlat, qh = uu % 12, b = uu / 12, kvh = qh / 3, row0 = TL + b * CL;
            U.Q = P + (size_t)row0 * EV_N + 256 + 64 * qh; U.K = P + 1024 + 64 * kvh; U.V = P + 1280 + 64 * kvh;
            U.nA = 4; U.rowA = row0; U.nB = 0; U.rowB = 0; U.rlo = 0; U.rhi = 0; U.mask = 0; U.kb0 = 0; U.q0 = 0;
            U.sink = inp(F, I_SINK)[li * 12 + qh]; U.O = MIX + (size_t)row0 * D + 256 + 64 * qh; }
        att::attn_unit<64>(U, (LAS char*)F.lds, F.tid);
    }
    __syncthreads();
}

namespace fft {
constexpr int N = 16384, IMG_BYTES = 17408 * 8;
__device__ __forceinline__ int phys(int i) { return i + 4 * (i >> 6); }
__device__ __forceinline__ f32x2 cmul(f32x2 a, f32x2 b) { return (f32x2){a.x * b.x - a.y * b.y, a.x * b.y + a.y * b.x}; }
__device__ __forceinline__ f32x2 cconj(f32x2 a) { return (f32x2){a.x, -a.y}; }
__device__ __forceinline__ void init_tables(LAS f32x2* tw, int tid) {
    if (tid < 384) { const int m = tid < 256 ? 128 * tid : tid - 256; float s, c; sincospif(-(float)m * (1.f / 16384.f), &s, &c); tw[tid] = (f32x2){c, s}; }
}
__device__ __forceinline__ f32x2 tw32k(const LAS f32x2* tw, int m) { return cmul(tw[(m >> 7) & 255], tw[256 + (m & 127)]); }
__device__ __forceinline__ void dft4(f32x2& x0, f32x2& x1, f32x2& x2, f32x2& x3) {
    const f32x2 a = x0 + x2, b = x0 - x2, c = x1 + x3, d = x1 - x3;
    x0 = a + c; x2 = a - c; x1 = (f32x2){b.x + d.y, b.y - d.x}; x3 = (f32x2){b.x - d.y, b.y + d.x};
}
__device__ __forceinline__ void dft16(f32x2 (&v)[16]) {
#pragma unroll
    for (int b = 0; b < 4; ++b) dft4(v[b], v[4 + b], v[8 + b], v[12 + b]);
    const float C1 = 0.92387953251128674f, S1 = 0.38268343236508977f, R2 = 0.70710678118654752f;
    const f32x2 W1 = {C1, -S1}, W2 = {R2, -R2}, W3 = {S1, -C1}, W4 = {0.f, -1.f}, W6 = {-R2, -R2}, W9 = {-C1, S1};
    v[4 * 1 + 1] = cmul(v[4 * 1 + 1], W1); v[4 * 1 + 2] = cmul(v[4 * 1 + 2], W2); v[4 * 1 + 3] = cmul(v[4 * 1 + 3], W3);
    v[4 * 2 + 1] = cmul(v[4 * 2 + 1], W2); v[4 * 2 + 2] = cmul(v[4 * 2 + 2], W4); v[4 * 2 + 3] = cmul(v[4 * 2 + 3], W6);
    v[4 * 3 + 1] = cmul(v[4 * 3 + 1], W3); v[4 * 3 + 2] = cmul(v[4 * 3 + 2], W6); v[4 * 3 + 3] = cmul(v[4 * 3 + 3], W9);
    f32x2 o[16];
#pragma unroll
    for (int c = 0; c < 4; ++c) { f32x2 y0 = v[4 * c], y1 = v[4 * c + 1], y2 = v[4 * c + 2], y3 = v[4 * c + 3]; dft4(y0, y1, y2, y3); o[c] = y0; o[c + 4] = y1; o[c + 8] = y2; o[c + 12] = y3; }
#pragma unroll
    for (int r = 0; r < 16; ++r) v[r] = o[r];
}
template <bool INV> __device__ __forceinline__ void pass16(LAS f32x2* X, const LAS f32x2* tw, int Sd, int tid) {
#pragma unroll 1
    for (int q = 0; q < 2; ++q) {
        const int g = tid + 512 * q, blk = (g / Sd) * (16 * Sd), j = g % Sd; f32x2 v[16];
#pragma unroll
        for (int k = 0; k < 16; ++k) v[k] = X[phys(blk + j + Sd * k)];
        const f32x2 w1 = tw32k(tw, 2 * j * (1024 / Sd));
        const f32x2 w2 = cmul(w1, w1), w3 = cmul(w2, w1), w4 = cmul(w2, w2), w5 = cmul(w4, w1), w6 = cmul(w4, w2), w7 = cmul(w4, w3), w8 = cmul(w4, w4);
        const f32x2 w9 = cmul(w8, w1), w10 = cmul(w8, w2), w11 = cmul(w8, w3), w12 = cmul(w8, w4), w13 = cmul(w8, w5), w14 = cmul(w8, w6), w15 = cmul(w8, w7);
#define TWALL(OP) OP(1, w1) OP(2, w2) OP(3, w3) OP(4, w4) OP(5, w5) OP(6, w6) OP(7, w7) OP(8, w8) OP(9, w9) OP(10, w10) OP(11, w11) OP(12, w12) OP(13, w13) OP(14, w14) OP(15, w15)
#define TWMUL(r, w) v[r] = cmul(v[r], w);
        if (INV) {
#pragma unroll
            for (int k = 0; k < 16; ++k) v[k] = cconj(v[k]);
            TWALL(TWMUL)
            dft16(v);
#pragma unroll
            for (int k = 0; k < 16; ++k) v[k] = cconj(v[k]);
        } else { dft16(v); TWALL(TWMUL) }
#undef TWMUL
#undef TWALL
#pragma unroll
        for (int k = 0; k < 16; ++k) X[phys(blk + j + Sd * k)] = v[k];
    }
}
template <bool INV> __device__ __forceinline__ void pass4(LAS f32x2* X, int tid) {
#pragma unroll 1
    for (int q = 0; q < 8; ++q) {
        const int g = tid + 512 * q; LAS f32x2* p = X + phys(4 * g);
        f32x2 a = p[0], b = p[1], c = p[2], d = p[3];
        if (INV) { a = cconj(a); b = cconj(b); c = cconj(c); d = cconj(d); }
        dft4(a, b, c, d);
        if (INV) { a = cconj(a); b = cconj(b); c = cconj(c); d = cconj(d); }
        p[0] = a; p[1] = b; p[2] = c; p[3] = d;
    }
}
__device__ __forceinline__ void fwd(LAS f32x2* X, const LAS f32x2* tw, int tid) {
    __syncthreads(); pass16<false>(X, tw, 1024, tid); __syncthreads(); pass16<false>(X, tw, 64, tid); __syncthreads(); pass16<false>(X, tw, 4, tid); __syncthreads(); pass4<false>(X, tid); __syncthreads();
}
__device__ __forceinline__ void inv(LAS f32x2* X, const LAS f32x2* tw, int tid) {
    __syncthreads(); pass4<true>(X, tid); __syncthreads(); pass16<true>(X, tw, 4, tid); __syncthreads(); pass16<true>(X, tw, 64, tid); __syncthreads(); pass16<true>(X, tw, 1024, tid); __syncthreads();
}
}

__device__ __forceinline__ void hyena_filter_task(Frame& F, int i, int L, int n0, float* gh) {
    LAS float* lz = (LAS float*)F.lds;
    LAS float* l1 = lz + 64 * 33;
    LAS float* l2 = l1 + 64 * 64;
    const float* w1 = inp(F, I_HYW1) + i * 33 * 64; const float* b1 = inp(F, I_HYB1) + i * 64; const float* w2 = inp(F, I_HYW2) + i * 64 * 64; const float* b2 = inp(F, I_HYB2) + i * 64;
    const float* w3 = inp(F, I_HYW3) + (size_t)i * 64 * 1024; const float* fq = inp(F, I_HYFREQ) + i * 128;
    __syncthreads();
    for (int idx = F.tid; idx < 64 * 33; idx += NTHR) { const int p = idx / 33, e = idx % 33; const float pos = (float)(n0 + p);
        float val;
        if (e == 0) val = pos / (float)(L - 1);
        else { const int jj = (e - 1) & 15; const float fr = 1e-4f + (float)jj * ((15.f - 1e-4f) / 15.f); const float ang = (6.283185307179586f / (float)L) * pos * fr; val = e <= 16 ? cosf(ang) : -sinf(ang); }
        lz[idx] = val; }
    __syncthreads();
    { const int k = F.tid & 63, pg = F.tid >> 6;
      for (int p = pg * 8; p < pg * 8 + 8; ++p) { float s = b1[k]; for (int e = 0; e < 33; ++e) s += lz[p * 33 + e] * w1[e * 64 + k]; l1[p * 64 + k] = sinf(fq[k] * s); } }
    __syncthreads();
    { const int k = F.tid & 63, pg = F.tid >> 6;
      for (int p = pg * 8; p < pg * 8 + 8; ++p) { float s = b2[k]; for (int e = 0; e < 64; ++e) s += l1[p * 64 + e] * w2[e * 64 + k]; l2[p * 64 + k] = sinf(fq[64 + k] * s); } }
    __syncthreads();
    { const int p = F.tid & 63, cg = __builtin_amdgcn_readfirstlane(F.tid >> 6); float h2[64];
#pragma unroll
      for (int e = 0; e < 64; ++e) h2[e] = l2[p * 64 + e];
      const float t = (float)(n0 + p) / (float)(L - 1);
      const float d0 = logf(1e-2f) / 0.3f, d1 = logf(1e-2f) / 1.5f;
      for (int cc = 0; cc < 128; ++cc) { const int col = cg * 128 + cc, c = col & 511, dir = col >> 9; float s = 0.f;
#pragma unroll
          for (int e = 0; e < 64; ++e) s += h2[e] * w3[e * 1024 + col];
          const float delta = fabsf(d0 + (d1 - d0) * ((float)c / 511.f));
          gh[((size_t)dir * 512 + c) * L + n0 + p] = s * expf(-t * delta); } }
    __syncthreads();
}

constexpr size_t GHC_OFF = 12 * MiB;
constexpr size_t ZC_OFF = 10 * MiB + 1536 * 1024;
__device__ __forceinline__ float sconv(const bf16* P, int seq0, int L, int t, int col, float w0, float w1, float w2, float bias) {
    const bf16* p = P + (size_t)(seq0 + t) * OD_N + col;
    float s = bias + w1 * bf2f(p[0]);
    if (t > 0) s += w0 * bf2f(p[-OD_N]);
    if (t + 1 < L) s += w2 * bf2f(p[OD_N]);
    return s;
}
__device__ __forceinline__ void hyena_z_tile(Frame& F, int li, int seq0, int L, int t0, int c0, bf16* Zrow0  , int Lz) {
    LAS bf16* l1 = (LAS bf16*)F.lds;
    LAS bf16* l2 = l1 + 130 * 64;
    const bf16* P = (const bf16*)(F.ws + A_P);
    __syncthreads();
    for (int i = F.tid; i < 130 * 8 * 2; i += NTHR) { const int which = i / (130 * 8), r = (i % (130 * 8)) / 8, c8 = (i % 8) * 8, t = t0 - 1 + r;
        u32x4 w = {0u, 0u, 0u, 0u}; if (t >= 0 && t < L) w = *(const u32x4*)(P + (size_t)(seq0 + t) * OD_N + (which ? 1024 : 512) + c0 + c8);
        *(LAS u32x4*)((which ? l2 : l1) + r * 64 + c8) = w; }
    __syncthreads();
    const int c = F.tid & 63, tc = F.tid >> 6;
    const float* cw = inp(F, I_HYCW) + (size_t)li * 3 * 1536; const float* cb = inp(F, I_HYCB) + (size_t)li * 1536;
    const int ca = 512 + c0 + c, cv = 1024 + c0 + c;
    const float a0 = cw[ca], a1 = cw[1536 + ca], a2 = cw[3072 + ca], ab = cb[ca], v0 = cw[cv], v1 = cw[1536 + cv], v2 = cw[3072 + cv], vb = cb[cv];
    unsigned o[8];
#pragma unroll
    for (int i = 0; i < 16; i += 2) { float z[2];
#pragma unroll
        for (int k = 0; k < 2; ++k) { const int r = tc * 16 + i + k + 1;
            const float x1 = ab + a0 * bf2f(l1[(r - 1) * 64 + c]) + a1 * bf2f(l1[r * 64 + c]) + a2 * bf2f(l1[(r + 1) * 64 + c]);
            const float vv = vb + v0 * bf2f(l2[(r - 1) * 64 + c]) + v1 * bf2f(l2[r * 64 + c]) + v2 * bf2f(l2[(r + 1) * 64 + c]);
            z[k] = x1 * vv; }
        o[i / 2] = pk2(z[0], z[1]); }
    bf16* dst = Zrow0 + (size_t)(c0 + c) * Lz + t0 + tc * 16;
    *(u32x4*)dst = (u32x4){o[0], o[1], o[2], o[3]}; *(u32x4*)(dst + 8) = (u32x4){o[4], o[5], o[6], o[7]};
}
__device__ __forceinline__ void hyena_filter_fft_unit(Frame& F, int c, int par) {
    LAS f32x2* X = (LAS f32x2*)F.lds; LAS f32x2* tw = (LAS f32x2*)(F.lds + fft::IMG_BYTES); LAS float* red = (LAS float*)(F.lds + fft::IMG_BYTES + 3072);
    const float* hf = (const float*)(F.ws + A_KVU) + (size_t)c * S; const float* hb = hf + (size_t)512 * S;
    __syncthreads();
    fft::init_tables(tw, F.tid);
    __syncthreads();
    float an = 0.f;
    for (int n = F.tid; n < S; n += NTHR) { const float f = hf[n], g = n ? hb[S - n] : 0.f; an += fabsf(f) + fabsf(g);
        f32x2 v; if (par == 0) v = (f32x2){f + g, 0.f}; else { const f32x2 t = fft::tw32k(tw, n); v = (f32x2){(f - g) * t.x, (f - g) * t.y}; }
        X[fft::phys(n)] = v; }
    an = wave_sum(an); if (F.lane == 0) red[F.wave] = an;
    fft::fwd(X, tw, F.tid);
    float nrm = 0.f;
#pragma unroll
    for (int w = 0; w < 8; ++w) nrm += red[w];
    const float sc = 1.f / (nrm * 2.f * (float)S);
    f32x2* G = (f32x2*)(F.ws + A_G) + ((size_t)c * 2 + par) * S;
    for (int p = F.tid; p < S; p += NTHR) { const f32x2 v = X[fft::phys(p)]; G[p] = (f32x2){v.x * sc, v.y * sc}; }
}
__device__ __forceinline__ void hyena_conv_unit(Frame& F, int c) {
    LAS f32x2* X = (LAS f32x2*)F.lds; LAS f32x2* tw = (LAS f32x2*)(F.lds + fft::IMG_BYTES);
    bf16* z0 = (bf16*)(F.ws + A_ZY) + (size_t)c * S; bf16* z1 = z0 + (size_t)512 * S;
    const f32x2* G = (const f32x2*)(F.ws + A_G) + (size_t)c * 2 * S;
    __syncthreads();
    fft::init_tables(tw, F.tid);
    __syncthreads();
    f32x2* yeg = (f32x2*)(F.ws + WS_H) + (size_t)F.bx * S;
#pragma unroll 1
    for (int par = 0; par < 2; ++par) {
        __syncthreads();
#pragma unroll 1
        for (int q = 0; q < 4; ++q) { const int n0 = 4096 * q + 8 * F.tid; const u32x4 a = *(const u32x4*)(z0 + n0), b = *(const u32x4*)(z1 + n0);
            const float re[8] = {bflo(a.x), bfhi(a.x), bflo(a.y), bfhi(a.y), bflo(a.z), bfhi(a.z), bflo(a.w), bfhi(a.w)}, im[8] = {bflo(b.x), bfhi(b.x), bflo(b.y), bfhi(b.y), bflo(b.z), bfhi(b.z), bflo(b.w), bfhi(b.w)};
#pragma unroll
            for (int i = 0; i < 8; ++i) { f32x2 v = {re[i], im[i]}; if (par) v = fft::cmul(v, fft::tw32k(tw, n0 + i)); X[fft::phys(n0 + i)] = v; } }
        fft::fwd(X, tw, F.tid);
        for (int p = F.tid; p < S; p += NTHR) { const int pp = fft::phys(p); X[pp] = fft::cmul(X[pp], G[(size_t)par * S + p]); }
        fft::inv(X, tw, F.tid);
        if (par == 0) {
            for (int p = F.tid; p < S; p += NTHR) yeg[p] = X[fft::phys(p)];
        } else {
#pragma unroll 1
            for (int q = 0; q < 4; ++q) { const int n0 = 4096 * q + 8 * F.tid; float re[8], im[8];
#pragma unroll
                for (int i = 0; i < 8; ++i) { const f32x2 v = fft::cmul(X[fft::phys(n0 + i)], fft::cconj(fft::tw32k(tw, n0 + i))); const f32x2 e = yeg[n0 + i]; re[i] = e.x + v.x; im[i] = e.y + v.y; }
                *(u32x4*)(z0 + n0) = (u32x4){pk2(re[0], re[1]), pk2(re[2], re[3]), pk2(re[4], re[5]), pk2(re[6], re[7])};
                *(u32x4*)(z1 + n0) = (u32x4){pk2(im[0], im[1]), pk2(im[2], im[3]), pk2(im[4], im[5]), pk2(im[6], im[7])}; }
        }
    }
}
__device__ __forceinline__ void hyena_ctx_conv_unit(Frame& F, int g8) {
    LAS float* lf = (LAS float*)F.lds; LAS float* lb = lf + 256; LAS float* lz = lb + 256; LAS float* red = lz + 512;
    const float* ghc = (const float*)(F.ws + GHC_OFF); bf16* zc = (bf16*)(F.ws + ZC_OFF);
    const int t = F.tid & 255, b = F.tid >> 8;
    for (int c = g8 * 8; c < g8 * 8 + 8; ++c) {
        __syncthreads();
        float an = 0.f;
        if (F.tid < 256) { const float f = ghc[(size_t)c * CL + t], g = ghc[((size_t)512 + c) * CL + t]; lf[t] = f; lb[t] = g; an = fabsf(f) + (t ? fabsf(g) : 0.f); }
        lz[b * 256 + t] = bf2f(zc[((size_t)b * 512 + c) * CL + t]);
        an = wave_sum(an); if (F.lane == 0) red[F.wave] = an;
        __syncthreads();
        float nrm = 0.f;
#pragma unroll
        for (int w = 0; w < 8; ++w) nrm += red[w];
        float y = 0.f;
        for (int s = 0; s <= t; ++s) y += lf[t - s] * lz[b * 256 + s];
        for (int s = t + 1; s < CL; ++s) y += lb[s - t] * lz[b * 256 + s];
        __syncthreads();
        zc[((size_t)b * 512 + c) * CL + t] = (bf16)f2bf(y / nrm);
    }
}
__device__ __forceinline__ void hyena_gate_tile(Frame& F, int li, int seq0, int L, int t0, int c0, const bf16* Yrow0, int Lz) {
    LAS bf16* l0 = (LAS bf16*)F.lds; LAS bf16* l1 = l0 + 130 * 64; LAS bf16* l2 = l1 + 130 * 64;
    const bf16* P = (const bf16*)(F.ws + A_P); bf16* MIX = (bf16*)(F.ws + A_MIX);
    __syncthreads();
    for (int i = F.tid; i < 130 * 8 * 3; i += NTHR) { const int which = i / (130 * 8), r = (i % (130 * 8)) / 8, c8 = (i % 8) * 8, t = t0 - 1 + r;
        u32x4 w = {0u, 0u, 0u, 0u}; if (t >= 0 && t < L) w = *(const u32x4*)(P + (size_t)(seq0 + t) * OD_N + which * 512 + c0 + c8);
        *(LAS u32x4*)((which == 0 ? l0 : which == 1 ? l1 : l2) + r * 64 + c8) = w; }
    __syncthreads();
    const int c = F.tid & 63, tc = F.tid >> 6;
    const float* cw = inp(F, I_HYCW) + (size_t)li * 3 * 1536; const float* cb = inp(F, I_HYCB) + (size_t)li * 1536;
    const int c0_ = c0 + c, ca = 512 + c0 + c, cv = 1024 + c0 + c;
    const float x0w0 = cw[c0_], x0w1 = cw[1536 + c0_], x0w2 = cw[3072 + c0_], x0b = cb[c0_];
    const float a0 = cw[ca], a1 = cw[1536 + ca], a2 = cw[3072 + ca], ab = cb[ca], v0 = cw[cv], v1 = cw[1536 + cv], v2 = cw[3072 + cv], vb = cb[cv];
    const float skip = inp(F, I_HYSKIP)[li * 512 + c0_];
    const bf16* ysrc = Yrow0 + (size_t)c0_ * Lz + t0 + tc * 16;
    const u32x4 ya = *(const u32x4*)ysrc, yb = *(const u32x4*)(ysrc + 8);
    const float yv[16] = {bflo(ya.x), bfhi(ya.x), bflo(ya.y), bfhi(ya.y), bflo(ya.z), bfhi(ya.z), bflo(ya.w), bfhi(ya.w), bflo(yb.x), bfhi(yb.x), bflo(yb.y), bfhi(yb.y), bflo(yb.z), bfhi(yb.z), bflo(yb.w), bfhi(yb.w)};
#pragma unroll
    for (int i = 0; i < 16; ++i) { const int r = tc * 16 + i + 1;
        const float x0 = x0b + x0w0 * bf2f(l0[(r - 1) * 64 + c]) + x0w1 * bf2f(l0[r * 64 + c]) + x0w2 * bf2f(l0[(r + 1) * 64 + c]);
        const float x1 = ab + a0 * bf2f(l1[(r - 1) * 64 + c]) + a1 * bf2f(l1[r * 64 + c]) + a2 * bf2f(l1[(r + 1) * 64 + c]);
        const float vv = vb + v0 * bf2f(l2[(r - 1) * 64 + c]) + v1 * bf2f(l2[r * 64 + c]) + v2 * bf2f(l2[(r + 1) * 64 + c]);
        const float z = x1 * vv;
        MIX[(size_t)(seq0 + t0 + tc * 16 + i) * D + c0_] = (bf16)f2bf(x0 * (yv[i] + skip * z)); }
}

__device__ __forceinline__ void phase_odd_prep(Frame& F, int li, bool need_ctx) {
    const bf16* P = (const bf16*)(F.ws + A_P); float* rs = (float*)(F.ws + WS_MISC + MISC_RSTD);
    for (int r = F.gw; r < T; r += F.NGW) {
        const bf16* p = P + (size_t)r * OD_N + 1536; const u32x2 a = *(const u32x2*)(p + 4 * F.lane); const unsigned b = *(const unsigned*)(p + 256 + 2 * F.lane);
        float s1 = bflo(a.x) * bflo(a.x) + bfhi(a.x) * bfhi(a.x) + bflo(a.y) * bflo(a.y) + bfhi(a.y) * bfhi(a.y), s2 = bflo(b) * bflo(b) + bfhi(b) * bfhi(b);
        s1 = wave_sum(s1); s2 = wave_sum(s2);
        if (F.lane == 0) { rs[r] = 1.f / sqrtf(s1 * (1.f / 256.f) + EPS); rs[T + r] = 1.f / sqrtf(s2 * (1.f / 128.f) + EPS); }
    }
    const int nz = 2048 + (need_ctx ? 32 : 0);
    for (int u = F.vcu; u < nz; u += F.G) {
        if (u < 2048) { const int cc = u & 7, tt = (u >> 3) & 127, b = u >> 10; hyena_z_tile(F, li, b * S, S, tt * 128, cc * 64, (bf16*)(F.ws + A_ZY) + (size_t)b * 512 * S, S); }
        else { const int uu = u - 2048, cc = uu & 7, tt = (uu >> 3) & 1, b = uu >> 4; hyena_z_tile(F, li, TL + b * CL, CL, tt * 128, cc * 64, (bf16*)(F.ws + ZC_OFF) + (size_t)b * 512 * CL, CL); }
    }
    for (int u = F.vcu; u < 1024; u += F.G) hyena_filter_fft_unit(F, u >> 1, u & 1);
    __syncthreads();
}
constexpr float MLA_C2 = 0.10206207261596577f * LOG2E;
__device__ __forceinline__ void phase_mla_prep(Frame& F, int li) {
    const bf16* P = (const bf16*)(F.ws + A_P); bf16* QU = (bf16*)(F.ws + A_QU); bf16* KVU = (bf16*)(F.ws + A_KVU);
    const f32x2* r32t = (const f32x2*)(F.ws + WS_ROPE) + (size_t)S * 32;
    const int hd = F.lane >> 2, qt = F.lane & 3, isk = hd >= 8, h = hd & 7;
    const float* gain = (isk ? inp(F, I_MKG) : inp(F, I_MQG)) + li * 96 + 24 * qt;
    float gn[24];
#pragma unroll
    for (int j = 0; j < 24; ++j) gn[j] = gain[j] * (isk ? 1.f : MLA_C2);
    for (int r = F.gw; r < T; r += F.NGW) {
        bf16* base = isk ? KVU + (size_t)r * KVU_N + 160 * h : QU + (size_t)r * QU_N + 96 * h;
        float v[24];
#pragma unroll
        for (int j8 = 0; j8 < 3; ++j8) { const int e0 = 24 * qt + 8 * j8;
            u32x4 w;
            if (isk && e0 >= 64) w = *(const u32x4*)(P + (size_t)r * OD_N + 1920 + (e0 - 64)); else w = *(const u32x4*)(base + e0);
            v[8 * j8 + 0] = bflo(w.x); v[8 * j8 + 1] = bfhi(w.x); v[8 * j8 + 2] = bflo(w.y); v[8 * j8 + 3] = bfhi(w.y); v[8 * j8 + 4] = bflo(w.z); v[8 * j8 + 5] = bfhi(w.z); v[8 * j8 + 6] = bflo(w.w); v[8 * j8 + 7] = bfhi(w.w); }
        float ss = 0.f;
#pragma unroll
        for (int j = 0; j < 24; ++j) ss += v[j] * v[j];
        ss += __shfl_xor(ss, 1); ss += __shfl_xor(ss, 2);
        const float rstd = 1.f / sqrtf(ss * (1.f / 96.f) + EPS);
#pragma unroll
        for (int j = 0; j < 24; ++j) v[j] *= rstd * gn[j];
        if (r < TL) {
            const int s = r % S; const f32x2* cs = r32t + (size_t)s * 16;
            float x2lo[8], x1lo[8];
#pragma unroll
            for (int i = 0; i < 8; ++i) { x2lo[i] = __shfl_xor(v[8 + i], 1); x1lo[i] = __shfl_xor(v[16 + i], 1); }
            if (qt == 2) {
#pragma unroll
                for (int i = 0; i < 8; ++i) { const f32x2 c = cs[i]; v[16 + i] = v[16 + i] * c.x - x2lo[i] * c.y; }
            } else if (qt == 3) {
#pragma unroll
                for (int i = 0; i < 8; ++i) { const f32x2 c = cs[i]; const float x2 = v[8 + i]; v[8 + i] = x2 * c.x + x1lo[i] * c.y; }
#pragma unroll
                for (int i = 0; i < 8; ++i) { const f32x2 c = cs[8 + i]; const float x1 = v[i], x2 = v[16 + i]; v[i] = x1 * c.x - x2 * c.y; v[16 + i] = x2 * c.x + x1 * c.y; }
            }
        }
#pragma unroll
        for (int j8 = 0; j8 < 3; ++j8) *(u32x4*)(base + 24 * qt + 8 * j8) = (u32x4){pk2(v[8 * j8], v[8 * j8 + 1]), pk2(v[8 * j8 + 2], v[8 * j8 + 3]), pk2(v[8 * j8 + 4], v[8 * j8 + 5]), pk2(v[8 * j8 + 6], v[8 * j8 + 7])};
    }
}
__device__ __forceinline__ void phase_mla(Frame& F, int li, bool need_ctx) {
    const bf16* QU = (const bf16*)(F.ws + A_QU); const bf16* KVU = (const bf16*)(F.ws + A_KVU); bf16* MIX = (bf16*)(F.ws + A_MIX);
    const int nlat = NB * MLA_H * (S / 256), nctx = need_ctx ? NB * MLA_H : 0;
    for (int u = F.vcu; u < nlat + nctx; u += F.G) {
        att::Unit U; U.ldq = QU_N; U.ldk = KVU_N; U.ldo = D; U.has_sink = 0; U.sink = 0.f; U.mask = 0; U.kb0 = 0; U.q0 = 0; U.rlo = 0; U.rhi = T;
        if (u < nlat) { const int qb = u % (S / 256), h = (u / (S / 256)) % MLA_H, b = u / (MLA_H * (S / 256)), row0 = b * S + qb * 256;
            U.Q = QU + (size_t)row0 * QU_N + 96 * h; U.K = KVU + 160 * h; U.V = KVU + 160 * h + 96;
            U.nA = S / 64; U.rowA = b * S; U.nB = CL / 64; U.rowB = TL + b * CL; U.O = MIX + (size_t)row0 * D + 512 + 64 * h; }
        else { const int uu = u - nlat, h = uu % MLA_H, b = uu / MLA_H, row0 = TL + b * CL;
            U.Q = QU + (size_t)row0 * QU_N + 96 * h; U.K = KVU + 160 * h; U.V = KVU + 160 * h + 96;
            U.nA = CL / 64; U.rowA = row0; U.nB = 0; U.rowB = 0; U.O = MIX + (size_t)row0 * D + 512 + 64 * h; }
        att::attn_unit<96>(U, (LAS char*)F.lds, F.tid);
    }
    __syncthreads();
}
__device__ __forceinline__ void phase_hyena_conv(Frame& F, int li, bool need_ctx) {
    for (int c = F.vcu; c < 512; c += F.G) hyena_conv_unit(F, c);
    __syncthreads();
}
__device__ __forceinline__ void phase_hyena_ctx_conv(Frame& F, int li, bool need_ctx) {
    if (need_ctx) for (int g8 = F.vcu; g8 < 64; g8 += F.G) hyena_ctx_conv_unit(F, g8);
    __syncthreads();
}
__device__ __forceinline__ void phase_hyena_gate(Frame& F, int li, bool need_ctx) {
    const int nz = 2048 + (need_ctx ? 32 : 0);
    for (int u = F.vcu; u < nz; u += F.G) {
        if (u < 2048) { const int cc = u & 7, tt = (u >> 3) & 127, b = u >> 10; hyena_gate_tile(F, li, b * S, S, tt * 128, cc * 64, (const bf16*)(F.ws + A_ZY) + (size_t)b * 512 * S, S); }
        else { const int uu = u - 2048, cc = uu & 7, tt = (uu >> 3) & 1, b = uu >> 4; hyena_gate_tile(F, li, TL + b * CL, CL, tt * 128, cc * 64, (const bf16*)(F.ws + ZC_OFF) + (size_t)b * 512 * CL, CL); }
    }
    __syncthreads();
}


__device__ __forceinline__ void ph_gemm_store(Frame& F, const bf16* A, const bf16* Bt, int lda, int K, int M, int N, bf16* O, int ldc, const float* rowscale) {
    asm volatile("" : "+s"(K), "+s"(lda)); pg8::Gemm g{A, Bt, lda, K}; pg8::StaticOrder So; So.init(M, N, F.G, F.bx); pg8::EpiStoreBf16 E{O, ldc, rowscale}; pg8::gemm_phase(F.lds, g, So, E, F.tid);
}
__device__ __forceinline__ void ph_gemm_res(Frame& F, const bf16* A, const bf16* Bt, int M, const float* srcL, float* dstL, const float* srcC, float* dstC, const float* gate, float on) {
    pg8::Gemm g{A, Bt, D, D}; pg8::StaticOrder So; So.init(M, D, F.G, F.bx); pg8::EpiResidual E{srcL, dstL, srcC, dstC, gate, on}; pg8::gemm_phase(F.lds, g, So, E, F.tid);
}
__device__ __forceinline__ void ph_gemm_moe_gu(Frame& F, int l) {
    int off[NE]; const int ntiles = moe_offsets(F, l, off); pg8::Gemm g{(const bf16*)(F.ws + A_H2S), (const bf16*)(F.ws + WS_WMOE), D, D};
    pg8::MoeOrder So{tile_e_ptr(F, l), ntiles, 4, F.G, F.vcu}; pg8::EpiSwiglu E{(bf16*)(F.ws + A_ACT)}; pg8::gemm_phase(F.lds, g, So, E, F.tid);
}
__device__ __forceinline__ void ph_gemm_moe_down(Frame& F, int l) {
    int off[NE]; const int ntiles = moe_offsets(F, l, off); pg8::Gemm g{(const bf16*)(F.ws + A_ACT), (const bf16*)(F.ws + WS_WMOE) + (size_t)NE * 1024 * 1024, FF, FF};
    pg8::MoeOrder So{tile_e_ptr(F, l), ntiles, 4, F.G, F.vcu}; pg8::EpiStoreBf16 E{(bf16*)(F.ws + A_YS), D, nullptr}; pg8::gemm_phase(F.lds, g, So, E, F.tid);
}

__global__ void __launch_bounds__(NTHR, 2) mk_fwd(Args args) {
    extern __shared__ __attribute__((aligned(16))) unsigned char lds_raw[];
    Frame F;
    F.lds = (LAS unsigned char*)lds_raw; F.in = (const LAS unsigned long long*)(F.lds + LDSCTL_OFF + 512); F.out = args.out; F.ws = args.ws;
    F.tid = threadIdx.x; F.lane = F.tid & 63; F.wave = __builtin_amdgcn_readfirstlane(F.tid >> 6);
    F.G = gridDim.x; F.bx = blockIdx.x; F.vcu = F.bx; F.gw = 0; F.NGW = F.G * NWAVES;
    volatile LAS unsigned* MISC = (volatile LAS unsigned*)(F.lds + MISC_OFF);
    for (int u = F.tid; u < (LDS_BYTES - LDSCTL_OFF) / 4; u += NTHR) ((LAS unsigned*)(F.lds + LDSCTL_OFF))[u] = 0u;
    __syncthreads();
    if (F.tid == 0) { LAS unsigned long long* tab = (LAS unsigned long long*)(F.lds + LDSCTL_OFF + 512);
#pragma unroll
        for (int i = 0; i < 36; ++i) tab[i] = (unsigned long long)args.in[i]; }
    __syncthreads();
    const int lo = args.ph_lo, hi = args.ph_hi;
    XcdBarrier bar; bar.bar = (unsigned*)(F.ws + WS_CTL) + CW_BAR; bar.x = 0; bar.st = nullptr;
    if (hi - lo > 1) bar = xcd_barrier_post((unsigned*)(F.ws + WS_CTL) + CW_BAR, MISC + 8);
    int k = 0;
#define PH_BEGIN if (lo <= k && k < hi) { { int t_ = threadIdx.x; asm volatile("" : "+v"(t_)); F.tid = t_; F.lane = t_ & 63; F.wave = __builtin_amdgcn_readfirstlane(t_ >> 6); \
        int b_ = blockIdx.x; asm volatile("" : "+s"(b_)); F.bx = b_; F.vcu = (F.G % 8 == 0) ? (b_ % 8) * (F.G / 8) + b_ / 8 : b_; F.gw = F.vcu * NWAVES + F.wave; \
        unsigned char* w_ = args.ws; asm volatile("" : "+s"(w_)); F.ws = w_; float* o_ = args.out; asm volatile("" : "+s"(o_)); F.out = o_; int g_ = gridDim.x; asm volatile("" : "+s"(g_)); F.G = g_; F.NGW = g_ * NWAVES; }
#define PH_END if (k + 1 < hi) xcd_barrier(bar); } ++k;
#define PH_END_NOBAR __syncthreads(); }
    LAS unsigned char* glds = F.lds;
#define wsm ((bf16*)(F.ws + WS_WSM))
#define H ((bf16*)(F.ws + WS_H))
#define P ((bf16*)(F.ws + A_P))
#define MIX ((bf16*)(F.ws + A_MIX))
#define XC ((float*)(F.ws + WS_XC))

    PH_BEGIN phase_prologue(F); PH_END

#pragma unroll 1
    for (int lp = 0; lp < 2; ++lp) {
        {
            const int l = 2 * lp, li = lp; const bool need_ctx = true;
            PH_BEGIN phase_norm1(F, l); __syncthreads(); moe_weight_convert(F, l); PH_END
            PH_BEGIN ph_gemm_store(F, H, (const bf16*)((const char*)wsm + W_EIN) + (size_t)li * EV_N * D, D, D, T, EV_N, P, EV_N, nullptr); PH_END
            PH_BEGIN phase_even_prep(F, li); PH_END
            PH_BEGIN phase_swa(F, li, need_ctx); PH_END
            PH_BEGIN ph_gemm_res(F, MIX, (const bf16*)((const char*)wsm + W_EOUT) + (size_t)li * D * D, T, l == 0 ? inp(F, I_X) : F.out, F.out, l == 0 ? inp(F, I_CTX) : XC, XC, mod_ptr(F, l, 0) + 2 * D, (STOP_AFTER >= 2 * l + 1) ? 1.f : 0.f); PH_END
            PH_BEGIN phase_norm2_route(F, l); PH_END
            PH_BEGIN phase_moe_permute(F, l); PH_END
            PH_BEGIN ph_gemm_moe_gu(F, l); PH_END
            PH_BEGIN ph_gemm_moe_down(F, l); PH_END
        }
        {
            const int l = 2 * lp + 1, li = lp; const bool need_ctx = (l < DEPTH - 1); const int Mx = need_ctx ? T : TL;
            PH_BEGIN phase_norm1(F, l); __syncthreads(); moe_weight_convert(F, l);
                for (int t = F.vcu; t < S / 64 + (need_ctx ? CL / 64 : 0); t += F.G) { if (t < S / 64) hyena_filter_task(F, li, S, t * 64, (float*)(F.ws + A_KVU)); else hyena_filter_task(F, li, CL, (t - S / 64) * 64, (float*)(F.ws + GHC_OFF)); }
            PH_END
            PH_BEGIN ph_gemm_store(F, H, (const bf16*)((const char*)wsm + W_OIN) + (size_t)li * OD_N * D, D, D, T, OD_N, P, OD_N, nullptr); PH_END
            PH_BEGIN phase_odd_prep(F, li, need_ctx); PH_END
            PH_BEGIN ph_gemm_store(F, P + 1536, (const bf16*)((const char*)wsm + W_UQ) + (size_t)li * QU_N * 256, OD_N, 256, T, QU_N, (bf16*)(F.ws + A_QU), QU_N, (const float*)(F.ws + WS_MISC + MISC_RSTD)); PH_END_NOBAR
            PH_BEGIN ph_gemm_store(F, P + 1792, (const bf16*)((const char*)wsm + W_UKV) + (size_t)li * KVU_N * 256, OD_N, 256, T, KVU_N, (bf16*)(F.ws + A_KVU), KVU_N, (const float*)(F.ws + WS_MISC + MISC_RSTD) + T); PH_END
            PH_BEGIN phase_mla_prep(F, li); PH_END
            PH_BEGIN phase_mla(F, li, need_ctx); PH_END_NOBAR
            PH_BEGIN phase_hyena_conv(F, li, need_ctx); PH_END_NOBAR
            PH_BEGIN phase_hyena_ctx_conv(F, li, need_ctx); PH_END
            PH_BEGIN phase_hyena_gate(F, li, need_ctx); PH_END
            PH_BEGIN ph_gemm_res(F, MIX, (const bf16*)((const char*)wsm + W_OOUT) + (size_t)li * D * D, Mx, F.out, F.out, XC, XC, mod_ptr(F, l, 0) + 2 * D, (STOP_AFTER >= 2 * l + 1) ? 1.f : 0.f); PH_END
            PH_BEGIN phase_norm2_route(F, l); PH_END
            PH_BEGIN phase_moe_permute(F, l); PH_END
            PH_BEGIN ph_gemm_moe_gu(F, l); PH_END
            PH_BEGIN ph_gemm_moe_down(F, l); PH_END
        }
    }
    PH_BEGIN phase_final(F); PH_END
#undef PH_BEGIN
#undef PH_END
#undef PH_END_NOBAR
#undef wsm
#undef H
#undef P
#undef MIX
#undef XC
}
constexpr int N_PHASES = 1 + 2 * (9 + 12) + 1;

extern "C" void kernel_launch(void* const* d_in, const int* in_sizes, int n_in, void* d_out, int out_size, void* d_ws, size_t ws_size, hipStream_t stream) {
    static int grid = 0;
    if (grid == 0) {
        if (n_in != 36 || out_size != TL * D || ws_size < WS_END) { fprintf(stderr, "kernel_launch: shape mismatch: n_in %d out %d ws %zu (need %zu)\n", n_in, out_size, ws_size, (size_t)WS_END); grid = -1; return; }
        int dev = 0, cus = 0, per_cu = 0;
        if (hipGetDevice(&dev) != hipSuccess || hipDeviceGetAttribute(&cus, hipDeviceAttributeMultiprocessorCount, dev) != hipSuccess) { grid = -1; return; }
        if (hipFuncSetAttribute((const void*)mk_fwd, hipFuncAttributeMaxDynamicSharedMemorySize, LDS_BYTES) != hipSuccess) { fprintf(stderr, "kernel_launch: hipFuncSetAttribute failed\n"); grid = -1; return; }
        if (hipOccupancyMaxActiveBlocksPerMultiprocessor(&per_cu, (const void*)mk_fwd, NTHR, LDS_BYTES) != hipSuccess || per_cu < 1) fprintf(stderr, "kernel_launch: occupancy query says %d\n", per_cu);
        (void)hipGetLastError();
        grid = cus;
    }
    if (grid < 0) return;
    if (hipMemsetAsync((char*)d_ws + WS_CTL, 0, CTL_ZERO_BYTES, stream) != hipSuccess) return;
    Args a{};
    for (int i = 0; i < 36; ++i) a.in[i] = (const float*)d_in[i];
    a.out = (float*)d_out; a.ws = (unsigned char*)d_ws;
#if MK_MULTI
    for (int p = 0; p < N_PHASES; ++p) { a.ph_lo = p; a.ph_hi = p + 1; hipLaunchKernelGGL(mk_fwd, dim3(grid), dim3(NTHR), LDS_BYTES, stream, a); }
#else
    a.ph_lo = 0; a.ph_hi = N_PHASES; hipLaunchKernelGGL(mk_fwd, dim3(grid), dim3(NTHR), LDS_BYTES, stream, a);
#endif
    const hipError_t le = hipPeekAtLastError();
    if (le != hipSuccess) fprintf(stderr, "kernel_launch: launch failed: %s\n", hipGetErrorName(le));
}
```

```cpp
#include <hip/hip_runtime.h>
#include <cstdio>
#include <cstdint>

#ifndef MK_MULTI
#define MK_MULTI 0
#endif
#ifndef DUP_MASK
#define DUP_MASK 0
#endif
#ifndef DUP_N
#define DUP_N 1
#endif
#ifndef PROBE_KIND
#define PROBE_KIND -1
#endif
#ifndef PROBE_Q
#define PROBE_Q 0
#endif
#ifndef PROBE_MUL
#define PROBE_MUL 2.f
#endif
#ifndef ATTN_FAST
#define ATTN_FAST attn_unit_dma
#endif
#ifndef MLA_EXPT
#define MLA_EXPT 0
#endif
#ifndef GEMM_ALIGN_MD
#define GEMM_ALIGN_MD true
#endif
#ifndef STOP_AFTER
#define STOP_AFTER 99
#endif

#define GAS __attribute__((address_space(1)))
#define LAS __attribute__((address_space(3)))
typedef unsigned short bf16;
typedef unsigned u32x4 __attribute__((ext_vector_type(4)));
typedef unsigned u32x2 __attribute__((ext_vector_type(2)));
typedef float f32x4 __attribute__((ext_vector_type(4)));
typedef float f32x2 __attribute__((ext_vector_type(2)));
typedef float f32x16 __attribute__((ext_vector_type(16)));
typedef float f32x8 __attribute__((ext_vector_type(8)));
typedef short bf16x8 __attribute__((ext_vector_type(8)));
typedef short s16x4 __attribute__((ext_vector_type(4)));
typedef int i32x4 __attribute__((ext_vector_type(4)));

constexpr int D = 1024, NB = 2, S = 16384, CL = 256, DEPTH = 4;
constexpr int TL = NB * S, TC = NB * CL, T = TL + TC;
constexpr int GRID_W = 64;
constexpr float EPS = 1e-6f;
constexpr int EV_N = 1536, OD_N = 2048  , OD_NR = 1952;
constexpr int NE = 16, FF = 512;
constexpr int HYW = 512;
constexpr int MLA_H = 8, MLA_QK = 96, MLA_V = 64, QU_N = 768, KVU_N = 1280  ;
constexpr int MOE_ROWS = 70656;
constexpr float LOG2E = 1.4426950408889634f;

constexpr size_t MiB = 1u << 20;
constexpr size_t WS_CTL = 0, CTL_ZERO_BYTES = 1 * MiB;
constexpr int CW_BAR = 4096;
constexpr int CW_WQ = 131072;
constexpr int CW_CNT = 65536;
constexpr size_t WS_MISC = 1 * MiB;
constexpr size_t MISC_MOD = 0, MISC_TILEE = 512 * 1024, MISC_RSTD = 600 * 1024  ;
constexpr size_t WS_ROPE = 2 * MiB;
constexpr size_t WS_XC = 8 * MiB;
constexpr size_t WS_ROUTE = 10 * MiB;
constexpr size_t WS_WSM = 13 * MiB;
constexpr size_t W_EIN = 0, W_EOUT = W_EIN + 2 * (size_t)EV_N * D * 2, W_OIN = W_EOUT + 2 * (size_t)D * D * 2, W_OOUT = W_OIN + 2 * (size_t)OD_N * D * 2,
                 W_UQ = W_OOUT + 2 * (size_t)D * D * 2, W_UKV = W_UQ + 2 * (size_t)QU_N * 256 * 2, W_SM_END = W_UKV + 2 * (size_t)KVU_N * 256 * 2;
static_assert(W_SM_END <= 24 * MiB, "small weights");
constexpr size_t WS_WMOE = 37 * MiB;
constexpr size_t WS_H = 85 * MiB;
constexpr size_t WS_ARENA = 150 * MiB;
constexpr size_t A_P = WS_ARENA;
constexpr size_t A_MIX = A_P + 130 * MiB;
constexpr size_t A_KVU = A_MIX + 65 * MiB;
constexpr size_t A_ZY = A_KVU + 82 * MiB;
constexpr size_t A_QU = A_ZY + 32 * MiB;
constexpr size_t A_G = A_QU + 49 * MiB;
constexpr size_t WS_HB = A_G + 64 * MiB;
constexpr size_t WS_LIST = A_G + 128 * MiB;
constexpr size_t WS_WOS = WS_LIST + 3 * MiB;
constexpr size_t WS_WT3 = WS_WOS + 6 * MiB;
constexpr size_t WS_F128 = WS_WT3 + 640 * 1024;
constexpr size_t WS_WPT = WS_WT3 + 512 * 1024;
constexpr size_t WS_END = WS_WT3 + 1 * MiB;
constexpr size_t A_H2S = A_P;
constexpr size_t A_ACT = A_KVU;
constexpr size_t A_YS = A_ZY;
static_assert(A_ACT + (size_t)MOE_ROWS * 1024 <= A_ZY && A_YS + (size_t)MOE_ROWS * 2048 <= WS_LIST, "moe aliases");
static_assert((size_t)T * 2048 * 2 <= 130 * MiB && (size_t)T * 1280 * 2 <= 82 * MiB && (size_t)T * 768 * 2 <= 49 * MiB, "arena");

constexpr int NWAVES = 8, NTHR = 512;
constexpr int RING_BYTES = 139264 + 4096;
constexpr int LDSCTL_OFF = RING_BYTES, MISC_OFF = LDSCTL_OFF + 64;
constexpr int LDS_BYTES = 147456;
static_assert(MISC_OFF + 128 <= LDS_BYTES, "lds");

#define LDS_WAIT() asm volatile("s_waitcnt lgkmcnt(0)" ::: "memory")
#define VM_WAIT() asm volatile("s_waitcnt vmcnt(0)" ::: "memory")
__device__ __forceinline__ unsigned f2bf(float f) { unsigned u = __builtin_bit_cast(unsigned, f); return (u + 0x7fffu + ((u >> 16) & 1u)) >> 16; }
__device__ __forceinline__ unsigned pk2(float lo, float hi) { return f2bf(lo) | (f2bf(hi) << 16); }
__device__ __forceinline__ float bf2f(unsigned short h) { return __builtin_bit_cast(float, (unsigned)h << 16); }
__device__ __forceinline__ float bflo(unsigned w) { return __builtin_bit_cast(float, w << 16); }
__device__ __forceinline__ float bfhi(unsigned w) { return __builtin_bit_cast(float, w & 0xffff0000u); }
template <int CTRL> __device__ __forceinline__ float dpp_f(float x) { return __builtin_bit_cast(float, __builtin_amdgcn_update_dpp(0, __builtin_bit_cast(int, x), CTRL, 0xf, 0xf, true)); }
__device__ __forceinline__ float wave_sum(float v) {
    v += dpp_f<0xB1>(v);
    v += dpp_f<0x4E>(v);
    v += dpp_f<0x141>(v);
    v += dpp_f<0x140>(v);
    const int b = __builtin_bit_cast(int, v);
    const float r0 = __builtin_bit_cast(float, __builtin_amdgcn_readlane(b, 0)), r1 = __builtin_bit_cast(float, __builtin_amdgcn_readlane(b, 16));
    const float r2 = __builtin_bit_cast(float, __builtin_amdgcn_readlane(b, 32)), r3 = __builtin_bit_cast(float, __builtin_amdgcn_readlane(b, 48));
    return (r0 + r1) + (r2 + r3);
}

namespace pg8 {
#define PG8_LAS __attribute__((address_space(3)))
typedef unsigned short bf16_t;
constexpr int BM = 256, BK = 64, HALF = 128, HTB = HALF * BK * 2, STAGE_BYTES = 8 * HTB, NXCD = 8, WGM = 8;
__host__ __device__ __forceinline__ int lds_byte(int r, int c) { const int st = (r >> 4) * 2 + (c >> 5), rr = r & 15, cc = c & 31, ob = rr * 64 + cc * 2; return st * 1024 + (ob ^ (((ob >> 9) & 1) << 5)); }
__host__ __device__ __forceinline__ void stage_rc(int b, int& R, int& C) { const int st = b / 1024, sb = b % 1024, swz = sb ^ (((sb >> 9) & 1) << 5); R = (st >> 1) * 16 + swz / 64; C = (st & 1) * 32 + (swz % 64) / 2; }
__host__ __device__ __forceinline__ int perm32(int rho) { const int n = rho >> 4, i = rho & 15; return 8 * (i >> 2) + 4 * n + (i & 3); }

struct Unit { int pm, pn; };
struct Gemm { const bf16_t* A; const bf16_t* Bt; int lda, K; };

struct StaticOrder {
    static constexpr bool GATHER = false;
    int nM, nN, nwg, G, c;
    __host__ __device__ void init(int M, int N, int G_, int c_) { nM = M / BM; nN = N / BM; nwg = nM * nN; G = G_; c = c_; }
    __host__ __device__ bool next(int i, Unit& u) const {
        const long L = (long)i * G + c; if (L >= nwg) return false;
        int wgid = (int)L; { const int q = nwg / NXCD, r = nwg % NXCD, xcd = wgid % NXCD, off = wgid / NXCD; wgid = (xcd < r ? xcd * (q + 1) : r * (q + 1) + (xcd - r) * q) + off; }
        const int nig = WGM * nN, gid = wgid / nig, fm = gid * WGM, gsz = (nM - fm) < WGM ? (nM - fm) : WGM;
        u.pm = fm + ((wgid % nig) % gsz); u.pn = (wgid % nig) / gsz; return true;
    }
    __device__ __forceinline__ size_t b_off(const Unit& u, int K) const { return (size_t)u.pn * BM * K * 2; }
};
struct MoeOrder {
    static constexpr bool GATHER = false;
    const PG8_LAS i32x4* tab; int ntiles, nN, G, c;
    __device__ bool next(int i, Unit& u) const { const int L = i * G + c; if (L >= ntiles * 4) return false; u.pm = L >> 2; u.pn = L & 3; return true; }
    __device__ __forceinline__ size_t b_off(const Unit& u, int K) const { const int e = __builtin_amdgcn_readfirstlane(tab[u.pm].x); return ((size_t)e * nN + u.pn) * BM * K * 2; }
};
struct MoeGatherOrder : MoeOrder {
    static constexpr bool GATHER = true;
    const int* list;
    __device__ __forceinline__ int a_row(const Unit& u, int r) const { const i32x4 t = tab[u.pm]; const int i = t.y + r; return i < t.z ? list[(size_t)t.x * T + i] : 0; }
};
__device__ __forceinline__ unsigned cvt_pk_bf16(float lo, float hi) { unsigned r; asm volatile("v_cvt_pk_bf16_f32 %0, %1, %2" : "=v"(r) : "v"(lo), "v"(hi)); return r; }

struct EpiStoreBf16 {
    static constexpr bool PERM = true;
    bf16_t* O; int ldc; const float* rowscale;
    __device__ __forceinline__ void operator()(const f32x4 (&acc)[2][2][4][2], const Unit& u, int wr, int wc, int fr, int fq) const {
        const int row0 = u.pm * BM + wr * 64 + fr, col0 = u.pn * BM + wc * 32 + 8 * fq;
#pragma unroll
        for (int ai = 0; ai < 2; ++ai)
#pragma unroll
            for (int m = 0; m < 4; ++m) { const int row = row0 + ai * HALF + m * 16; bf16_t* rowp = O + (size_t)row * ldc + col0; const float sc = rowscale ? rowscale[row] : 1.f;
#pragma unroll
                for (int bj = 0; bj < 2; ++bj) { f32x4 v0 = acc[ai][bj][m][0] * sc, v1 = acc[ai][bj][m][1] * sc;
                    u32x4 w; w.x = cvt_pk_bf16(v0[0], v0[1]); w.y = cvt_pk_bf16(v0[2], v0[3]); w.z = cvt_pk_bf16(v1[0], v1[1]); w.w = cvt_pk_bf16(v1[2], v1[3]);
                    *(u32x4*)(rowp + bj * HALF) = w; } }
    }
};
struct EpiNull {
    static constexpr bool PERM = true;
    __device__ __forceinline__ void operator()(const f32x4 (&acc)[2][2][4][2], const Unit& u, int wr, int wc, int fr, int fq) const {
#pragma unroll
        for (int ai = 0; ai < 2; ++ai)
#pragma unroll
            for (int bj = 0; bj < 2; ++bj)
#pragma unroll
                for (int m = 0; m < 4; ++m)
#pragma unroll
                    for (int n = 0; n < 2; ++n) asm volatile("" :: "v"(acc[ai][bj][m][n]));
    }
};
struct EpiSwiglu {
    static constexpr bool PERM = true;
    bf16_t* O;
    __device__ __forceinline__ void operator()(const f32x4 (&acc)[2][2][4][2], const Unit& u, int wr, int wc, int fr, int fq) const {
        const int row0 = u.pm * BM + wr * 64 + fr, col0 = u.pn * HALF + wc * 32 + 8 * fq;
#pragma unroll
        for (int ai = 0; ai < 2; ++ai)
#pragma unroll
            for (int m = 0; m < 4; ++m) { bf16_t* rowp = O + (size_t)(row0 + ai * HALF + m * 16) * FF + col0; float o[8];
#pragma unroll
                for (int n = 0; n < 2; ++n)
#pragma unroll
                    for (int j = 0; j < 4; ++j) { const float g = acc[ai][0][m][n][j], up = acc[ai][1][m][n][j]; o[4 * n + j] = g * __builtin_amdgcn_rcpf(1.f + __expf(-g)) * up; }
                u32x4 w; w.x = cvt_pk_bf16(o[0], o[1]); w.y = cvt_pk_bf16(o[2], o[3]); w.z = cvt_pk_bf16(o[4], o[5]); w.w = cvt_pk_bf16(o[6], o[7]);
                *(u32x4*)rowp = w; }
    }
};
struct EpiResidual {
    static constexpr bool PERM = false;
    const float* srcL; float* dstL; const float* srcC; float* dstC; const float* gate; float on;
    __device__ __forceinline__ void operator()(const f32x4 (&acc)[2][2][4][2], const Unit& u, int wr, int wc, int fr, int fq) const {
        const int row0 = u.pm * BM + wr * 64 + fr, col0 = u.pn * BM + wc * 32 + 4 * fq;
        const bool lat = (u.pm * BM) < TL; const int mrow = lat ? (u.pm * BM) / S : 2;
        const float* gp = gate + (size_t)mrow * 6 * D + col0;
        f32x4 gv[2][2];
#pragma unroll
        for (int bj = 0; bj < 2; ++bj)
#pragma unroll
            for (int n = 0; n < 2; ++n) gv[bj][n] = *(const f32x4*)(gp + bj * HALF + n * 16) * on;
        const float* sb = lat ? srcL : srcC - (size_t)TL * D; float* db = lat ? dstL : dstC - (size_t)TL * D;
#pragma unroll
        for (int ai = 0; ai < 2; ++ai)
#pragma unroll
            for (int m = 0; m < 4; ++m) { const size_t ro = (size_t)(row0 + ai * HALF + m * 16) * D + col0;
#pragma unroll
                for (int bj = 0; bj < 2; ++bj)
#pragma unroll
                    for (int n = 0; n < 2; ++n) { const f32x4 xv = *(const f32x4*)(sb + ro + bj * HALF + n * 16); *(f32x4*)(db + ro + bj * HALF + n * 16) = xv + gv[bj][n] * acc[ai][bj][m][n]; } }
    }
};

struct EpiResInit {
    static constexpr bool PERM = true;
    const bf16_t* src; bf16_t* dst;
    __device__ __forceinline__ void init(f32x4 (&acc)[2][2][4][2], const Unit& u, int wr, int wc, int fr, int fq) const {
        const int row0 = u.pm * BM + wr * 64 + fr, col0 = u.pn * BM + wc * 32 + 8 * fq;
#pragma unroll
        for (int ai = 0; ai < 2; ++ai)
#pragma unroll
            for (int m = 0; m < 4; ++m) { const bf16_t* rowp = src + (size_t)(row0 + ai * HALF + m * 16) * D + col0;
#pragma unroll
                for (int bj = 0; bj < 2; ++bj) { const u32x4 w = *(const u32x4*)(rowp + bj * HALF);
                    acc[ai][bj][m][0] = (f32x4){bflo(w.x), bfhi(w.x), bflo(w.y), bfhi(w.y)}; acc[ai][bj][m][1] = (f32x4){bflo(w.z), bfhi(w.z), bflo(w.w), bfhi(w.w)}; } }
    }
    __device__ __forceinline__ void operator()(const f32x4 (&acc)[2][2][4][2], const Unit& u, int wr, int wc, int fr, int fq) const {
        const int row0 = u.pm * BM + wr * 64 + fr, col0 = u.pn * BM + wc * 32 + 8 * fq;
#pragma unroll
        for (int ai = 0; ai < 2; ++ai)
#pragma unroll
            for (int m = 0; m < 4; ++m) { bf16_t* rowp = dst + (size_t)(row0 + ai * HALF + m * 16) * D + col0;
#pragma unroll
                for (int bj = 0; bj < 2; ++bj) { const f32x4 v0 = acc[ai][bj][m][0], v1 = acc[ai][bj][m][1];
                    u32x4 w; w.x = cvt_pk_bf16(v0[0], v0[1]); w.y = cvt_pk_bf16(v0[2], v0[3]); w.z = cvt_pk_bf16(v1[0], v1[1]); w.w = cvt_pk_bf16(v1[2], v1[3]);
                    *(u32x4*)(rowp + bj * HALF) = w; } }
    }
};
struct ResOrder : StaticOrder {
    __device__ __forceinline__ size_t b_off(const Unit& u, int K) const { const int m = (u.pm * BM) < TL ? (u.pm * BM) / S : 2; return ((size_t)m * 4 + u.pn) * BM * K * 2; }
};
template <class E_> struct has_init { template <class T_> static auto test(int) -> decltype(&T_::init, char()); template <class> static long test(...); static constexpr bool value = sizeof(test<E_>(0)) == 1; };
template <class Epi, class Sched, bool ALIGN_EPI = true>
__device__ __forceinline__ void gemm_phase(PG8_LAS unsigned char* lds, const Gemm g, const Sched& S_, const Epi& E, const int tid) {
    const int wid = __builtin_amdgcn_readfirstlane(tid >> 6), lane = tid & 63, wr = wid >> 2, wc = wid & 3, fr = lane & 15, fq = lane >> 4;
    const int K = g.K, lda = g.lda, nt = K / BK;
    unsigned voffA[2], voffB[2];
#pragma unroll
    for (int i = 0; i < 2; ++i) { int R, C; stage_rc(tid * 16 + i * 8192, R, C); const int Rb = Epi::PERM ? ((R & ~31) + perm32(R & 31)) : R;
        voffA[i] = (unsigned)(R * lda + C) * 2u; voffB[i] = (unsigned)(Rb * K + C) * 2u; }
    const size_t kstep = (size_t)(BK * 2);
    const size_t hsA = (size_t)HALF * lda * 2, hsB = (size_t)HALF * K * 2;
    const size_t tstepA = 2 * hsA;
    const unsigned ldsw = (unsigned)wid * 1024u;
    const int aoff = lds_byte(wr * 64 + fr, fq * 8), boff = lds_byte(wc * 32 + fr, fq * 8);
#define PG8_SA(b, h) (((b) * 2 + (h)) * HTB)
#define PG8_SB(b, h) ((4 + (b) * 2 + (h)) * HTB)
#define PG8_STAGE(bufoff, gbase, voff) do { _Pragma("unroll") for (int _i = 0; _i < 2; ++_i) \
        __builtin_amdgcn_global_load_lds((const unsigned*)((const char*)(gbase) + (voff)[_i]), (PG8_LAS unsigned*)(lds + (bufoff) + ldsw + _i * 8192), 16, 0, 0); } while (0)
#define PG8_LDA(dst, b, h) do { _Pragma("unroll") for (int m = 0; m < 4; ++m) _Pragma("unroll") for (int k = 0; k < 2; ++k) dst[m][k] = *(const PG8_LAS bf16x8*)(lds + PG8_SA(b, h) + aoff + m * 2048 + k * 1024); } while (0)
#define PG8_LDB(dst, b, h) do { _Pragma("unroll") for (int n = 0; n < 2; ++n) _Pragma("unroll") for (int k = 0; k < 2; ++k) dst[n][k] = *(const PG8_LAS bf16x8*)(lds + PG8_SB(b, h) + boff + n * 2048 + k * 1024); } while (0)
#define PG8_MMA(ai, bj, At, Bt) do { __builtin_amdgcn_s_setprio(1); _Pragma("unroll") for (int m = 0; m < 4; ++m) _Pragma("unroll") for (int n = 0; n < 2; ++n) _Pragma("unroll") for (int k = 0; k < 2; ++k) \
        acc[ai][bj][m][n] = __builtin_amdgcn_mfma_f32_16x16x32_bf16(Bt[n][k], At[m][k], acc[ai][bj][m][n], 0, 0, 0); __builtin_amdgcn_s_setprio(0); } while (0)
#define PG8_WAIT_V(n) asm volatile("s_waitcnt vmcnt(" #n ")" ::: "memory")
#define PG8_WAIT_L(n) asm volatile("s_waitcnt lgkmcnt(" #n ")" ::: "memory")
#define PG8_BAR __builtin_amdgcn_s_barrier()
#define PG8_SCHED __builtin_amdgcn_sched_barrier(0)
    Unit cur, nxt; int ui = 0;
    if (!S_.next(0, cur)) return;
    f32x4 acc[2][2][4][2];
    if constexpr (has_init<Epi>::value) E.init(acc, cur, wr, wc, fr, fq); else {
#pragma unroll
    for (int a = 0; a < 2; ++a)
#pragma unroll
        for (int b = 0; b < 2; ++b)
#pragma unroll
            for (int m = 0; m < 4; ++m)
#pragma unroll
                for (int n = 0; n < 2; ++n) acc[a][b][m][n] = (f32x4){0.f, 0.f, 0.f, 0.f}; }
    bf16x8 At[4][2], B0[2][2], B1[2][2];
    const char* cA = (const char*)g.A + (size_t)cur.pm * tstepA; const char* cB = (const char*)g.Bt + S_.b_off(cur, K);
    PG8_STAGE(PG8_SB(0, 0), cB, voffB); PG8_STAGE(PG8_SB(0, 1), cB + hsB, voffB); PG8_STAGE(PG8_SA(0, 0), cA, voffA); PG8_STAGE(PG8_SA(0, 1), cA + hsA, voffA);
    if (wr == 1) PG8_BAR;
    PG8_WAIT_V(2); PG8_BAR;
    PG8_STAGE(PG8_SB(1, 0), cB + kstep, voffB); PG8_STAGE(PG8_SA(1, 0), cA + kstep, voffA); PG8_STAGE(PG8_SB(1, 1), cB + hsB + kstep, voffB);
    PG8_WAIT_V(6); PG8_BAR;
    for (;;) {
        const bool has_next = S_.next(ui + 1, nxt);
        const char* nA = has_next ? (const char*)g.A + (size_t)nxt.pm * tstepA : cA; const char* nB = has_next ? (const char*)g.Bt + S_.b_off(nxt, K) : cB;
        for (int t = 0; t < nt; t += 2) {
            const bool last = (t == nt - 2);
            const char* a1 = cA + (size_t)(t + 1) * kstep;
            const char* a2 = last ? nA : cA + (size_t)(t + 2) * kstep; const char* b2 = last ? nB : cB + (size_t)(t + 2) * kstep;
            const char* a3 = a2 + kstep; const char* b3 = b2 + kstep;
            PG8_LDB(B0, 0, 0); PG8_LDB(B1, 0, 1); PG8_SCHED; PG8_LDA(At, 0, 0); PG8_STAGE(PG8_SA(1, 1), a1 + hsA, voffA);
            PG8_WAIT_V(8); PG8_WAIT_L(0); PG8_BAR; PG8_MMA(0, 0, At, B0); PG8_MMA(0, 1, At, B1); PG8_BAR; PG8_SCHED;
            PG8_LDA(At, 0, 1); PG8_STAGE(PG8_SB(0, 0), b2, voffB); PG8_STAGE(PG8_SB(0, 1), b2 + hsB, voffB); PG8_STAGE(PG8_SA(0, 0), a2, voffA);
            PG8_WAIT_V(8); PG8_WAIT_L(0); PG8_BAR; PG8_MMA(1, 0, At, B0); PG8_MMA(1, 1, At, B1); PG8_BAR; PG8_SCHED;
            PG8_LDB(B0, 1, 0); PG8_LDB(B1, 1, 1); PG8_SCHED; PG8_LDA(At, 1, 0); PG8_STAGE(PG8_SA(0, 1), a2 + hsA, voffA);
            PG8_WAIT_V(8); PG8_WAIT_L(0); PG8_BAR; PG8_MMA(0, 0, At, B0); PG8_MMA(0, 1, At, B1); PG8_BAR; PG8_SCHED;
            PG8_LDA(At, 1, 1); PG8_STAGE(PG8_SB(1, 0), b3, voffB); PG8_STAGE(PG8_SB(1, 1), b3 + hsB, voffB); PG8_STAGE(PG8_SA(1, 0), a3, voffA);
            PG8_WAIT_V(8); PG8_WAIT_L(0); PG8_BAR; PG8_MMA(1, 0, At, B0); PG8_MMA(1, 1, At, B1); PG8_BAR; PG8_SCHED;
        }
        if constexpr (ALIGN_EPI) { if (wr == 0) PG8_BAR; }
        E(acc, cur, wr, wc, fr, fq);
        if (!has_next) break;
        if constexpr (has_init<Epi>::value) E.init(acc, nxt, wr, wc, fr, fq); else {
#pragma unroll
        for (int a = 0; a < 2; ++a)
#pragma unroll
            for (int b = 0; b < 2; ++b)
#pragma unroll
                for (int m = 0; m < 4; ++m)
#pragma unroll
                    for (int n = 0; n < 2; ++n) acc[a][b][m][n] = (f32x4){0.f, 0.f, 0.f, 0.f}; }
        cur = nxt; cA = nA; cB = nB; ++ui;
        if constexpr (ALIGN_EPI) { if (wr == 1) PG8_BAR; }
    }
    PG8_WAIT_V(0);
    if constexpr (!ALIGN_EPI) { if (wr == 0) PG8_BAR; }
    PG8_BAR;
#undef PG8_SA
#undef PG8_SB
#undef PG8_STAGE
#undef PG8_LDA
#undef PG8_LDB
#undef PG8_MMA
#undef PG8_WAIT_V
#undef PG8_WAIT_L
#undef PG8_BAR
#undef PG8_SCHED
}
template <class Epi, class Sched, bool ALIGN_EPI = true>
__device__ __forceinline__ void gemm_phase_gather(PG8_LAS unsigned char* lds, const Gemm g, const Sched& S_, const Epi& E, const int tid) {
    const int wid = __builtin_amdgcn_readfirstlane(tid >> 6), lane = tid & 63, wr = wid >> 2, wc = wid & 3, fr = lane & 15, fq = lane >> 4;
    const int K = g.K, lda = g.lda, nt = K / BK;
    unsigned voffB[2], cofs[2]; int rA[2];
#pragma unroll
    for (int i = 0; i < 2; ++i) { int R, C; stage_rc(tid * 16 + i * 8192, R, C); const int Rb = Epi::PERM ? ((R & ~31) + perm32(R & 31)) : R;
        rA[i] = R; cofs[i] = (unsigned)C * 2u; voffB[i] = (unsigned)(Rb * K + C) * 2u; }
    unsigned vc[2][2], vn[2][2];
#define PG8_ROWS(dst, unit) do { _Pragma("unroll") for (int h_ = 0; h_ < 2; ++h_) _Pragma("unroll") for (int i_ = 0; i_ < 2; ++i_) dst[h_][i_] = (unsigned)S_.a_row(unit, 128 * h_ + rA[i_]) * (unsigned)(lda * 2) + cofs[i_]; } while (0)
#define PG8_STAGE_G(bufoff, kbyte, v) do { _Pragma("unroll") for (int _i = 0; _i < 2; ++_i) \
        __builtin_amdgcn_global_load_lds((const unsigned*)((const char*)g.A + (kbyte) + (v)[_i]), (PG8_LAS unsigned*)(lds + (bufoff) + ldsw + _i * 8192), 16, 0, 0); } while (0)
    const size_t kstep = (size_t)(BK * 2);
    const size_t hsB = (size_t)HALF * K * 2;
    const unsigned ldsw = (unsigned)wid * 1024u;
    const int aoff = lds_byte(wr * 64 + fr, fq * 8), boff = lds_byte(wc * 32 + fr, fq * 8);
#define PG8_SA(b, h) (((b) * 2 + (h)) * HTB)
#define PG8_SB(b, h) ((4 + (b) * 2 + (h)) * HTB)
#define PG8_STAGE(bufoff, gbase, voff) do { _Pragma("unroll") for (int _i = 0; _i < 2; ++_i) \
        __builtin_amdgcn_global_load_lds((const unsigned*)((const char*)(gbase) + (voff)[_i]), (PG8_LAS unsigned*)(lds + (bufoff) + ldsw + _i * 8192), 16, 0, 0); } while (0)
#define PG8_LDA(dst, b, h) do { _Pragma("unroll") for (int m = 0; m < 4; ++m) _Pragma("unroll") for (int k = 0; k < 2; ++k) dst[m][k] = *(const PG8_LAS bf16x8*)(lds + PG8_SA(b, h) + aoff + m * 2048 + k * 1024); } while (0)
#define PG8_LDB(dst, b, h) do { _Pragma("unroll") for (int n = 0; n < 2; ++n) _Pragma("unroll") for (int k = 0; k < 2; ++k) dst[n][k] = *(const PG8_LAS bf16x8*)(lds + PG8_SB(b, h) + boff + n * 2048 + k * 1024); } while (0)
#define PG8_MMA(ai, bj, At, Bt) do { __builtin_amdgcn_s_setprio(1); _Pragma("unroll") for (int m = 0; m < 4; ++m) _Pragma("unroll") for (int n = 0; n < 2; ++n) _Pragma("unroll") for (int k = 0; k < 2; ++k) \
        acc[ai][bj][m][n] = __builtin_amdgcn_mfma_f32_16x16x32_bf16(Bt[n][k], At[m][k], acc[ai][bj][m][n], 0, 0, 0); __builtin_amdgcn_s_setprio(0); } while (0)
#define PG8_WAIT_V(n) asm volatile("s_waitcnt vmcnt(" #n ")" ::: "memory")
#define PG8_WAIT_L(n) asm volatile("s_waitcnt lgkmcnt(" #n ")" ::: "memory")
#define PG8_BAR __builtin_amdgcn_s_barrier()
#define PG8_SCHED __builtin_amdgcn_sched_barrier(0)
    Unit cur, nxt; int ui = 0;
    if (!S_.next(0, cur)) return;
    f32x4 acc[2][2][4][2];
#pragma unroll
    for (int a = 0; a < 2; ++a)
#pragma unroll
        for (int b = 0; b < 2; ++b)
#pragma unroll
            for (int m = 0; m < 4; ++m)
#pragma unroll
                for (int n = 0; n < 2; ++n) acc[a][b][m][n] = (f32x4){0.f, 0.f, 0.f, 0.f};
    bf16x8 At[4][2], B0[2][2], B1[2][2];
    const char* cB = (const char*)g.Bt + S_.b_off(cur, K); PG8_ROWS(vc, cur);
    PG8_STAGE(PG8_SB(0, 0), cB, voffB); PG8_STAGE(PG8_SB(0, 1), cB + hsB, voffB); PG8_STAGE_G(PG8_SA(0, 0), 0, vc[0]); PG8_STAGE_G(PG8_SA(0, 1), 0, vc[1]);
    if (wr == 1) PG8_BAR;
    PG8_WAIT_V(2); PG8_BAR;
    PG8_STAGE(PG8_SB(1, 0), cB + kstep, voffB); PG8_STAGE_G(PG8_SA(1, 0), kstep, vc[0]); PG8_STAGE(PG8_SB(1, 1), cB + hsB + kstep, voffB);
    PG8_WAIT_V(6); PG8_BAR;
    for (;;) {
        const bool has_next = S_.next(ui + 1, nxt);
        const char* nB = has_next ? (const char*)g.Bt + S_.b_off(nxt, K) : cB;
        if (has_next) PG8_ROWS(vn, nxt); else { _Pragma("unroll") for (int h_ = 0; h_ < 2; ++h_) _Pragma("unroll") for (int i_ = 0; i_ < 2; ++i_) vn[h_][i_] = vc[h_][i_]; }
        for (int t = 0; t < nt; t += 2) {
            const bool last = (t == nt - 2);
            const size_t a1 = (size_t)(t + 1) * kstep, a2 = last ? 0 : (size_t)(t + 2) * kstep, a3 = a2 + kstep; const char* b2 = last ? nB : cB + (size_t)(t + 2) * kstep; const char* b3 = b2 + kstep;
            unsigned w0[2], w1[2];
#pragma unroll
            for (int i_ = 0; i_ < 2; ++i_) { w0[i_] = last ? vn[0][i_] : vc[0][i_]; w1[i_] = last ? vn[1][i_] : vc[1][i_]; }
            PG8_LDB(B0, 0, 0); PG8_LDB(B1, 0, 1); PG8_SCHED; PG8_LDA(At, 0, 0); PG8_STAGE_G(PG8_SA(1, 1), a1, vc[1]);
            PG8_WAIT_V(8); PG8_WAIT_L(0); PG8_BAR; PG8_MMA(0, 0, At, B0); PG8_MMA(0, 1, At, B1); PG8_BAR; PG8_SCHED;
            PG8_LDA(At, 0, 1); PG8_STAGE(PG8_SB(0, 0), b2, voffB); PG8_STAGE(PG8_SB(0, 1), b2 + hsB, voffB); PG8_STAGE_G(PG8_SA(0, 0), a2, w0);
            PG8_WAIT_V(8); PG8_WAIT_L(0); PG8_BAR; PG8_MMA(1, 0, At, B0); PG8_MMA(1, 1, At, B1); PG8_BAR; PG8_SCHED;
            PG8_LDB(B0, 1, 0); PG8_LDB(B1, 1, 1); PG8_SCHED; PG8_LDA(At, 1, 0); PG8_STAGE_G(PG8_SA(0, 1), a2, w1);
            PG8_WAIT_V(8); PG8_WAIT_L(0); PG8_BAR; PG8_MMA(0, 0, At, B0); PG8_MMA(0, 1, At, B1); PG8_BAR; PG8_SCHED;
            PG8_LDA(At, 1, 1); PG8_STAGE(PG8_SB(1, 0), b3, voffB); PG8_STAGE(PG8_SB(1, 1), b3 + hsB, voffB); PG8_STAGE_G(PG8_SA(1, 0), a3, w0);
            PG8_WAIT_V(8); PG8_WAIT_L(0); PG8_BAR; PG8_MMA(1, 0, At, B0); PG8_MMA(1, 1, At, B1); PG8_BAR; PG8_SCHED;
        }
        if constexpr (ALIGN_EPI) { if (wr == 0) PG8_BAR; }
        E(acc, cur, wr, wc, fr, fq);
        if (!has_next) break;
#pragma unroll
        for (int a = 0; a < 2; ++a)
#pragma unroll
            for (int b = 0; b < 2; ++b)
#pragma unroll
                for (int m = 0; m < 4; ++m)
#pragma unroll
                    for (int n = 0; n < 2; ++n) acc[a][b][m][n] = (f32x4){0.f, 0.f, 0.f, 0.f};
        cur = nxt; cB = nB; ++ui;
#pragma unroll
        for (int h_ = 0; h_ < 2; ++h_)
#pragma unroll
            for (int i_ = 0; i_ < 2; ++i_) vc[h_][i_] = vn[h_][i_];
        if constexpr (ALIGN_EPI) { if (wr == 1) PG8_BAR; }
    }
    PG8_WAIT_V(0);
    if constexpr (!ALIGN_EPI) { if (wr == 0) PG8_BAR; }
    PG8_BAR;
#undef PG8_SA
#undef PG8_SB
#undef PG8_STAGE
#undef PG8_STAGE_G
#undef PG8_ROWS
#undef PG8_LDA
#undef PG8_LDB
#undef PG8_MMA
#undef PG8_WAIT_V
#undef PG8_WAIT_L
#undef PG8_BAR
#undef PG8_SCHED
}
}

#define XB_TMO      128
#define XB_XCNT(j)  (256  + 64 * (j))
#define XB_XSUB(j)  (1280 + 64 * (j))
#define XB_XGEN(j)  (2304 + 64 * (j))
#define XB_TOP      3328
#define XB_TOPGEN   3392
#define XCD_BAR_WORDS 3456
#define XB_SPIN_CAP (1u << 20)
__device__ __forceinline__ unsigned xb_ld(unsigned* p)              { return __hip_atomic_load(p, __ATOMIC_RELAXED, __HIP_MEMORY_SCOPE_AGENT); }
__device__ __forceinline__ unsigned xb_add(unsigned* p, unsigned v) { return __hip_atomic_fetch_add(p, v, __ATOMIC_RELAXED, __HIP_MEMORY_SCOPE_AGENT); }
__device__ __forceinline__ unsigned xb_xcc_id() { return (unsigned)__builtin_amdgcn_s_getreg((3 << 11) | 20) & 0xFu; }
#define XB_SPIN(cond, bar) do { unsigned _sp = 0; while (cond) { __builtin_amdgcn_s_sleep(1); \
    if ((++_sp & 255u) == 0u) { if (xb_ld(&(bar)[XB_TMO])) break; if (_sp > XB_SPIN_CAP) { atomicAdd(&(bar)[XB_TMO], 1u); break; } } } } while (0)
struct XcdBarrier { unsigned* bar; unsigned x; volatile LAS unsigned* st; };
__device__ __forceinline__ XcdBarrier xcd_barrier_post(unsigned* bar, volatile LAS unsigned* st) {
    XcdBarrier b; b.bar = bar; b.x = xb_xcc_id(); b.st = st;
    if (threadIdx.x == 0) (void)xb_add(&bar[XB_XCNT(b.x)], 1u);
    return b;
}
__device__ __forceinline__ void xcd_barrier_complete(unsigned* bar, unsigned x, unsigned& nloc, unsigned& nx) {
    const unsigned G = gridDim.x * gridDim.y * gridDim.z;
    unsigned sum, cnt, mine, sp = 0u;
    for (;;) {
        sum = 0u; cnt = 0u; mine = 0u;
#pragma unroll
        for (unsigned j = 0; j < 16; ++j) { const unsigned c = xb_ld(&bar[XB_XCNT(j)]); sum += c; cnt += (c > 0u) ? 1u : 0u; mine = (j == x) ? c : mine; }
        if (sum == G) break;
        __builtin_amdgcn_s_sleep(1);
        if ((++sp & 255u) == 0u) { if (xb_ld(&bar[XB_TMO])) break; if (sp > XB_SPIN_CAP) { atomicAdd(&bar[XB_TMO], 1u); break; } }
    }
    nloc = mine > 0u ? mine : 1u; nx = cnt > 0u ? cnt : 1u;
}
__device__ __forceinline__ void xcd_barrier(const XcdBarrier& b) {
    asm volatile("s_waitcnt vmcnt(0)" ::: "memory");
    __syncthreads();
    if (threadIdx.x == 0) {
        unsigned* bar = b.bar;
        __builtin_amdgcn_s_waitcnt(0);
        unsigned nloc = b.st[0], nx = b.st[1];
        if (nloc == 0u) { xcd_barrier_complete(bar, b.x, nloc, nx); b.st[0] = nloc; b.st[1] = nx; }
        const unsigned old = xb_add(&bar[XB_XSUB(b.x)], 1u);
        const unsigned gen = old / nloc;
        if (old + 1u == (gen + 1u) * nloc) {
            __builtin_amdgcn_fence(__ATOMIC_RELEASE, "agent");
            asm volatile("s_waitcnt vmcnt(0)" ::: "memory");
            const unsigned og = xb_add(&bar[XB_TOP], 1u);
            const unsigned tg = og / nx;
            if (og + 1u == (tg + 1u) * nx) xb_add(&bar[XB_TOPGEN], 1u);
            else XB_SPIN(xb_ld(&bar[XB_TOPGEN]) == tg, bar);
            __builtin_amdgcn_fence(__ATOMIC_ACQUIRE, "agent");
            xb_add(&bar[XB_XGEN(b.x)], 1u);
            asm volatile("s_waitcnt vmcnt(0)" ::: "memory");
        } else {
            XB_SPIN(xb_ld(&bar[XB_XGEN(b.x)]) == gen, bar);
            __builtin_amdgcn_fence(__ATOMIC_ACQUIRE, "agent");
            asm volatile("s_waitcnt vmcnt(0)" ::: "memory");
        }
    }
    __syncthreads();
}

struct Args { const float* in[36]; float* out; unsigned char* ws; int ph_lo, ph_hi; };
struct Frame {
    LAS unsigned char* lds;
    const LAS unsigned long long* in; float* out; unsigned char* ws;
    int tid, lane, wave, vcu, G, gw, NGW, bx;
};
enum { I_X = 0, I_C, I_CTX, I_CCTX, I_ADAW, I_ADAB, I_NORMG, I_EVWIN, I_EVWOUT, I_POOLW, I_POOLS, I_SWAQG, I_SWAKG, I_SINK, I_ODWIN, I_ODWOUT, I_HYCW, I_HYCB,
       I_HYW1, I_HYB1, I_HYW2, I_HYB2, I_HYW3, I_HYFREQ, I_HYSKIP, I_CQG, I_CKVG, I_WUQ, I_WUKV, I_MQG, I_MKG, I_RW, I_RB, I_MG, I_MU, I_MD };

__device__ __forceinline__ const float* inp(const Frame& F, int i) { const unsigned long long v = F.in[i];
    const unsigned lo = __builtin_amdgcn_readfirstlane((unsigned)v), hi = __builtin_amdgcn_readfirstlane((unsigned)(v >> 32)); return (const float*)(((unsigned long long)hi << 32) | lo); }
__device__ __forceinline__ float* mod_ptr(const Frame& F, int l, int m) { return (float*)(F.ws + WS_MISC + MISC_MOD) + ((size_t)l * 3 + m) * 6 * D; }
__device__ __forceinline__ int* tile_e_ptr(const Frame& F, int l) { return (int*)(F.ws + WS_MISC + MISC_TILEE) + l * 288; }
__device__ __forceinline__ unsigned* cnt_ptr(const Frame& F, int l) { return (unsigned*)(F.ws + WS_CTL) + CW_CNT + 64 * NE * l; }
__device__ __forceinline__ const float* xsrc_row(const Frame& F, int l, int r) {
    if (r < TL) return (l == 0 ? inp(F, I_X) : F.out) + (size_t)r * D;
    return (l == 0 ? inp(F, I_CTX) : (const float*)(F.ws + WS_XC)) + (size_t)(r - TL) * D;
}
__device__ __forceinline__ bf16* hb_row(const Frame& F, int r) { return (bf16*)(F.ws + WS_HB) + (size_t)r * D; }
__device__ __forceinline__ float* xdst_row(const Frame& F, int r) { return r < TL ? F.out + (size_t)r * D : (float*)(F.ws + WS_XC) + (size_t)(r - TL) * D; }

template <class RowMap>
__device__ __forceinline__ void tr_item(const float* W, int N, bf16* WT, int Kd, int k0, int n0, LAS float* scr, int lane, RowMap rm) {
#pragma unroll 8
    for (int i = 0; i < 32; ++i) { const int kk = 2 * i + (lane >> 5); scr[kk * 33 + (lane & 31)] = W[(size_t)(k0 + kk) * N + n0 + (lane & 31)]; }
    LDS_WAIT(); asm volatile("" ::: "memory");
    const int c = lane & 7;
#pragma unroll
    for (int j = 0; j < 4; ++j) { const int n = (lane >> 3) + 8 * j; const LAS float* s = scr + (8 * c) * 33 + n;
        u32x4 o; o.x = pk2(s[0 * 33], s[1 * 33]); o.y = pk2(s[2 * 33], s[3 * 33]); o.z = pk2(s[4 * 33], s[5 * 33]); o.w = pk2(s[6 * 33], s[7 * 33]);
        *(u32x4*)(WT + (size_t)rm(n0 + n) * Kd + k0 + 8 * c) = o; }
    LDS_WAIT(); asm volatile("" ::: "memory");
}
template <class RowMap>
__device__ __forceinline__ void tr_item64(const float* W, int N, bf16* WT, int Kd, int k0, int n0, int nvalid, LAS float* scr, int lane, RowMap rm, const float* colscale = nullptr, float on = 1.f) {
    const int c4 = (lane & 15) * 4; f32x4 cs4 = {1.f, 1.f, 1.f, 1.f}; if (colscale) cs4 = *(const f32x4*)(colscale + n0 + c4) * on;
#pragma unroll 4
    for (int i = 0; i < 16; ++i) { const int kk = 4 * i + (lane >> 4); f32x4 w = {0.f, 0.f, 0.f, 0.f};
        if (c4 < nvalid) w = *(const f32x4*)(W + (size_t)(k0 + kk) * N + n0 + c4) * cs4;
        LAS float* d = scr + kk * 65 + c4; d[0] = w.x; d[1] = w.y; d[2] = w.z; d[3] = w.w; }
    LDS_WAIT(); asm volatile("" ::: "memory");
    const int c = lane & 7;
#pragma unroll
    for (int j = 0; j < 8; ++j) { const int n = (lane >> 3) + 8 * j; const LAS float* s = scr + (8 * c) * 65 + n;
        u32x4 o; o.x = pk2(s[0 * 65], s[1 * 65]); o.y = pk2(s[2 * 65], s[3 * 65]); o.z = pk2(s[4 * 65], s[5 * 65]); o.w = pk2(s[6 * 65], s[7 * 65]);
        if (n < nvalid) *(u32x4*)(WT + (size_t)rm(n0 + n) * Kd + k0 + 8 * c) = o; }
    LDS_WAIT(); asm volatile("" ::: "memory");
}
struct RmId { __device__ __forceinline__ int operator()(int n) const { return n; } };
struct RmGate { int add; __device__ __forceinline__ int operator()(int n) const { return 256 * (n >> 7) + add + (n & 127); } };

__device__ __forceinline__ float silu_f(float v) { return v / (1.f + __expf(-v)); }

__device__ __forceinline__ void phase_prologue(Frame& F) {
    LAS float* scr = (LAS float*)(F.lds + F.wave * 16896);
    bf16* wsm = (bf16*)(F.ws + WS_WSM);
    {
        constexpr int I_EI = 16 * 24, I_EO = 16 * 16, I_OI = 16 * 31, I_OO = 16 * 16, PER = I_EI + I_EO + I_OI + I_OO;
        for (int it = F.gw; it < 2 * PER; it += F.NGW) {
            const int i = it / PER; int r = it % PER;
            if (r < I_EI) { tr_item64(inp(F, I_EVWIN) + (size_t)i * D * EV_N, EV_N, (bf16*)((char*)wsm + W_EIN) + (size_t)i * EV_N * D, D, 64 * (r / 24), 64 * (r % 24), 64, scr, F.lane, RmId{}); continue; } r -= I_EI;
            if (r < I_EO) { tr_item64(inp(F, I_EVWOUT) + (size_t)i * D * D, D, (bf16*)((char*)wsm + W_EOUT) + (size_t)i * D * D, D, 64 * (r / 16), 64 * (r % 16), 64, scr, F.lane, RmId{}); continue; } r -= I_EO;
            if (r < I_OI) { tr_item64(inp(F, I_ODWIN) + (size_t)i * D * OD_NR, OD_NR, (bf16*)((char*)wsm + W_OIN) + (size_t)i * OD_N * D, D, 64 * (r / 31), 64 * (r % 31), (r % 31) == 30 ? 32 : 64, scr, F.lane, RmId{}); continue; } r -= I_OI;
            tr_item64(inp(F, I_ODWOUT) + (size_t)i * D * D, D, (bf16*)((char*)wsm + W_OOUT) + (size_t)i * D * D, D, 64 * (r / 16), 64 * (r % 16), 64, scr, F.lane, RmId{});
        }
    }
    const int gt = F.gw * 64 + F.lane, NGT = F.NGW * 64;
    for (int idx = gt; idx < 2 * 96 * (D / 8); idx += NGT) { const int i = idx / (96 * (D / 8)), r = idx % (96 * (D / 8));
        *(u32x4*)((bf16*)((char*)wsm + W_OIN) + (size_t)i * OD_N * D + (size_t)(OD_NR + r / (D / 8)) * D + 8 * (r % (D / 8))) = (u32x4){0u, 0u, 0u, 0u}; }
    for (int idx = gt; idx < 2 * QU_N * 32; idx += NGT) { const int i = idx / (QU_N * 32), r = idx % (QU_N * 32), n = r / 32, kc = r % 32;
        const float* W = inp(F, I_WUQ) + (size_t)i * 256 * QU_N; const float* gn = inp(F, I_CQG) + i * 256; float v[8];
#pragma unroll
        for (int j = 0; j < 8; ++j) v[j] = W[(size_t)(8 * kc + j) * QU_N + n] * gn[8 * kc + j];
        *(u32x4*)((bf16*)((char*)wsm + W_UQ) + (size_t)i * QU_N * 256 + (size_t)n * 256 + 8 * kc) = (u32x4){pk2(v[0], v[1]), pk2(v[2], v[3]), pk2(v[4], v[5]), pk2(v[6], v[7])}; }
    for (int idx = gt; idx < 2 * KVU_N * 32; idx += NGT) { const int i = idx / (KVU_N * 32), r = idx % (KVU_N * 32), n = r / 32, kc = r % 32, h = n / 160, j = n % 160;
        const float* W = inp(F, I_WUKV) + (size_t)i * 128 * 1024; const float* gn = inp(F, I_CKVG) + i * 128; float v[8];
        const bool z = (kc >= 16) || (j >= 64 && j < 96); const int col = h * 128 + (j < 64 ? j : j - 32);
#pragma unroll
        for (int jj = 0; jj < 8; ++jj) v[jj] = z ? 0.f : W[(size_t)(8 * kc + jj) * 1024 + col] * gn[8 * kc + jj];
        *(u32x4*)((bf16*)((char*)wsm + W_UKV) + (size_t)i * KVU_N * 256 + (size_t)n * 256 + 8 * kc) = (u32x4){pk2(v[0], v[1]), pk2(v[2], v[3]), pk2(v[4], v[5]), pk2(v[6], v[7])}; }
    for (int idx = gt; idx < 128 * 128; idx += NGT) { const int kk = idx >> 7, nn = idx & 127; float sn, cs; sincospif(-(float)((kk * nn) & 127) * (1.f / 64.f), &sn, &cs);
        ((bf16*)(F.ws + WS_F128))[idx] = (bf16)f2bf(cs); ((bf16*)(F.ws + WS_F128))[128 * 128 + idx] = (bf16)f2bf(sn); }
    for (int idx = gt; idx < 2 * 4 * 64 * 8; idx += NGT) { const int lg = idx / 512, r = idx % 512, d = r / 8, kc = r % 8; const float* W = inp(F, I_POOLW) + (size_t)lg * 64 * 64; float v[8];
#pragma unroll
        for (int j = 0; j < 8; ++j) v[j] = W[(size_t)(8 * kc + j) * 64 + d];
        *(u32x4*)((bf16*)(F.ws + WS_WPT) + ((size_t)lg * 64 + d) * 64 + 8 * kc) = (u32x4){pk2(v[0], v[1]), pk2(v[2], v[3]), pk2(v[4], v[5]), pk2(v[6], v[7])}; }
    for (int idx = gt; idx < 2 * 1024 * 8; idx += NGT) { const int i = idx / 8192, r = idx % 8192, col = r / 8, kc = r % 8; const float* W = inp(F, I_HYW3) + (size_t)i * 64 * 1024; float v[8];
#pragma unroll
        for (int j = 0; j < 8; ++j) v[j] = W[(size_t)(8 * kc + j) * 1024 + col];
        *(u32x4*)((bf16*)(F.ws + WS_WT3) + ((size_t)i * 1024 + col) * 64 + 8 * kc) = (u32x4){pk2(v[0], v[1]), pk2(v[2], v[3]), pk2(v[4], v[5]), pk2(v[6], v[7])}; }
    { f32x2* r64 = (f32x2*)(F.ws + WS_ROPE); f32x2* r32 = r64 + (size_t)S * 32;
      for (int idx = gt; idx < S * 32; idx += NGT) { const int s = idx >> 5, i = idx & 31; const float pos = (float)(i < 16 ? s / GRID_W : s % GRID_W);
          const float inv = powf(10000.f, -(float)(i & 15) / 16.f); float sn, cs; sincosf(pos * inv, &sn, &cs); r64[idx] = (f32x2){cs, sn}; }
      for (int idx = gt; idx < S * 16; idx += NGT) { const int s = idx >> 4, i = idx & 15; const float pos = (float)(i < 8 ? s / GRID_W : s % GRID_W);
          const float inv = powf(10000.f, -(float)(i & 7) / 8.f); float sn, cs; sincosf(pos * inv, &sn, &cs); r32[idx] = (f32x2){cs, sn}; } }
    if (F.bx < 96) {
        __syncthreads();
        LAS float* sl = (LAS float*)(F.lds);
        LAS float* red = (LAS float*)(F.lds + 16384);
        for (int i = F.tid; i < 3 * D; i += NTHR) { const int m = i / D, k = i % D; sl[i] = silu_f(m < 2 ? inp(F, I_C)[m * D + k] : inp(F, I_CCTX)[k]); }
        __syncthreads();
        const int l = F.bx / 24, j0 = (F.bx % 24) * 256 + 4 * F.lane;
        const float* W = inp(F, I_ADAW) + (size_t)l * D * 6 * D + j0;
        f32x4 a0 = {0.f, 0.f, 0.f, 0.f}, a1 = a0, a2 = a0;
#pragma unroll 8
        for (int k = F.wave * 128; k < F.wave * 128 + 128; ++k) { const f32x4 w = *(const f32x4*)(W + (size_t)k * 6 * D); a0 += w * sl[k]; a1 += w * sl[D + k]; a2 += w * sl[2 * D + k]; }
        *(LAS f32x4*)(red + (F.wave * 3 + 0) * 256 + 4 * F.lane) = a0; *(LAS f32x4*)(red + (F.wave * 3 + 1) * 256 + 4 * F.lane) = a1; *(LAS f32x4*)(red + (F.wave * 3 + 2) * 256 + 4 * F.lane) = a2;
        __syncthreads();
        for (int i = F.tid; i < 3 * 256; i += NTHR) { const int m = i / 256, jj = i % 256; float s = inp(F, I_ADAB)[l * 6 * D + (F.bx % 24) * 256 + jj];
#pragma unroll
            for (int w = 0; w < 8; ++w) s += red[(w * 3 + m) * 256 + jj];
            mod_ptr(F, l, m)[(F.bx % 24) * 256 + jj] = s; }
        __syncthreads();
    }
}

__device__ __forceinline__ void moe_weight_convert(Frame& F, int l) {
    LAS float* scr = (LAS float*)(F.lds + F.wave * 16896);
    bf16* wgu = (bf16*)(F.ws + WS_WMOE); bf16* wd = wgu + (size_t)NE * 1024 * 1024;
    for (int it = F.gw; it < NE * 3 * 128; it += F.NGW) {
        const int e = it / 384, r = it % 384, which = r / 128, q = r % 128;
        if (which == 0)      tr_item64(inp(F, I_MG) + ((size_t)l * NE + e) * D * FF, FF, wgu + (size_t)e * 1024 * 1024, D, 64 * (q / 8), 64 * (q % 8), 64, scr, F.lane, RmGate{0});
        else if (which == 1) tr_item64(inp(F, I_MU) + ((size_t)l * NE + e) * D * FF, FF, wgu + (size_t)e * 1024 * 1024, D, 64 * (q / 8), 64 * (q % 8), 64, scr, F.lane, RmGate{128});
        else                 tr_item64(inp(F, I_MD) + ((size_t)l * NE + e) * FF * D, D, wd + (size_t)e * 1024 * FF, FF, 64 * (q / 16), 64 * (q % 16), 64, scr, F.lane, RmId{});
    }
}

__device__ __forceinline__ int moe_offsets(const Frame& F, int l, int (&off)[NE]) {
    const unsigned* cnt = cnt_ptr(F, l); int acc = 0;
#pragma unroll
    for (int e = 0; e < NE; ++e) { off[e] = acc; const int c = (int)__builtin_amdgcn_readfirstlane(__hip_atomic_load(cnt + 64 * e, __ATOMIC_RELAXED, __HIP_MEMORY_SCOPE_AGENT)); acc += ((c + 255) >> 8) << 8; }
    return acc >> 8;
}
__device__ __forceinline__ void wout_scaled_convert(Frame& F, int l, float on) {
    LAS float* scr = (LAS float*)(F.lds + F.wave * 16896);
    const float* W = (l & 1 ? inp(F, I_ODWOUT) : inp(F, I_EVWOUT)) + (size_t)(l >> 1) * D * D; bf16* wos = (bf16*)(F.ws + WS_WOS);
    for (int it = F.gw; it < 3 * 256; it += F.NGW) { const int m = it / 256, q = it % 256;
        tr_item64(W, D, wos + (size_t)m * D * D, D, 64 * (q / 16), 64 * (q % 16), 64, scr, F.lane, RmId{}, mod_ptr(F, l, m) + 2 * D, on); }
}
__device__ __forceinline__ int2 moe_pos(const int4 ri, const int (&off)[NE]) { int p0 = 0, p1 = 0;
#pragma unroll
    for (int e = 0; e < NE; ++e) { if (ri.x == e) p0 = off[e] + ri.y; if (ri.z == e) p1 = off[e] + ri.w; }
    return make_int2(p0, p1); }
__device__ __forceinline__ void moe_load_rows(const Frame& F, int2 pos, u32x2 (&y0)[4], u32x2 (&y1)[4]) {
    const bf16* ys = (const bf16*)(F.ws + A_YS);
#pragma unroll
    for (int j = 0; j < 4; ++j) { const int c = 4 * F.lane + 256 * j; y0[j] = *(const u32x2*)(ys + (size_t)pos.x * D + c); y1[j] = *(const u32x2*)(ys + (size_t)pos.y * D + c); }
}
__device__ __forceinline__ void moe_combine_row(const Frame& F, int lp, int r, f32x4 (&v)[4], float cs, const u32x2 (&y0a)[4], const u32x2 (&y1a)[4], f32x2 w) {
    const float* g2 = mod_ptr(F, lp, r < TL ? r / S : 2) + 5 * D;
#pragma unroll
    for (int j = 0; j < 4; ++j) { const int c = 4 * F.lane + 256 * j; const u32x2 y0 = y0a[j], y1 = y1a[j]; const f32x4 g = *(const f32x4*)(g2 + c) * cs;
        v[j].x += g.x * (w.x * bflo(y0.x) + w.y * bflo(y1.x)); v[j].y += g.y * (w.x * bfhi(y0.x) + w.y * bfhi(y1.x));
        v[j].z += g.z * (w.x * bflo(y0.y) + w.y * bflo(y1.y)); v[j].w += g.w * (w.x * bfhi(y0.y) + w.y * bfhi(y1.y)); }
}
__device__ __forceinline__ float row_rstd(const f32x4 (&v)[4]) {
    float s = 0.f;
#pragma unroll
    for (int j = 0; j < 4; ++j) s += (v[j].x * v[j].x + v[j].y * v[j].y) + (v[j].z * v[j].z + v[j].w * v[j].w);
    return 1.f / sqrtf(wave_sum(s) * (1.f / D) + EPS);
}
__device__ __forceinline__ void modulate_row(const Frame& F, int l, int which, int r, const f32x4 (&v)[4], float rstd, f32x4 (&h)[4]) {
    const float* gn = inp(F, I_NORMG) + ((size_t)l * 2 + which) * D; const float* mp = mod_ptr(F, l, r < TL ? r / S : 2) + (which ? 3 : 0) * D;
#pragma unroll
    for (int j = 0; j < 4; ++j) { const int c = 4 * F.lane + 256 * j; const f32x4 g = *(const f32x4*)(gn + c), sh = *(const f32x4*)(mp + c), sc = *(const f32x4*)(mp + D + c);
        h[j] = v[j] * rstd * g * (sc + 1.f) + sh; }
}
__device__ __forceinline__ void store_row_bf16(bf16* dst, int lane, const f32x4 (&h)[4]) {
#pragma unroll
    for (int j = 0; j < 4; ++j) *(u32x2*)(dst + 4 * lane + 256 * j) = (u32x2){pk2(h[j].x, h[j].y), pk2(h[j].z, h[j].w)};
}
struct ModCache { f32x4 gs[4], sh[4], g2[4]; int m; };
__device__ __forceinline__ void modc_load(const Frame& F, ModCache& c, int l, int which, int lp, bool comb, float cs, int m) {
    const float* gn = inp(F, I_NORMG) + ((size_t)l * 2 + which) * D; const float* mp = mod_ptr(F, l, m) + (which ? 3 : 0) * D; const float* g2 = mod_ptr(F, comb ? lp : 0, m) + 5 * D;
#pragma unroll
    for (int j = 0; j < 4; ++j) { const int col = 4 * F.lane + 256 * j; const f32x4 g = *(const f32x4*)(gn + col), sc = *(const f32x4*)(mp + D + col);
        c.gs[j] = g * (sc + 1.f); c.sh[j] = *(const f32x4*)(mp + col); c.g2[j] = comb ? *(const f32x4*)(g2 + col) * cs : (f32x4){0.f, 0.f, 0.f, 0.f}; }
    c.m = m;
}
__device__ __forceinline__ void combine_c(const ModCache& c, f32x4 (&v)[4], const u32x2 (&y0a)[4], const u32x2 (&y1a)[4], f32x2 w) {
#pragma unroll
    for (int j = 0; j < 4; ++j) { const u32x2 y0 = y0a[j], y1 = y1a[j]; const f32x4 g = c.g2[j];
        v[j].x += g.x * (w.x * bflo(y0.x) + w.y * bflo(y1.x)); v[j].y += g.y * (w.x * bfhi(y0.x) + w.y * bfhi(y1.x));
        v[j].z += g.z * (w.x * bflo(y0.y) + w.y * bflo(y1.y)); v[j].w += g.w * (w.x * bfhi(y0.y) + w.y * bfhi(y1.y)); }
}
__device__ __forceinline__ void modulate_c(const ModCache& c, const f32x4 (&v)[4], float rstd, f32x4 (&h)[4]) {
#pragma unroll
    for (int j = 0; j < 4; ++j) h[j] = v[j] * rstd * c.gs[j] + c.sh[j];
}
template <bool FINAL> __device__ __forceinline__ void norm1_deep(Frame& F, int l, float cs, const int (&off)[NE], int lp) {
    constexpr int KD = 3;
    bf16* H = (bf16*)(F.ws + WS_H);
    const int4* rip = (const int4*)(F.ws + WS_ROUTE); const f32x2* wp = (const f32x2*)(F.ws + WS_ROUTE + 600 * 1024);
    u32x2 nb[KD][4], y0[KD][4], y1[KD][4]; int4 ri[KD]; f32x2 rwn[KD], wcur[KD];
#pragma unroll
    for (int s = 0; s < KD; ++s) { ri[s] = make_int4(0, 0, 0, 0); rwn[s] = (f32x2){0.f, 0.f}; wcur[s] = (f32x2){0.f, 0.f};
#pragma unroll
        for (int j = 0; j < 4; ++j) { nb[s][j] = (u32x2){0u, 0u}; y0[s][j] = (u32x2){0u, 0u}; y1[s][j] = (u32x2){0u, 0u}; } }
#define N1D_REC(s, r) do { const int r_ = (r); if (r_ < TL) { ri[s] = rip[r_]; rwn[s] = wp[r_]; } } while (0)
#define N1D_DATA(s, r) do { const int r_ = (r); if (r_ < TL) { const bf16* hs = hb_row(F, r_); \
        _Pragma("unroll") for (int j = 0; j < 4; ++j) nb[s][j] = *(const u32x2*)(hs + 4 * F.lane + 256 * j); \
        moe_load_rows(F, moe_pos(ri[s], off), y0[s], y1[s]); wcur[s] = rwn[s]; } } while (0)
#pragma unroll
    for (int s = 0; s < KD; ++s) N1D_REC(s, F.gw + s * F.NGW);
#pragma unroll
    for (int s = 0; s < KD; ++s) { N1D_DATA(s, F.gw + s * F.NGW); N1D_REC(s, F.gw + (s + KD) * F.NGW); }
    ModCache mc; mc.m = -1;
    for (int rb = F.gw; rb < TL; rb += KD * F.NGW) {
#pragma unroll
        for (int s = 0; s < KD; ++s) { const int r = rb + s * F.NGW;
            if (r < TL) {
                { const int m = r / S; if (m != mc.m) modc_load(F, mc, FINAL ? 3 : l, 0, lp, true, cs, m); }
                f32x4 v[4];
#pragma unroll
                for (int j = 0; j < 4; ++j) { const u32x2 t = nb[s][j]; v[j] = (f32x4){bflo(t.x), bfhi(t.x), bflo(t.y), bfhi(t.y)}; }
                if (STOP_AFTER >= (FINAL ? 8 : 2 * l)) combine_c(mc, v, y0[s], y1[s], wcur[s]);
                N1D_DATA(s, r + KD * F.NGW); N1D_REC(s, r + 2 * KD * F.NGW);
                if (FINAL) { float* xd = F.out + (size_t)r * D;
#pragma unroll
                    for (int j = 0; j < 4; ++j) *(f32x4*)(xd + 4 * F.lane + 256 * j) = v[j]; }
                else { store_row_bf16(hb_row(F, r), F.lane, v);
                    const float rstd = row_rstd(v); f32x4 h[4]; modulate_c(mc, v, rstd, h); store_row_bf16(H + (size_t)r * D, F.lane, h); }
            } }
    }
#undef N1D_REC
#undef N1D_DATA
}
template <bool FINAL> __device__ __forceinline__ void norm1_rows(Frame& F, int l, float cs) {
    bf16* H = (bf16*)(F.ws + WS_H);
    const int4* rip = (const int4*)(F.ws + WS_ROUTE); const f32x2* wp = (const f32x2*)(F.ws + WS_ROUTE + 600 * 1024);
    const int Tn = FINAL ? TL : T; const bool comb = FINAL || l > 0; const int lp = FINAL ? 3 : l - 1;
    int off[NE];
    if (comb) (void)moe_offsets(F, lp, off); else {
#pragma unroll
        for (int e = 0; e < NE; ++e) off[e] = 0; }
    int r0 = F.gw;
    if (comb) { norm1_deep<FINAL>(F, l, cs, off, lp); r0 = TL + F.gw; }
    f32x4 nv[4]; u32x2 nb[4]; u32x2 ny0[4], ny1[4]; f32x2 nw = {0.f, 0.f}; int4 nri = make_int4(0, 0, 0, 0); f32x2 nnw = {0.f, 0.f};
#pragma unroll
    for (int j = 0; j < 4; ++j) { nv[j] = (f32x4){0.f, 0.f, 0.f, 0.f}; nb[j] = (u32x2){0u, 0u}; ny0[j] = (u32x2){0u, 0u}; ny1[j] = (u32x2){0u, 0u}; }
    auto isbf = [&](int r) -> bool { return FINAL || (l > 0 && r < TL); };
    auto xload = [&](int r) { if (isbf(r)) { const bf16* hs = hb_row(F, r);
#pragma unroll
            for (int j = 0; j < 4; ++j) nb[j] = *(const u32x2*)(hs + 4 * F.lane + 256 * j); }
        else { const float* xs = xsrc_row(F, l, r);
#pragma unroll
            for (int j = 0; j < 4; ++j) nv[j] = *(const f32x4*)(xs + 4 * F.lane + 256 * j); } };
    if (r0 < Tn) { xload(r0);
        if (comb) { const int4 ri = rip[r0]; nw = wp[r0]; moe_load_rows(F, moe_pos(ri, off), ny0, ny1); if (r0 + F.NGW < Tn) { nri = rip[r0 + F.NGW]; nnw = wp[r0 + F.NGW]; } } }
    ModCache mc; mc.m = -1;
    for (int r = r0; r < Tn; r += F.NGW) {
        { const int m = r < TL ? r / S : 2; if (m != mc.m) modc_load(F, mc, FINAL ? 3 : l, 0, lp, comb, cs, m); }
        f32x4 v[4]; u32x2 y0[4], y1[4]; const f32x2 w = nw;
        if (isbf(r)) {
#pragma unroll
            for (int j = 0; j < 4; ++j) { const u32x2 t = nb[j]; v[j] = (f32x4){bflo(t.x), bfhi(t.x), bflo(t.y), bfhi(t.y)}; } }
        else {
#pragma unroll
            for (int j = 0; j < 4; ++j) v[j] = nv[j]; }
#pragma unroll
        for (int j = 0; j < 4; ++j) { y0[j] = ny0[j]; y1[j] = ny1[j]; }
        const int rn = r + F.NGW;
        if (rn < Tn) { xload(rn);
            if (comb) { moe_load_rows(F, moe_pos(nri, off), ny0, ny1); nw = nnw; if (rn + F.NGW < Tn) { nri = rip[rn + F.NGW]; nnw = wp[rn + F.NGW]; } } }
        if (comb) { if (STOP_AFTER >= (FINAL ? 8 : 2 * l)) combine_c(mc, v, y0, y1, w);
            if (FINAL) { float* xd = F.out + (size_t)r * D;
#pragma unroll
                for (int j = 0; j < 4; ++j) *(f32x4*)(xd + 4 * F.lane + 256 * j) = v[j]; }
            else if (r < TL) store_row_bf16(hb_row(F, r), F.lane, v);
            else { float* xd = xdst_row(F, r);
#pragma unroll
                for (int j = 0; j < 4; ++j) *(f32x4*)(xd + 4 * F.lane + 256 * j) = v[j]; } }
        else if (r < TL) store_row_bf16(hb_row(F, r), F.lane, v);
        if (!FINAL) { const float rstd = row_rstd(v); f32x4 h[4]; modulate_c(mc, v, rstd, h); store_row_bf16(H + (size_t)r * D, F.lane, h); }
    }
}
__device__ __forceinline__ void phase_norm1(Frame& F, int l, float cs = 1.f) { norm1_rows<false>(F, l, cs); }
__device__ __forceinline__ void phase_final(Frame& F, float cs = 1.f) { norm1_rows<true>(F, 3, cs); }

__device__ __forceinline__ void phase_norm2_route(Frame& F, int l, bool dry = false) {
    bf16* H = (bf16*)(F.ws + WS_H);
    LAS float* rw = (LAS float*)F.lds;
    for (int i = F.tid; i < D * NE; i += NTHR) { const int k = i / NE, e = i % NE; rw[e * D + k] = inp(F, I_RW)[i]; }
    LAS unsigned* lcnt = (LAS unsigned*)(F.lds + 65536);
    if (F.tid < 32) lcnt[F.tid] = 0u;
    __syncthreads();
    const int Tm = (l < DEPTH - 1) ? T : TL;
    unsigned* cnt = cnt_ptr(F, l);
    int4* route_i = (int4*)(F.ws + WS_ROUTE); f32x2* route_w = (f32x2*)(F.ws + WS_ROUTE + 600 * 1024);
    f32x4 nv[4]; u32x2 nb[4];
#pragma unroll
    for (int j = 0; j < 4; ++j) { nv[j] = (f32x4){0.f, 0.f, 0.f, 0.f}; nb[j] = (u32x2){0u, 0u}; }
    auto xload = [&](int r) { if (r < TL) { const bf16* hs = hb_row(F, r);
#pragma unroll
            for (int j = 0; j < 4; ++j) nb[j] = *(const u32x2*)(hs + 4 * F.lane + 256 * j); }
        else { const float* xs = xdst_row(F, r);
#pragma unroll
            for (int j = 0; j < 4; ++j) nv[j] = *(const f32x4*)(xs + 4 * F.lane + 256 * j); } };
    if (F.gw < Tm) xload(F.gw);
    ModCache mc; mc.m = -1;
    float st[NE]; int idx = 0;
#pragma unroll
    for (int e = 0; e < NE; ++e) st[e] = 0.f;
    for (int r = F.gw; r < Tm; r += F.NGW) {
        { const int m = r < TL ? r / S : 2; if (m != mc.m) modc_load(F, mc, l, 1, 0, false, 0.f, m); }
        f32x4 v[4];
        if (r < TL) {
#pragma unroll
            for (int j = 0; j < 4; ++j) { const u32x2 t = nb[j]; v[j] = (f32x4){bflo(t.x), bfhi(t.x), bflo(t.y), bfhi(t.y)}; } }
        else {
#pragma unroll
            for (int j = 0; j < 4; ++j) v[j] = nv[j]; }
        if (r + F.NGW < Tm) xload(r + F.NGW);
        const float rstd = row_rstd(v); f32x4 h[4]; modulate_c(mc, v, rstd, h);
        store_row_bf16(H + (size_t)r * D, F.lane, h);
        const bool mine = (F.lane == idx);
        float sv[NE];
#pragma unroll
        for (int e = 0; e < NE; ++e) { float s = 0.f; asm volatile("" ::: "memory");
            f32x2 a0 = {0.f, 0.f}, a1 = {0.f, 0.f};
#pragma unroll
            for (int j = 0; j < 4; ++j) { const f32x4 w = *(const LAS f32x4*)(rw + e * D + 4 * F.lane + 256 * j);
                a0 = (f32x2){h[j].x, h[j].y} * (f32x2){w.x, w.y} + a0; a1 = (f32x2){h[j].z, h[j].w} * (f32x2){w.z, w.w} + a1; }
            { const f32x2 a = a0 + a1; s = a.x + a.y; }
            sv[e] = s; }
#pragma unroll
        for (int e = 0; e < NE; ++e) { const float lge = wave_sum(sv[e]); st[e] = mine ? lge : st[e]; }
        ++idx;
    }
    const int nrows = idx, myr = F.gw + F.lane * F.NGW; const bool act = (F.lane < nrows) && !dry;
    int e0, e1, r0 = 0, r1 = 0; float wn0, wn1;
    {
        float sc[NE], bi[NE];
#pragma unroll
        for (int e = 0; e < NE; ++e) { sc[e] = 1.f / (1.f + expf(-st[e])); bi[e] = sc[e] + inp(F, I_RB)[e]; }
        int sel = 0; float best = -INFINITY;
#pragma unroll
        for (int g = 0; g < 4; ++g) { float m1 = -INFINITY, m2 = -INFINITY;
#pragma unroll
            for (int i = 0; i < 4; ++i) { const float b = bi[4 * g + i]; if (b > m1) { m2 = m1; m1 = b; } else if (b > m2) m2 = b; }
            const float gs = m1 + m2; if (gs > best) { best = gs; sel = g; } }
        float b4[4], s4[4];
#pragma unroll
        for (int i = 0; i < 4; ++i) { b4[i] = bi[0 + i]; s4[i] = sc[0 + i]; }
#pragma unroll
        for (int g = 1; g < 4; ++g) if (sel == g) {
#pragma unroll
            for (int i = 0; i < 4; ++i) { b4[i] = bi[4 * g + i]; s4[i] = sc[4 * g + i]; } }
        int i0 = 0; float v0 = b4[0], w0 = s4[0];
#pragma unroll
        for (int i = 1; i < 4; ++i) if (b4[i] > v0) { v0 = b4[i]; w0 = s4[i]; i0 = i; }
        int i1 = 0; float v1 = -INFINITY, w1 = 0.f;
#pragma unroll
        for (int i = 0; i < 4; ++i) if (i != i0 && b4[i] > v1) { v1 = b4[i]; w1 = s4[i]; i1 = i; }
        const float ws_ = 1.f / (w0 + w1);
        e0 = 4 * sel + i0; e1 = 4 * sel + i1; wn0 = w0 * ws_; wn1 = w1 * ws_;
    }
    if (act) { r0 = (int)__hip_atomic_fetch_add(lcnt + e0, 1u, __ATOMIC_RELAXED, __HIP_MEMORY_SCOPE_WORKGROUP); r1 = (int)__hip_atomic_fetch_add(lcnt + e1, 1u, __ATOMIC_RELAXED, __HIP_MEMORY_SCOPE_WORKGROUP); }
    __syncthreads();
    if (F.tid < NE && !dry) lcnt[NE + F.tid] = atomicAdd(&cnt[64 * F.tid], lcnt[F.tid]);
    __syncthreads();
    if (act) { int* list = (int*)(F.ws + WS_LIST); r0 += (int)lcnt[NE + e0]; r1 += (int)lcnt[NE + e1];
        route_i[myr] = make_int4(e0, r0, e1, r1); route_w[myr] = (f32x2){wn0, wn1};
        list[(size_t)e0 * T + r0] = myr; list[(size_t)e1 * T + r1] = myr; }
    __syncthreads();
}
__device__ __forceinline__ int moe_tile_table(Frame& F, int l) {
    int off[NE]; const int ntiles = moe_offsets(F, l, off);
    LAS i32x4* tab = (LAS i32x4*)(F.lds + 131072); const unsigned* cnt = cnt_ptr(F, l);
    __syncthreads();
    for (int t = F.tid; t < ntiles; t += NTHR) { int e = 0, o = 0;
#pragma unroll
        for (int k = 1; k < NE; ++k) if (t * 256 >= off[k]) { e = k; o = off[k]; }
        tab[t] = (i32x4){e, t * 256 - o, (int)__hip_atomic_load(cnt + 64 * e, __ATOMIC_RELAXED, __HIP_MEMORY_SCOPE_AGENT), 0}; }
    __syncthreads();
    return ntiles;
}

namespace att {
#define SBAR() __builtin_amdgcn_sched_barrier(0)
__device__ __forceinline__ int crow(int r, int hi) { return (r & 3) + 8 * (r >> 2) + 4 * hi; }
__device__ __forceinline__ unsigned cvtpk(float lo, float hi) { unsigned r; asm volatile("v_cvt_pk_bf16_f32 %0, %1, %2" : "=v"(r) : "v"(lo), "v"(hi)); return r; }
constexpr float THRL = 8.f;
__device__ __forceinline__ void partialSM(f32x16& p0, f32x16& p1, float& m_reg, float& alpha) {
    float pmax = p0[0];
#pragma unroll
    for (int r = 1; r < 16; ++r) pmax = fmaxf(pmax, p0[r]);
#pragma unroll
    for (int r = 0; r < 16; ++r) pmax = fmaxf(pmax, p1[r]);
    { auto rr = __builtin_amdgcn_permlane32_swap(__float_as_uint(pmax), __float_as_uint(pmax), false, false); pmax = fmaxf(__uint_as_float(rr[0]), __uint_as_float(rr[1])); }
    float mn;
    if (__builtin_expect(__all(pmax - m_reg <= THRL), 1)) { mn = m_reg; alpha = 1.f; }
    else { mn = fmaxf(m_reg, pmax); alpha = __builtin_amdgcn_exp2f(m_reg - mn); m_reg = mn; }
#pragma unroll
    for (int r = 0; r < 16; ++r) p0[r] = __builtin_amdgcn_exp2f(p0[r] - mn);
#pragma unroll
    for (int r = 0; r < 16; ++r) p1[r] = p1[r] - mn;
}
__device__ __forceinline__ void finishSM(f32x16& p0, f32x16& p1, float alpha, float& l_reg, bf16x8& pa0, bf16x8& pa1, bf16x8& pa2, bf16x8& pa3) {
#pragma unroll
    for (int r = 0; r < 16; ++r) p1[r] = __builtin_amdgcn_exp2f(p1[r]);
    float ps = 0;
#pragma unroll
    for (int r = 0; r < 16; ++r) ps += p0[r];
#pragma unroll
    for (int r = 0; r < 16; ++r) ps += p1[r];
    { auto rr = __builtin_amdgcn_permlane32_swap(__float_as_uint(ps), __float_as_uint(ps), false, false); ps = __uint_as_float(rr[0]) + __uint_as_float(rr[1]); }
    l_reg = l_reg * alpha + ps;
#define PK4(P, BASE, OUT) do { unsigned a0 = cvtpk(P[BASE + 0], P[BASE + 1]), a1 = cvtpk(P[BASE + 2], P[BASE + 3]);   \
    unsigned b0 = cvtpk(P[BASE + 4], P[BASE + 5]), b1 = cvtpk(P[BASE + 6], P[BASE + 7]);                              \
    auto r0 = __builtin_amdgcn_permlane32_swap(a0, b0, false, false); auto r1 = __builtin_amdgcn_permlane32_swap(a1, b1, false, false); \
    u32x4 w = {r0[0], r1[0], r0[1], r1[1]}; OUT = *reinterpret_cast<bf16x8*>(&w); } while (0)
    PK4(p0, 0, pa0); PK4(p0, 8, pa1); PK4(p1, 0, pa2); PK4(p1, 8, pa3);
#undef PK4
}
template <int DK> __device__ __forceinline__ void qkt(f32x16& p0, f32x16& p1, const LAS char* Ks, const bf16x8* qr, int r32, int hi) {
    constexpr int KS = 2 * DK + 16;
    p0 = f32x16{}; p1 = f32x16{};
#pragma unroll
    for (int d0 = 0; d0 < DK / 16; ++d0) { const int cb = (d0 * 16 + hi * 8) * 2;
        const bf16x8 b0 = *(const LAS bf16x8*)(Ks + r32 * KS + cb);
        const bf16x8 b1 = *(const LAS bf16x8*)(Ks + (32 + r32) * KS + cb);
        p0 = __builtin_amdgcn_mfma_f32_32x32x16_bf16(b0, qr[d0], p0, 0, 0, 0);
        p1 = __builtin_amdgcn_mfma_f32_32x32x16_bf16(b1, qr[d0], p1, 0, 0, 0); }
}
__device__ __forceinline__ int v_st(int k, int c) { const int kk = (k & ~0xC) | ((k & 4) << 1) | ((k & 8) >> 1); return ((kk >> 3) * 2 + (c >> 5)) * 512 + ((kk & 7) * 32 + (c & 31)) * 2; }
__device__ __forceinline__ int v_rd_base(int lane) { return ((lane & 3) << 3) | (((lane >> 2) & 3) << 6) | (((lane >> 4) & 1) << 5) | (((lane >> 5) & 1) << 8); }
constexpr int v_rd_off(int d0, int ks, int half) { return d0 * 512 + ks * 2048 + half * 1024; }
template <int OFF> __device__ __forceinline__ s16x4 tr_read(int vb) { s16x4 r; asm volatile("ds_read_b64_tr_b16 %0, %1 offset:%2" : "=&v"(r) : "v"(vb), "i"(OFF) : "memory"); return r; }
template <int D0> __device__ __forceinline__ void pv_one(f32x16& od, int vb, bf16x8 pa0, bf16x8 pa1, bf16x8 pa2, bf16x8 pa3) {
    const s16x4 l0 = tr_read<v_rd_off(D0, 0, 0)>(vb), h0 = tr_read<v_rd_off(D0, 0, 1)>(vb), l1 = tr_read<v_rd_off(D0, 1, 0)>(vb), h1 = tr_read<v_rd_off(D0, 1, 1)>(vb);
    const s16x4 l2 = tr_read<v_rd_off(D0, 2, 0)>(vb), h2 = tr_read<v_rd_off(D0, 2, 1)>(vb), l3 = tr_read<v_rd_off(D0, 3, 0)>(vb), h3 = tr_read<v_rd_off(D0, 3, 1)>(vb);
    asm volatile("s_waitcnt lgkmcnt(0)" ::: "memory"); SBAR();
#define PK(L, H) (bf16x8){L[0], L[1], L[2], L[3], H[0], H[1], H[2], H[3]}
    od = __builtin_amdgcn_mfma_f32_32x32x16_bf16(pa0, PK(l0, h0), od, 0, 0, 0);
    od = __builtin_amdgcn_mfma_f32_32x32x16_bf16(pa1, PK(l1, h1), od, 0, 0, 0);
    od = __builtin_amdgcn_mfma_f32_32x32x16_bf16(pa2, PK(l2, h2), od, 0, 0, 0);
    od = __builtin_amdgcn_mfma_f32_32x32x16_bf16(pa3, PK(l3, h3), od, 0, 0, 0);
#undef PK
}
struct Unit {
    const bf16* Q; int ldq;
    const bf16* K; const bf16* V; int ldk;
    int nA, rowA, nB, rowB, rlo, rhi;
    int mask;
    int kb0, q0;
    float sink; int has_sink;
    bf16* O; int ldo;
    int qprep, qrope, qpos0; const float* qgain; const f32x2* ropet; float qc2;
};
template <int DK> __device__ __forceinline__ void attn_unit(const Unit& U, LAS char* lds, const int tid) {
    constexpr int KS = 2 * DK + 16, SHM_V = 8192, SHM_K = 64 * KS, NKP = DK / 8;
    const int wid = __builtin_amdgcn_readfirstlane(tid >> 6), lane = tid & 63, r32 = lane & 31, hi = lane >> 5;
    LAS char* V_lds = lds; LAS char* K_lds = lds + 2 * SHM_V;
    LAS float* ws = (LAS float*)(lds + 2 * SHM_V + 2 * SHM_K) + wid * 64; LAS float* li_l = ws; LAS float* al_l = ws + 32;
    float m_reg = -1e30f, l_reg = 0; f32x16 o[2] = {}; bf16x8 qr[DK / 16];
    const bf16* Qw = U.Q + (size_t)(wid * 32 + r32) * U.ldq + hi * 8;
#pragma unroll
    for (int d0 = 0; d0 < DK / 16; ++d0) qr[d0] = *(const bf16x8*)(Qw + d0 * 16);
    const int vkey = tid >> 3, vc = (tid & 7) * 8, vst = v_st(vkey, vc);
    const int k0key = tid / NKP, k0ch = tid % NKP, k1key = (512 + tid) / NKP, k1ch = (512 + tid) % NKP;
    const bool k1on = (DK == 96) && (tid < 256);
    const int vb0 = (int)(uintptr_t)V_lds + v_rd_base(lane);
    const int NT = U.nA + U.nB;
    auto tile_row = [&](int j) -> int { if (j < U.nA) return U.rowA + 64 * j; int r = U.rowB + 64 * (j - U.nA); r = r < U.rlo ? U.rlo : r; return r > U.rhi ? U.rhi : r; };
    struct Slot { bf16x8 v, k0, k1; };
    Slot sE, sO;
#define SLOAD(sl, j) do { const int _row = tile_row(j); sl.v = *(const bf16x8*)(U.V + (size_t)(_row + vkey) * U.ldk + vc); sl.k0 = *(const bf16x8*)(U.K + (size_t)(_row + k0key) * U.ldk + k0ch * 8); \
        if (k1on) sl.k1 = *(const bf16x8*)(U.K + (size_t)(_row + k1key) * U.ldk + k1ch * 8); } while (0)
#define SWRITE(b, sl) do { *(LAS bf16x8*)(V_lds + (b) * SHM_V + vst) = sl.v; *(LAS bf16x8*)(K_lds + (b) * SHM_K + k0key * KS + k0ch * 16) = sl.k0; \
        if (k1on) *(LAS bf16x8*)(K_lds + (b) * SHM_K + k1key * KS + k1ch * 16) = sl.k1; } while (0)
#define RESC(a) do { if (__any((a) < 1.f)) { if (hi == 0) al_l[r32] = (a); asm volatile("s_waitcnt lgkmcnt(0)" ::: "memory"); \
        _Pragma("unroll") for (int d = 0; d < 2; ++d) _Pragma("unroll") for (int r = 0; r < 16; ++r) o[d][r] *= al_l[crow(r, hi)]; } } while (0)
#define MASK(P0, P1, j) do { if (U.mask && (j) >= U.nA) { const int kb = U.kb0 + 64 * ((j) - U.nA), dq = wid * 32 + r32; \
        _Pragma("unroll") for (int r = 0; r < 16; ++r) { const int k0_ = kb + crow(r, hi), k1_ = k0_ + 32; \
            const bool ok0 = (k0_ - dq <= 128) && (dq - k0_ <= 128) && ((unsigned)(U.q0 + k0_) < (unsigned)S); \
            const bool ok1 = (k1_ - dq <= 128) && (dq - k1_ <= 128) && ((unsigned)(U.q0 + k1_) < (unsigned)S); \
            P0[r] = ok0 ? P0[r] : -INFINITY; P1[r] = ok1 ? P1[r] : -INFINITY; } } } while (0)
    f32x16 pA0, pA1, pB0, pB1; float alA, alB; bf16x8 pa0, pa1, pa2, pa3;
    __syncthreads();
    SLOAD(sE, 0); SWRITE(0, sE); __syncthreads();
    qkt<DK>(pA0, pA1, K_lds, qr, r32, hi); MASK(pA0, pA1, 0); partialSM(pA0, pA1, m_reg, alA);
    SLOAD(sO, 1); if (2 < NT) SLOAD(sE, 2);
    SWRITE(1, sO); __syncthreads();
    for (int j = 1; j + 1 < NT; j += 2) {
        SBAR(); qkt<DK>(pB0, pB1, K_lds + SHM_K, qr, r32, hi); MASK(pB0, pB1, j);
        finishSM(pA0, pA1, alA, l_reg, pa0, pa1, pa2, pa3); SBAR();
        SLOAD(sO, j + 2); SBAR();
        pv_one<0>(o[0], vb0, pa0, pa1, pa2, pa3); pv_one<1>(o[1], vb0, pa0, pa1, pa2, pa3); partialSM(pB0, pB1, m_reg, alB);
        __syncthreads(); SWRITE(0, sE);
        RESC(alB); __syncthreads();
        SBAR(); qkt<DK>(pA0, pA1, K_lds, qr, r32, hi); MASK(pA0, pA1, j + 1);
        finishSM(pB0, pB1, alB, l_reg, pa0, pa1, pa2, pa3); SBAR();
        if (j + 3 < NT) SLOAD(sE, j + 3); SBAR();
        pv_one<0>(o[0], vb0 + SHM_V, pa0, pa1, pa2, pa3); pv_one<1>(o[1], vb0 + SHM_V, pa0, pa1, pa2, pa3); partialSM(pA0, pA1, m_reg, alA);
        __syncthreads(); SWRITE(1, sO);
        RESC(alA); __syncthreads();
    }
    SBAR(); qkt<DK>(pB0, pB1, K_lds + SHM_K, qr, r32, hi); MASK(pB0, pB1, NT - 1);
    finishSM(pA0, pA1, alA, l_reg, pa0, pa1, pa2, pa3); SBAR();
    pv_one<0>(o[0], vb0, pa0, pa1, pa2, pa3); pv_one<1>(o[1], vb0, pa0, pa1, pa2, pa3); partialSM(pB0, pB1, m_reg, alB);
    __syncthreads(); RESC(alB);
    finishSM(pB0, pB1, alB, l_reg, pa0, pa1, pa2, pa3); SBAR();
    pv_one<0>(o[0], vb0 + SHM_V, pa0, pa1, pa2, pa3); pv_one<1>(o[1], vb0 + SHM_V, pa0, pa1, pa2, pa3);
    if (U.has_sink) l_reg += __builtin_amdgcn_exp2f(U.sink * LOG2E - m_reg);
    if (hi == 0) li_l[r32] = l_reg; asm volatile("s_waitcnt lgkmcnt(0)" ::: "memory");
    float rli[16];
#pragma unroll
    for (int r = 0; r < 16; ++r) rli[r] = __builtin_amdgcn_rcpf(li_l[crow(r, hi)]);
    bf16* Ow = U.O + (size_t)(wid * 32) * U.ldo;
#pragma unroll
    for (int r = 0; r < 16; ++r) { const int orow = crow(r, hi);
#pragma unroll
        for (int d0 = 0; d0 < 2; ++d0) Ow[(size_t)orow * U.ldo + d0 * 32 + r32] = (bf16)f2bf(o[d0][r] * rli[r]); }
#undef SLOAD
#undef SWRITE
#undef RESC
#undef MASK
}

__device__ __forceinline__ void partialF(f32x16& p0) {
#pragma unroll
    for (int r = 0; r < 16; ++r) p0[r] = __builtin_amdgcn_exp2f(p0[r]);
}
__device__ __forceinline__ void finishF(f32x16& p0, f32x16& p1, float& lsum, bf16x8& pa0, bf16x8& pa1, bf16x8& pa2, bf16x8& pa3) {
#pragma unroll
    for (int r = 0; r < 16; ++r) p1[r] = __builtin_amdgcn_exp2f(p1[r]);
    { const f32x16 s16 = p0 + p1;
      const float a0 = (s16[0] + s16[1]) + (s16[2] + s16[3]), a1 = (s16[4] + s16[5]) + (s16[6] + s16[7]), a2 = (s16[8] + s16[9]) + (s16[10] + s16[11]), a3 = (s16[12] + s16[13]) + (s16[14] + s16[15]);
      lsum += (a0 + a1) + (a2 + a3); }
#define PK4(P, BASE, OUT) do { unsigned a0 = cvtpk(P[BASE + 0], P[BASE + 1]), a1 = cvtpk(P[BASE + 2], P[BASE + 3]);   \
    unsigned b0 = cvtpk(P[BASE + 4], P[BASE + 5]), b1 = cvtpk(P[BASE + 6], P[BASE + 7]);                              \
    auto r0 = __builtin_amdgcn_permlane32_swap(a0, b0, false, false); auto r1 = __builtin_amdgcn_permlane32_swap(a1, b1, false, false); \
    u32x4 w = {r0[0], r1[0], r0[1], r1[1]}; OUT = *reinterpret_cast<bf16x8*>(&w); } while (0)
    PK4(p0, 0, pa0); PK4(p0, 8, pa1); PK4(p1, 0, pa2); PK4(p1, 8, pa3);
#undef PK4
}
__device__ __forceinline__ void finishF_ns(f32x16& p0, f32x16& p1, f32x2& lacc, bf16x8& pa0, bf16x8& pa1, bf16x8& pa2, bf16x8& pa3) {
#pragma unroll
    for (int r = 0; r < 16; ++r) p1[r] = __builtin_amdgcn_exp2f(p1[r]);
    { const f32x16 s16 = p0 + p1; const f32x8 s8 = s16.lo + s16.hi; const f32x4 s4 = s8.lo + s8.hi; lacc += s4.lo + s4.hi; }
#define PK4N(P, BASE, OUT) do { const u32x4 w = {cvtpk(P[BASE + 0], P[BASE + 1]), cvtpk(P[BASE + 2], P[BASE + 3]), cvtpk(P[BASE + 4], P[BASE + 5]), cvtpk(P[BASE + 6], P[BASE + 7])}; OUT = __builtin_bit_cast(bf16x8, w); } while (0)
    PK4N(p0, 0, pa0); PK4N(p0, 8, pa1); PK4N(p1, 0, pa2); PK4N(p1, 8, pa3);
#undef PK4N
}
template <int DK> __device__ __forceinline__ void qkt_c(f32x16& p0, f32x16& p1, const LAS char* Ks, const bf16x8* qr, const f32x16& cinit, int r32, int hi) {
    constexpr int KS = 2 * DK + 16;
    bf16x8 kf[DK / 8];
#pragma unroll
    for (int d0 = 0; d0 < DK / 16; ++d0) { const int cb = (d0 * 16 + hi * 8) * 2;
        kf[2 * d0] = *(const LAS bf16x8*)(Ks + r32 * KS + cb); kf[2 * d0 + 1] = *(const LAS bf16x8*)(Ks + (32 + r32) * KS + cb); }
    SBAR();
#pragma unroll
    for (int d0 = 0; d0 < DK / 16; ++d0) {
        p0 = __builtin_amdgcn_mfma_f32_32x32x16_bf16(kf[2 * d0], qr[d0], d0 == 0 ? cinit : p0, 0, 0, 0);
        p1 = __builtin_amdgcn_mfma_f32_32x32x16_bf16(kf[2 * d0 + 1], qr[d0], d0 == 0 ? cinit : p1, 0, 0, 0); }
}
template <int DK> __device__ __forceinline__ void attn_unit_fm(const Unit& U, float Mref, LAS char* lds, const int tid) {
    constexpr int KS = 2 * DK + 16, SHM_V = 8192, SHM_K = 64 * KS, NKP = DK / 8;
    const int wid = __builtin_amdgcn_readfirstlane(tid >> 6), lane = tid & 63, r32 = lane & 31, hi = lane >> 5;
    LAS char* V_lds = lds; LAS char* K_lds = lds + 3 * SHM_V;
    LAS float* ws = (LAS float*)(lds + 3 * SHM_V + 2 * SHM_K) + wid * 64; LAS float* li_l = ws;
    float lsum = 0; f32x16 o[2] = {}; bf16x8 qr[DK / 16];
    const f32x16 cinit = {};
    const bf16* Qw = U.Q + (size_t)(wid * 32 + r32) * U.ldq + hi * 8;
#pragma unroll
    for (int d0 = 0; d0 < DK / 16; ++d0) qr[d0] = *(const bf16x8*)(Qw + d0 * 16);
    const int vkey = tid >> 3, vc = (tid & 7) * 8, vst = v_st(vkey, vc);
    const int k0key = tid / NKP, k0ch = tid % NKP, k1key = (512 + tid) / NKP, k1ch = (512 + tid) % NKP;
    const bool k1on = (DK == 96) && (tid < 256);
    const int vb0 = (int)(uintptr_t)V_lds + v_rd_base(lane);
    const int NT = U.nA + U.nB;
    auto tile_row = [&](int j) -> int { if (j < U.nA) return U.rowA + 64 * j; int r = U.rowB + 64 * (j - U.nA); r = r < U.rlo ? U.rlo : r; return r > U.rhi ? U.rhi : r; };
    struct Slot { bf16x8 v, k0, k1; };
    Slot s0, s1;
#define SLOAD(sl, j) do { const int _row = tile_row(j); sl.v = *(const bf16x8*)(U.V + (size_t)(_row + vkey) * U.ldk + vc); sl.k0 = *(const bf16x8*)(U.K + (size_t)(_row + k0key) * U.ldk + k0ch * 8); \
        if (k1on) sl.k1 = *(const bf16x8*)(U.K + (size_t)(_row + k1key) * U.ldk + k1ch * 8); } while (0)
#define SWRITE(kb, vbuf, sl) do { *(LAS bf16x8*)(V_lds + (vbuf) * SHM_V + vst) = sl.v; *(LAS bf16x8*)(K_lds + (kb) * SHM_K + k0key * KS + k0ch * 16) = sl.k0; \
        if (k1on) *(LAS bf16x8*)(K_lds + (kb) * SHM_K + k1key * KS + k1ch * 16) = sl.k1; } while (0)
#define MASK(P0, P1, j) do { if (U.mask && (j) >= U.nA) { const int kb = U.kb0 + 64 * ((j) - U.nA), dq = wid * 32 + r32; \
        _Pragma("unroll") for (int r = 0; r < 16; ++r) { const int k0_ = kb + crow(r, hi), k1_ = k0_ + 32; \
            const bool ok0 = (k0_ - dq <= 128) && (dq - k0_ <= 128) && ((unsigned)(U.q0 + k0_) < (unsigned)S); \
            const bool ok1 = (k1_ - dq <= 128) && (dq - k1_ <= 128) && ((unsigned)(U.q0 + k1_) < (unsigned)S); \
            P0[r] = ok0 ? P0[r] : -INFINITY; P1[r] = ok1 ? P1[r] : -INFINITY; } } } while (0)
    f32x16 pA0, pA1, pB0, pB1; bf16x8 pa0, pa1, pa2, pa3;
    __syncthreads();
    SLOAD(s0, 0); SLOAD(s1, 1);
    SWRITE(0, 0, s0); if (2 < NT) SLOAD(s0, 2);
    SWRITE(1, 1, s1); if (3 < NT) SLOAD(s1, 3);
    __syncthreads();
    qkt_c<DK>(pA0, pA1, K_lds, qr, cinit, r32, hi); MASK(pA0, pA1, 0); partialF(pA0);
    int vcur = 0;
    for (int t = 0; t < NT; t += 2) {
        __syncthreads();
        SBAR(); qkt_c<DK>(pB0, pB1, K_lds + SHM_K, qr, cinit, r32, hi); MASK(pB0, pB1, t + 1);
        finishF(pA0, pA1, lsum, pa0, pa1, pa2, pa3); SBAR();
        { const int vb = vb0 + vcur * SHM_V; pv_one<0>(o[0], vb, pa0, pa1, pa2, pa3); pv_one<1>(o[1], vb, pa0, pa1, pa2, pa3); } partialF(pB0);
        { const int v2 = vcur == 0 ? 2 : vcur - 1;
          if (t + 2 < NT) { SWRITE(0, v2, s0); if (t + 4 < NT) SLOAD(s0, t + 4); } }
        vcur = vcur == 2 ? 0 : vcur + 1;
        __syncthreads();
        SBAR(); if (t + 2 < NT) { qkt_c<DK>(pA0, pA1, K_lds, qr, cinit, r32, hi); MASK(pA0, pA1, t + 2); }
        finishF(pB0, pB1, lsum, pa0, pa1, pa2, pa3); SBAR();
        { const int vb = vb0 + vcur * SHM_V; pv_one<0>(o[0], vb, pa0, pa1, pa2, pa3); pv_one<1>(o[1], vb, pa0, pa1, pa2, pa3); } if (t + 2 < NT) partialF(pA0);
        { const int v2 = vcur == 0 ? 2 : vcur - 1;
          if (t + 3 < NT) { SWRITE(1, v2, s1); if (t + 5 < NT) SLOAD(s1, t + 5); } }
        vcur = vcur == 2 ? 0 : vcur + 1;
    }
    { auto rr = __builtin_amdgcn_permlane32_swap(__float_as_uint(lsum), __float_as_uint(lsum), false, false); lsum = __uint_as_float(rr[0]) + __uint_as_float(rr[1]); }
    if (U.has_sink) lsum += __builtin_amdgcn_exp2f(U.sink * LOG2E);
    if (hi == 0) li_l[r32] = lsum; asm volatile("s_waitcnt lgkmcnt(0)" ::: "memory");
    float rli[16];
#pragma unroll
    for (int r = 0; r < 16; ++r) rli[r] = __builtin_amdgcn_rcpf(li_l[crow(r, hi)]);
    bf16* Ow = U.O + (size_t)(wid * 32) * U.ldo;
#pragma unroll
    for (int r = 0; r < 16; ++r) { const int orow = crow(r, hi);
#pragma unroll
        for (int d0 = 0; d0 < 2; ++d0) Ow[(size_t)orow * U.ldo + d0 * 32 + r32] = (bf16)f2bf(o[d0][r] * rli[r]); }
#undef SLOAD
#undef SWRITE
#undef MASK
}

template <int DK> __device__ __forceinline__ void prep_q(const Unit& U, bf16x8* qr, int wid, int r32, int hi) {
    if (U.qprep) {
        float v[DK / 16][8]; float ss = 0.f;
#pragma unroll
        for (int d0 = 0; d0 < DK / 16; ++d0) { const u32x4 w = __builtin_bit_cast(u32x4, qr[d0]);
            v[d0][0] = bflo(w.x); v[d0][1] = bfhi(w.x); v[d0][2] = bflo(w.y); v[d0][3] = bfhi(w.y); v[d0][4] = bflo(w.z); v[d0][5] = bfhi(w.z); v[d0][6] = bflo(w.w); v[d0][7] = bfhi(w.w);
#pragma unroll
            for (int j = 0; j < 8; ++j) ss += v[d0][j] * v[d0][j]; }
        ss += __shfl_xor(ss, 32);
        const float rs = U.qc2 / sqrtf(ss * (1.f / DK) + EPS);
#pragma unroll
        for (int d0 = 0; d0 < DK / 16; ++d0) { const f32x4 g0 = *(const f32x4*)(U.qgain + 16 * d0 + 8 * hi), g1 = *(const f32x4*)(U.qgain + 16 * d0 + 8 * hi + 4);
            v[d0][0] *= rs * g0.x; v[d0][1] *= rs * g0.y; v[d0][2] *= rs * g0.z; v[d0][3] *= rs * g0.w; v[d0][4] *= rs * g1.x; v[d0][5] *= rs * g1.y; v[d0][6] *= rs * g1.z; v[d0][7] *= rs * g1.w; }
        if (U.qrope) {
            constexpr int NA = DK == 64 ? 32 : 16, NP = DK == 64 ? 2 : 1, D1 = DK == 64 ? 0 : 4, DD = DK == 64 ? 2 : 1;
            const f32x2* cs = U.ropet + (size_t)(U.qpos0 + wid * 32 + r32) * NA + 8 * hi;
#pragma unroll
            for (int p = 0; p < NP; ++p)
#pragma unroll
                for (int j = 0; j < 8; ++j) { const f32x2 c = cs[16 * p + j]; const float x1 = v[D1 + p][j], x2 = v[D1 + p + DD][j]; v[D1 + p][j] = x1 * c.x - x2 * c.y; v[D1 + p + DD][j] = x2 * c.x + x1 * c.y; }
        }
#pragma unroll
        for (int d0 = 0; d0 < DK / 16; ++d0) { const u32x4 w = {pk2(v[d0][0], v[d0][1]), pk2(v[d0][2], v[d0][3]), pk2(v[d0][4], v[d0][5]), pk2(v[d0][6], v[d0][7])}; qr[d0] = __builtin_bit_cast(bf16x8, w); }
    }
}
__device__ __forceinline__ const bf16* rflp(const bf16* p) { const unsigned long long v = (unsigned long long)p; const unsigned lo = __builtin_amdgcn_readfirstlane((unsigned)v), hi = __builtin_amdgcn_readfirstlane((unsigned)(v >> 32)); return (const bf16*)(((unsigned long long)hi << 32) | lo); }
__device__ __forceinline__ void glds16(const void* gsrc, unsigned lds_dst) { unsigned keep;
    asm volatile("s_mov_b32 %0, m0\n\ts_mov_b32 m0, %2\n\ts_nop 0\n\tglobal_load_lds_dwordx4 %1, off\n\ts_mov_b32 m0, %0" : "=&s"(keep) : "v"(gsrc), "s"(lds_dst) : "memory"); }
#define WAIT_BAR(N) asm volatile("s_waitcnt vmcnt(" #N ") lgkmcnt(0)\n\ts_barrier" ::: "memory")
template <int DK> __device__ __forceinline__ void attn_unit_dma(const Unit& U, LAS char* lds, const int tid) {
    constexpr int KS = 2 * DK + 16, SHM_V = 8192, SHM_K = 64 * KS, NKP = DK / 8, NPK = SHM_K / 1024;
    static_assert(SHM_K % 1024 == 0, "K tile is a whole number of 1 KiB DMA pieces");
    const int wid = __builtin_amdgcn_readfirstlane(tid >> 6), lane = tid & 63, r32 = lane & 31, hi = lane >> 5;
    LAS char* V_lds = lds; LAS char* K_lds = lds + 4 * SHM_V;
    LAS float* ws = (LAS float*)(lds + 4 * SHM_V + 3 * SHM_K) + wid * 64; LAS float* li_l = ws;
    const unsigned lds0 = (unsigned)(uintptr_t)lds;
    f32x2 lacc = {0.f, 0.f}; f32x16 o[2] = {}; bf16x8 qr[DK / 16];
    const int nA_ = __builtin_amdgcn_readfirstlane(U.nA), NT = __builtin_amdgcn_readfirstlane(U.nA + U.nB), rowA_ = __builtin_amdgcn_readfirstlane(U.rowA), rowB_ = __builtin_amdgcn_readfirstlane(U.rowB);
    const int rlo_ = __builtin_amdgcn_readfirstlane(U.rlo), rhi_ = __builtin_amdgcn_readfirstlane(U.rhi), ldk_ = __builtin_amdgcn_readfirstlane(U.ldk);
    const bf16* Kp = rflp(U.K); const bf16* Vp = rflp(U.V);
    const f32x16 cinit = {};
    const bf16* Qw = U.Q + (size_t)(wid * 32 + r32) * U.ldq + hi * 8;
#pragma unroll
    for (int d0 = 0; d0 < DK / 16; ++d0) qr[d0] = *(const bf16x8*)(Qw + d0 * 16);
    const int kp1 = (wid + 8 < NPK) ? wid + 8 : wid;
    int koff0, koff1, voff;
    { const int b0 = wid * 1024 + lane * 16, r0 = b0 / KS, c0 = (b0 % KS) / 16; koff0 = r0 * U.ldk + (c0 < NKP ? c0 : 0) * 8;
      const int b1 = kp1 * 1024 + lane * 16, r1 = b1 / KS, c1 = (b1 % KS) / 16; koff1 = r1 * U.ldk + (c1 < NKP ? c1 : 0) * 8;
      const int i = wid * 64 + lane, sub = i >> 5, sl = i & 31, kk = (sub >> 1) * 8 + (sl >> 2), c = (sub & 1) * 32 + (sl & 3) * 8, key = kk;
      voff = key * U.ldk + c; }
    const unsigned kdst0 = lds0 + 4 * SHM_V + wid * 1024, kdst1 = lds0 + 4 * SHM_V + kp1 * 1024, vdst = lds0 + wid * 1024;
    const int vb0 = (int)lds0 + v_rd_base(lane);
    auto tile_row = [&](int j) -> int { j = j < NT ? j : NT - 1; if (j < nA_) return rowA_ + 64 * j; int r = rowB_ + 64 * (j - nA_); r = r < rlo_ ? rlo_ : r; return r > rhi_ ? rhi_ : r; };
#define DMA_TILE(j, kslot, vslot) do { const unsigned ro_ = (unsigned)(tile_row(j) * ldk_);     \
        glds16(Vp + (ro_ + (unsigned)voff), (unsigned)__builtin_amdgcn_readfirstlane(vdst + (vslot) * SHM_V)); \
        glds16(Kp + (ro_ + (unsigned)koff0), (unsigned)__builtin_amdgcn_readfirstlane(kdst0 + (kslot) * SHM_K)); \
        glds16(Kp + (ro_ + (unsigned)koff1), (unsigned)__builtin_amdgcn_readfirstlane(kdst1 + (kslot) * SHM_K)); } while (0)
    const int dq_ = wid * 32 + r32, klo_ = (dq_ - 128 > -U.q0) ? dq_ - 128 : -U.q0, khi_ = (dq_ + 128 < S - 1 - U.q0) ? dq_ + 128 : S - 1 - U.q0;
    const unsigned krange_ = (unsigned)(khi_ - klo_); const int kofs_ = U.kb0 - 64 * U.nA - klo_ + 4 * hi;
#define MASK(P0, P1, j) do { if (U.mask && (j) >= U.nA) { const int t_ = kofs_ + 64 * (j); \
        _Pragma("unroll") for (int r = 0; r < 16; ++r) { const unsigned u0_ = (unsigned)(t_ + (r & 3) + 8 * (r >> 2)), u1_ = u0_ + 32u; \
            P0[r] = u0_ <= krange_ ? P0[r] : -INFINITY; P1[r] = u1_ <= krange_ ? P1[r] : -INFINITY; } } } while (0)
    f32x16 pA0, pA1, pB0, pB1; bf16x8 pa0, pa1, pa2, pa3;
    asm volatile("s_waitcnt lgkmcnt(0)\n\ts_barrier" ::: "memory");
    DMA_TILE(0, 0, 0); DMA_TILE(1, 1, 1); DMA_TILE(2, 2, 2);
    prep_q<DK>(U, qr, wid, r32, hi);
    WAIT_BAR(6);
    qkt_c<DK>(pA0, pA1, K_lds, qr, cinit, r32, hi); MASK(pA0, pA1, 0); partialF(pA0);
    int kn = 1, vc = 0, k3 = 0, v3 = 3;
#define STEP_A(t_) do { WAIT_BAR(3); DMA_TILE((t_) + 3, k3, v3); \
        SBAR(); qkt_c<DK>(pB0, pB1, K_lds + kn * SHM_K, qr, cinit, r32, hi); MASK(pB0, pB1, (t_) + 1); \
        finishF_ns(pA0, pA1, lacc, pa0, pa1, pa2, pa3); SBAR(); \
        { const int vb = vb0 + vc * SHM_V; pv_one<0>(o[0], vb, pa0, pa1, pa2, pa3); pv_one<1>(o[1], vb, pa0, pa1, pa2, pa3); } partialF(pB0); \
        kn = kn == 2 ? 0 : kn + 1; vc = (vc + 1) & 3; k3 = k3 == 2 ? 0 : k3 + 1; v3 = (v3 + 1) & 3; } while (0)
#define STEP_B(t_, HAS_NEXT) do { WAIT_BAR(3); DMA_TILE((t_) + 4, k3, v3); \
        SBAR(); if (HAS_NEXT) { qkt_c<DK>(pA0, pA1, K_lds + kn * SHM_K, qr, cinit, r32, hi); MASK(pA0, pA1, (t_) + 2); } \
        finishF_ns(pB0, pB1, lacc, pa0, pa1, pa2, pa3); SBAR(); \
        { const int vb = vb0 + vc * SHM_V; pv_one<0>(o[0], vb, pa0, pa1, pa2, pa3); pv_one<1>(o[1], vb, pa0, pa1, pa2, pa3); } if (HAS_NEXT) partialF(pA0); \
        kn = kn == 2 ? 0 : kn + 1; vc = (vc + 1) & 3; k3 = k3 == 2 ? 0 : k3 + 1; v3 = (v3 + 1) & 3; } while (0)
    if (wid >= 4) asm volatile("s_setprio 1" ::: "memory");
    int t = 0;
    for (; t + 2 < NT; t += 2) { STEP_A(t); STEP_B(t, true); }
    STEP_A(t); STEP_B(t, false);
    asm volatile("s_setprio 0" ::: "memory");
#undef STEP_A
#undef STEP_B
    asm volatile("s_waitcnt vmcnt(0)" ::: "memory");
    float lsum = lacc.x + lacc.y;
    { auto rr = __builtin_amdgcn_permlane32_swap(__float_as_uint(lsum), __float_as_uint(lsum), false, false); lsum = __uint_as_float(rr[0]) + __uint_as_float(rr[1]); }
    if (U.has_sink) lsum += __builtin_amdgcn_exp2f(U.sink * LOG2E);
    if (hi == 0) li_l[r32] = lsum; asm volatile("s_waitcnt lgkmcnt(0)" ::: "memory");
    float rli[16];
#pragma unroll
    for (int r = 0; r < 16; ++r) rli[r] = __builtin_amdgcn_rcpf(li_l[crow(r, hi)]);
    bf16* Ow = U.O + (size_t)(wid * 32) * U.ldo;
#pragma unroll
    for (int r = 0; r < 16; ++r) { const int orow = crow(r, hi);
#pragma unroll
        for (int d0 = 0; d0 < 2; ++d0) Ow[(size_t)orow * U.ldo + d0 * 32 + r32] = (bf16)f2bf(o[d0][r] * rli[r]); }
#undef DMA_TILE
#undef MASK
}

template <int V> struct IC { static constexpr int v = V; };
template <int I, int N, class F> __device__ __forceinline__ void sfor(F&& f) { if constexpr (I < N) { f(IC<I>{}); sfor<I + 1, N>(f); } }
template <int OFF> __device__ __forceinline__ bf16x8 rd128(int a) { u32x4 r; asm volatile("ds_read_b128 %0, %1 offset:%2" : "=&v"(r) : "v"(a), "i"(OFF) : "memory"); return __builtin_bit_cast(bf16x8, r); }
template <int N> __device__ __forceinline__ void lgkm_wait() { asm volatile("s_waitcnt lgkmcnt(%0)" :: "n"(N) : "memory"); }
#ifndef PP_PRIO
#define PP_PRIO 1
#endif
#ifndef PP_GRP
#define PP_GRP(w) ((w) >> 2)
#endif
template <int DK> __device__ __forceinline__ void attn_unit_pp(const Unit& U, LAS char* lds, const int tid) {
    constexpr int KS = 2 * DK + 16, SHM_V = 8192, SHM_K = 64 * KS, NKP = DK / 8, NPK = SHM_K / 1024;
    static_assert(SHM_K % 1024 == 0, "K tile is a whole number of 1 KiB DMA pieces");
    const int wid = __builtin_amdgcn_readfirstlane(tid >> 6), lane = tid & 63, r32 = lane & 31, hi = lane >> 5;
    LAS char* V_lds = lds; LAS char* K_lds = lds + 4 * SHM_V;
    LAS float* ws = (LAS float*)(lds + 4 * SHM_V + 3 * SHM_K) + wid * 64; LAS float* li_l = ws;
    const unsigned lds0 = (unsigned)(uintptr_t)lds;
    float lsum = 0; f32x16 o[2] = {}; bf16x8 qr[DK / 16];
    const f32x16 cinit = {};
    const bf16* Qw = U.Q + (size_t)(wid * 32 + r32) * U.ldq + hi * 8;
#pragma unroll
    for (int d0 = 0; d0 < DK / 16; ++d0) qr[d0] = *(const bf16x8*)(Qw + d0 * 16);
    prep_q<DK>(U, qr, wid, r32, hi);
    const int kp1 = (wid + 8 < NPK) ? wid + 8 : wid;
    int koff0, koff1, voff;
    { const int b0 = wid * 1024 + lane * 16, r0 = b0 / KS, c0 = (b0 % KS) / 16; koff0 = r0 * U.ldk + (c0 < NKP ? c0 : 0) * 8;
      const int b1 = kp1 * 1024 + lane * 16, r1 = b1 / KS, c1 = (b1 % KS) / 16; koff1 = r1 * U.ldk + (c1 < NKP ? c1 : 0) * 8;
      const int i = wid * 64 + lane, sub = i >> 5, sl = i & 31, kk = (sub >> 1) * 8 + (sl >> 2), c = (sub & 1) * 32 + (sl & 3) * 8, key = (kk & ~0xC) | ((kk & 4) << 1) | ((kk & 8) >> 1);
      voff = key * U.ldk + c; }
    const unsigned kdst0 = lds0 + 4 * SHM_V + wid * 1024, kdst1 = lds0 + 4 * SHM_V + kp1 * 1024, vdst = lds0 + wid * 1024;
    const int vb0 = (int)lds0 + v_rd_base(lane);
    const int ka0 = (int)lds0 + 4 * SHM_V + r32 * KS + hi * 16;
    const int NT = U.nA + U.nB;
    auto tile_row = [&](int j) -> int { j = j < NT ? j : NT - 1; if (j < U.nA) return U.rowA + 64 * j; int r = U.rowB + 64 * (j - U.nA); r = r < U.rlo ? U.rlo : r; return r > U.rhi ? U.rhi : r; };
#define DMA_TILE(j, kslot, vslot) do { const size_t ro_ = (size_t)tile_row(j) * U.ldk; \
        glds16(U.V + ro_ + voff, (unsigned)__builtin_amdgcn_readfirstlane(vdst + (vslot) * SHM_V)); \
        glds16(U.K + ro_ + koff0, (unsigned)__builtin_amdgcn_readfirstlane(kdst0 + (kslot) * SHM_K)); \
        glds16(U.K + ro_ + koff1, (unsigned)__builtin_amdgcn_readfirstlane(kdst1 + (kslot) * SHM_K)); } while (0)
#define MASK(P0, P1, j) do { if (U.mask && (j) >= U.nA) { const int kb = U.kb0 + 64 * ((j) - U.nA), dq = wid * 32 + r32; \
        _Pragma("unroll") for (int r = 0; r < 16; ++r) { const int k0_ = kb + crow(r, hi), k1_ = k0_ + 32; \
            const bool ok0 = (k0_ - dq <= 128) && (dq - k0_ <= 128) && ((unsigned)(U.q0 + k0_) < (unsigned)S); \
            const bool ok1 = (k1_ - dq <= 128) && (dq - k1_ <= 128) && ((unsigned)(U.q0 + k1_) < (unsigned)S); \
            P0[r] = ok0 ? P0[r] : -INFINITY; P1[r] = ok1 ? P1[r] : -INFINITY; } } } while (0)
    f32x16 p0, p1; bf16x8 pa0, pa1, pa2, pa3;
    const int grp = PP_GRP(wid);
    asm volatile("s_waitcnt vmcnt(0) lgkmcnt(0)\n\ts_barrier" ::: "memory");
    DMA_TILE(0, 0, 0); DMA_TILE(1, 1, 1); DMA_TILE(2, 2, 2);
    WAIT_BAR(6);
    if (grp) asm volatile("s_barrier" ::: "memory");
    qkt_c<DK>(p0, p1, K_lds, qr, cinit, r32, hi);
    int kn = 1, vc = 0, k3 = 0, v3 = 3;
    for (int k = 0; k < NT; ++k) {
        if (grp == 0) asm volatile("s_barrier" ::: "memory"); else { WAIT_BAR(3); DMA_TILE(k + 3, k3, v3); }
        SBAR(); MASK(p0, p1, k); partialF(p0); finishF(p0, p1, lsum, pa0, pa1, pa2, pa3); asm volatile("" : "+v"(lsum)); SBAR();
        if (grp == 0) { WAIT_BAR(3); DMA_TILE(k + 3, k3, v3); } else if (k + 1 < NT) asm volatile("s_barrier" ::: "memory");
        SBAR();
        if (PP_PRIO) asm volatile("s_setprio 2" ::: "memory");
        if (k + 1 < NT) {
            constexpr int ND = DK / 16, VS = (16 + ND - 1) / ND;
            const int vb = vb0 + vc * SHM_V, ka = ka0 + kn * SHM_K;
            bf16x8 kf[2 * ND]; s16x4 vr[16];
            sfor<0, ND>([&](auto d) __attribute__((always_inline)) { constexpr int d0 = decltype(d)::v; kf[2 * d0] = rd128<d0 * 32>(ka); kf[2 * d0 + 1] = rd128<32 * KS + d0 * 32>(ka); });
            sfor<0, ND>([&](auto d) __attribute__((always_inline)) { constexpr int d0 = decltype(d)::v; constexpr int V0 = VS * d0 < 16 ? VS * d0 : 16, V1 = VS * (d0 + 1) < 16 ? VS * (d0 + 1) : 16;
                lgkm_wait<2 * ND - 2 * (d0 + 1) + V0>(); SBAR();
                p0 = __builtin_amdgcn_mfma_f32_32x32x16_bf16(kf[2 * d0], qr[d0], d0 == 0 ? cinit : p0, 0, 0, 0);
                p1 = __builtin_amdgcn_mfma_f32_32x32x16_bf16(kf[2 * d0 + 1], qr[d0], d0 == 0 ? cinit : p1, 0, 0, 0); SBAR();
                sfor<V0, V1>([&](auto n_) __attribute__((always_inline)) { constexpr int n = decltype(n_)::v, j = n >> 1; vr[n] = tr_read<v_rd_off(j & 1, j >> 1, n & 1)>(vb); }); });
            const bf16x8 pa[4] = {pa0, pa1, pa2, pa3};
            sfor<0, 8>([&](auto j_) __attribute__((always_inline)) { constexpr int j = decltype(j_)::v;
                lgkm_wait<14 - 2 * j>(); SBAR();
                const bf16x8 vf = {vr[2 * j][0], vr[2 * j][1], vr[2 * j][2], vr[2 * j][3], vr[2 * j + 1][0], vr[2 * j + 1][1], vr[2 * j + 1][2], vr[2 * j + 1][3]};
                o[j & 1] = __builtin_amdgcn_mfma_f32_32x32x16_bf16(pa[j >> 1], vf, o[j & 1], 0, 0, 0); SBAR(); });
        } else { const int vb = vb0 + vc * SHM_V; pv_one<0>(o[0], vb, pa0, pa1, pa2, pa3); pv_one<1>(o[1], vb, pa0, pa1, pa2, pa3); }
        if (PP_PRIO) asm volatile("s_setprio 0" ::: "memory");
        kn = kn == 2 ? 0 : kn + 1; vc = (vc + 1) & 3; k3 = k3 == 2 ? 0 : k3 + 1; v3 = (v3 + 1) & 3;
    }
    asm volatile("s_waitcnt vmcnt(0)" ::: "memory");
    { auto rr = __builtin_amdgcn_permlane32_swap(__float_as_uint(lsum), __float_as_uint(lsum), false, false); lsum = __uint_as_float(rr[0]) + __uint_as_float(rr[1]); }
    if (U.has_sink) lsum += __builtin_amdgcn_exp2f(U.sink * LOG2E);
    if (hi == 0) li_l[r32] = lsum; asm volatile("s_waitcnt lgkmcnt(0)" ::: "memory");
    float rli[16];
#pragma unroll
    for (int r = 0; r < 16; ++r) rli[r] = __builtin_amdgcn_rcpf(li_l[crow(r, hi)]);
    bf16* Ow = U.O + (size_t)(wid * 32) * U.ldo;
#pragma unroll
    for (int r = 0; r < 16; ++r) { const int orow = crow(r, hi);
#pragma unroll
        for (int d0 = 0; d0 < 2; ++d0) Ow[(size_t)orow * U.ldo + d0 * 32 + r32] = (bf16)f2bf(o[d0][r] * rli[r]); }
#undef DMA_TILE
#undef MASK
}

__device__ __forceinline__ void finishF_b(f32x16& p0, f32x16& p1, float& lsum, bf16x8& pa0, bf16x8& pa1, bf16x8& pa2, bf16x8& pa3) {
    { const f32x16 s16 = p0 + p1;
      const float a0 = (s16[0] + s16[1]) + (s16[2] + s16[3]), a1 = (s16[4] + s16[5]) + (s16[6] + s16[7]), a2 = (s16[8] + s16[9]) + (s16[10] + s16[11]), a3 = (s16[12] + s16[13]) + (s16[14] + s16[15]);
      lsum += (a0 + a1) + (a2 + a3); }
#define PK4(P, BASE, OUT) do { unsigned a0 = cvtpk(P[BASE + 0], P[BASE + 1]), a1 = cvtpk(P[BASE + 2], P[BASE + 3]);   \
    unsigned b0 = cvtpk(P[BASE + 4], P[BASE + 5]), b1 = cvtpk(P[BASE + 6], P[BASE + 7]);                              \
    auto r0 = __builtin_amdgcn_permlane32_swap(a0, b0, false, false); auto r1 = __builtin_amdgcn_permlane32_swap(a1, b1, false, false); \
    u32x4 w = {r0[0], r1[0], r0[1], r1[1]}; OUT = *reinterpret_cast<bf16x8*>(&w); } while (0)
    PK4(p0, 0, pa0); PK4(p0, 8, pa1); PK4(p1, 0, pa2); PK4(p1, 8, pa3);
#undef PK4
}
template <int DK, int EX> __device__ __forceinline__ void attn_unit_dma_x(const Unit& U, LAS char* lds, const int tid) {
    constexpr int KS = 2 * DK + 16, SHM_V = 8192, SHM_K = 64 * KS, NKP = DK / 8, NPK = SHM_K / 1024;
    static_assert(SHM_K % 1024 == 0, "K tile is a whole number of 1 KiB DMA pieces");
    const int wid = __builtin_amdgcn_readfirstlane(tid >> 6), lane = tid & 63, r32 = lane & 31, hi = lane >> 5;
    LAS char* V_lds = lds; LAS char* K_lds = lds + 4 * SHM_V;
    LAS float* ws = (LAS float*)(lds + 4 * SHM_V + 3 * SHM_K) + wid * 64; LAS float* li_l = ws;
    const unsigned lds0 = (unsigned)(uintptr_t)lds;
    float lsum = 0; f32x16 o[2] = {}; bf16x8 qr[DK / 16];
    const f32x16 cinit = {};
    const bf16* Qw = U.Q + (size_t)(wid * 32 + r32) * U.ldq + hi * 8;
#pragma unroll
    for (int d0 = 0; d0 < DK / 16; ++d0) qr[d0] = *(const bf16x8*)(Qw + d0 * 16);
    const int kp1 = (wid + 8 < NPK) ? wid + 8 : wid;
    int koff0, koff1, voff;
    { const int b0 = wid * 1024 + lane * 16, r0 = b0 / KS, c0 = (b0 % KS) / 16; koff0 = r0 * U.ldk + (c0 < NKP ? c0 : 0) * 8;
      const int b1 = kp1 * 1024 + lane * 16, r1 = b1 / KS, c1 = (b1 % KS) / 16; koff1 = r1 * U.ldk + (c1 < NKP ? c1 : 0) * 8;
      const int i = wid * 64 + lane, sub = i >> 5, sl = i & 31, kk = (sub >> 1) * 8 + (sl >> 2), c = (sub & 1) * 32 + (sl & 3) * 8, key = (kk & ~0xC) | ((kk & 4) << 1) | ((kk & 8) >> 1);
      voff = key * U.ldk + c; }
    const unsigned kdst0 = lds0 + 4 * SHM_V + wid * 1024, kdst1 = lds0 + 4 * SHM_V + kp1 * 1024, vdst = lds0 + wid * 1024;
    const int vb0 = (int)lds0 + v_rd_base(lane);
    const int NT = U.nA + U.nB;
    auto tile_row = [&](int j) -> int { j = j < NT ? j : NT - 1; if (j < U.nA) return U.rowA + 64 * j; int r = U.rowB + 64 * (j - U.nA); r = r < U.rlo ? U.rlo : r; return r > U.rhi ? U.rhi : r; };
#define DMA_TILE(j, kslot, vslot) do { if (EX == 2) break; const size_t ro_ = (size_t)tile_row(j) * U.ldk; \
        glds16(U.V + ro_ + voff, (unsigned)__builtin_amdgcn_readfirstlane(vdst + (vslot) * SHM_V)); \
        glds16(U.K + ro_ + koff0, (unsigned)__builtin_amdgcn_readfirstlane(kdst0 + (kslot) * SHM_K)); \
        glds16(U.K + ro_ + koff1, (unsigned)__builtin_amdgcn_readfirstlane(kdst1 + (kslot) * SHM_K)); } while (0)
#define MASK(P0, P1, j) do { if (U.mask && (j) >= U.nA) { const int kb = U.kb0 + 64 * ((j) - U.nA), dq = wid * 32 + r32; \
        _Pragma("unroll") for (int r = 0; r < 16; ++r) { const int k0_ = kb + crow(r, hi), k1_ = k0_ + 32; \
            const bool ok0 = (k0_ - dq <= 128) && (dq - k0_ <= 128) && ((unsigned)(U.q0 + k0_) < (unsigned)S); \
            const bool ok1 = (k1_ - dq <= 128) && (dq - k1_ <= 128) && ((unsigned)(U.q0 + k1_) < (unsigned)S); \
            P0[r] = ok0 ? P0[r] : -INFINITY; P1[r] = ok1 ? P1[r] : -INFINITY; } } } while (0)
    f32x16 pA0, pA1, pB0, pB1; bf16x8 pa0, pa1, pa2, pa3;
    asm volatile("s_waitcnt vmcnt(0) lgkmcnt(0)\n\ts_barrier" ::: "memory");
    DMA_TILE(0, 0, 0); DMA_TILE(1, 1, 1); DMA_TILE(2, 2, 2);
    WAIT_BAR(6);
    qkt_c<DK>(pA0, pA1, K_lds, qr, cinit, r32, hi); MASK(pA0, pA1, 0); partialF(pA0);
    int kn = 1, vc = 0, k3 = 0, v3 = 3;
#define STEP_A(t_) do { if (EX == 6) {} else if (EX == 2) asm volatile("s_waitcnt lgkmcnt(0)\n\ts_barrier" ::: "memory"); else WAIT_BAR(3); DMA_TILE((t_) + 3, k3, v3); \
        SBAR(); if (EX != 5) qkt_c<DK>(pB0, pB1, K_lds + kn * SHM_K, qr, cinit, r32, hi); else { asm volatile("" : "+v"(pB0), "+v"(pB1)); } MASK(pB0, pB1, (t_) + 1); \
        if (EX != 3) finishF(pA0, pA1, lsum, pa0, pa1, pa2, pa3); else finishF_b(pA0, pA1, lsum, pa0, pa1, pa2, pa3); SBAR(); \
        { const int vb = vb0 + vc * SHM_V; if (EX != 4) { pv_one<0>(o[0], vb, pa0, pa1, pa2, pa3); pv_one<1>(o[1], vb, pa0, pa1, pa2, pa3); } else { asm volatile("" :: "v"(pa0), "v"(pa1), "v"(pa2), "v"(pa3)); } } if (EX != 3) partialF(pB0); \
        kn = kn == 2 ? 0 : kn + 1; vc = (vc + 1) & 3; k3 = k3 == 2 ? 0 : k3 + 1; v3 = (v3 + 1) & 3; } while (0)
#define STEP_B(t_, HAS_NEXT) do { if (EX == 6) {} else if (EX == 2) asm volatile("s_waitcnt lgkmcnt(0)\n\ts_barrier" ::: "memory"); else WAIT_BAR(3); DMA_TILE((t_) + 4, k3, v3); \
        SBAR(); if (HAS_NEXT) { if (EX != 5) qkt_c<DK>(pA0, pA1, K_lds + kn * SHM_K, qr, cinit, r32, hi); else { asm volatile("" : "+v"(pA0), "+v"(pA1)); } MASK(pA0, pA1, (t_) + 2); } \
        if (EX != 3) finishF(pB0, pB1, lsum, pa0, pa1, pa2, pa3); else finishF_b(pB0, pB1, lsum, pa0, pa1, pa2, pa3); SBAR(); \
        { const int vb = vb0 + vc * SHM_V; if (EX != 4) { pv_one<0>(o[0], vb, pa0, pa1, pa2, pa3); pv_one<1>(o[1], vb, pa0, pa1, pa2, pa3); } else { asm volatile("" :: "v"(pa0), "v"(pa1), "v"(pa2), "v"(pa3)); } } if (HAS_NEXT && EX != 3) partialF(pA0); \
        kn = kn == 2 ? 0 : kn + 1; vc = (vc + 1) & 3; k3 = k3 == 2 ? 0 : k3 + 1; v3 = (v3 + 1) & 3; } while (0)
    int t = 0;
    for (; t + 2 < NT; t += 2) { STEP_A(t); STEP_B(t, true); }
    STEP_A(t); STEP_B(t, false);
#undef STEP_A
#undef STEP_B
    asm volatile("s_waitcnt vmcnt(0)" ::: "memory");
    { auto rr = __builtin_amdgcn_permlane32_swap(__float_as_uint(lsum), __float_as_uint(lsum), false, false); lsum = __uint_as_float(rr[0]) + __uint_as_float(rr[1]); }
    if (U.has_sink) lsum += __builtin_amdgcn_exp2f(U.sink * LOG2E);
    if (hi == 0) li_l[r32] = lsum; asm volatile("s_waitcnt lgkmcnt(0)" ::: "memory");
    float rli[16];
#pragma unroll
    for (int r = 0; r < 16; ++r) rli[r] = __builtin_amdgcn_rcpf(li_l[crow(r, hi)]);
    asm volatile("" :: "v"(o[0]), "v"(o[1]), "v"(rli[0]), "v"(rli[7]), "v"(rli[15]));
#undef DMA_TILE
#undef MASK
}

typedef float f32x4_ __attribute__((ext_vector_type(4)));
template <int OFF> __device__ __forceinline__ s16x4 tr_read16(int vb) { s16x4 r; asm volatile("ds_read_b64_tr_b16 %0, %1 offset:%2" : "=&v"(r) : "v"(vb), "i"(OFF) : "memory"); return r; }
template <int DK> __device__ __forceinline__ void attn_unit_dma16(const Unit& U, LAS char* lds, const int tid) {
    constexpr int KS = 2 * DK + 16, VS = 160, SHM_V = 64 * VS, SHM_K = 64 * KS, NKP = DK / 8, NPK = SHM_K / 1024, NPV = SHM_V / 1024, NDS = DK / 32;
    static_assert(SHM_K % 1024 == 0 && SHM_V % 1024 == 0, "whole DMA pieces");
    const int wid = __builtin_amdgcn_readfirstlane(tid >> 6), lane = tid & 63, c = lane & 15, g = lane >> 4;
    LAS char* V_lds = lds; LAS char* K_lds = lds + 4 * SHM_V;
    const unsigned lds0 = (unsigned)(uintptr_t)lds;
    float lsum[2] = {0.f, 0.f}; f32x4_ o[4][2]; bf16x8 qf[2][NDS];
#pragma unroll
    for (int d = 0; d < 4; ++d)
#pragma unroll
        for (int q = 0; q < 2; ++q) o[d][q] = (f32x4_){0.f, 0.f, 0.f, 0.f};
#pragma unroll
    for (int qb = 0; qb < 2; ++qb)
#pragma unroll
        for (int ds = 0; ds < NDS; ++ds) qf[qb][ds] = *(const bf16x8*)(U.Q + (size_t)(wid * 32 + 16 * qb + c) * U.ldq + 32 * ds + 8 * g);
    const int kp1 = (wid + 8 < NPK) ? wid + 8 : wid, vp1 = (wid + 8 < NPV) ? wid + 8 : wid;
    int koff0, koff1, voff0, voff1;
    { const int b0 = wid * 1024 + lane * 16, r0 = b0 / KS, c0 = (b0 % KS) / 16; koff0 = r0 * U.ldk + (c0 < NKP ? c0 : 0) * 8;
      const int b1 = kp1 * 1024 + lane * 16, r1 = b1 / KS, c1 = (b1 % KS) / 16; koff1 = r1 * U.ldk + (c1 < NKP ? c1 : 0) * 8;
      const int b2 = wid * 1024 + lane * 16, r2 = b2 / VS, c2 = (b2 % VS) / 16; voff0 = r2 * U.ldk + (c2 < 8 ? c2 : 0) * 8;
      const int b3 = vp1 * 1024 + lane * 16, r3 = b3 / VS, c3 = (b3 % VS) / 16; voff1 = r3 * U.ldk + (c3 < 8 ? c3 : 0) * 8; }
    const unsigned kdst0 = lds0 + 4 * SHM_V + wid * 1024, kdst1 = lds0 + 4 * SHM_V + kp1 * 1024, vdst0 = lds0 + wid * 1024, vdst1 = lds0 + vp1 * 1024;
    const int kb0_ = c * KS + 16 * g;
    const int vrd = (int)lds0 + (4 * g + ((lane >> 2) & 3)) * VS + (lane & 3) * 8;
    const int NT = U.nA + U.nB;
    auto tile_row = [&](int j) -> int { j = j < NT ? j : NT - 1; if (j < U.nA) return U.rowA + 64 * j; int r = U.rowB + 64 * (j - U.nA); r = r < U.rlo ? U.rlo : r; return r > U.rhi ? U.rhi : r; };
#define DMA_TILE(j, kslot, vslot) do { const size_t ro_ = (size_t)tile_row(j) * U.ldk; \
        glds16(U.V + ro_ + voff0, (unsigned)__builtin_amdgcn_readfirstlane(vdst0 + (vslot) * SHM_V)); \
        glds16(U.V + ro_ + voff1, (unsigned)__builtin_amdgcn_readfirstlane(vdst1 + (vslot) * SHM_V)); \
        glds16(U.K + ro_ + koff0, (unsigned)__builtin_amdgcn_readfirstlane(kdst0 + (kslot) * SHM_K)); \
        glds16(U.K + ro_ + koff1, (unsigned)__builtin_amdgcn_readfirstlane(kdst1 + (kslot) * SHM_K)); } while (0)
#define WAIT_BAR4(N) asm volatile("s_waitcnt vmcnt(" #N ") lgkmcnt(0)\n\ts_barrier" ::: "memory")
#define QK16(SC, Ks) do { bf16x8 kf[4][NDS]; \
        _Pragma("unroll") for (int kb = 0; kb < 4; ++kb) _Pragma("unroll") for (int ds = 0; ds < NDS; ++ds) kf[kb][ds] = *(const LAS bf16x8*)((Ks) + kb0_ + kb * 16 * KS + ds * 64); \
        SBAR(); \
        _Pragma("unroll") for (int ds = 0; ds < NDS; ++ds) _Pragma("unroll") for (int kb = 0; kb < 4; ++kb) _Pragma("unroll") for (int qb = 0; qb < 2; ++qb) \
            SC[kb][qb] = __builtin_amdgcn_mfma_f32_16x16x32_bf16(kf[kb][ds], qf[qb][ds], ds == 0 ? (f32x4_){0.f, 0.f, 0.f, 0.f} : SC[kb][qb], 0, 0, 0); } while (0)
#define MASK16(SC, j) do { if (U.mask && (j) >= U.nA) { const int kbase = U.kb0 + 64 * ((j) - U.nA); \
        _Pragma("unroll") for (int kb = 0; kb < 4; ++kb) _Pragma("unroll") for (int qb = 0; qb < 2; ++qb) _Pragma("unroll") for (int i = 0; i < 4; ++i) { \
            const int k_ = kbase + 16 * kb + 4 * g + i, dq = wid * 32 + 16 * qb + c; \
            const bool ok = (k_ - dq <= 128) && (dq - k_ <= 128) && ((unsigned)(U.q0 + k_) < (unsigned)S); SC[kb][qb][i] = ok ? SC[kb][qb][i] : -INFINITY; } } } while (0)
#define EXPH(SC, KB0) do { _Pragma("unroll") for (int kb = KB0; kb < KB0 + 2; ++kb) _Pragma("unroll") for (int qb = 0; qb < 2; ++qb) _Pragma("unroll") for (int i = 0; i < 4; ++i) SC[kb][qb][i] = __builtin_amdgcn_exp2f(SC[kb][qb][i]); } while (0)
#define FINISH16(SC) do { EXPH(SC, 2); \
        _Pragma("unroll") for (int qb = 0; qb < 2; ++qb) { const f32x4_ t0 = SC[0][qb] + SC[1][qb], t1 = SC[2][qb] + SC[3][qb], t = t0 + t1; lsum[qb] += (t[0] + t[1]) + (t[2] + t[3]); \
            _Pragma("unroll") for (int s_ = 0; s_ < 2; ++s_) { u32x4 w_ = {cvtpk(SC[2 * s_][qb][0], SC[2 * s_][qb][1]), cvtpk(SC[2 * s_][qb][2], SC[2 * s_][qb][3]), cvtpk(SC[2 * s_ + 1][qb][0], SC[2 * s_ + 1][qb][1]), cvtpk(SC[2 * s_ + 1][qb][2], SC[2 * s_ + 1][qb][3])}; \
                pb[s_][qb] = *reinterpret_cast<bf16x8*>(&w_); } } } while (0)
#define PVS(S_, vb_) do { s16x4 va[4], vh[4]; \
        va[0] = tr_read16<(S_) * 32 * VS + 0>(vb_); vh[0] = tr_read16<(S_) * 32 * VS + 16 * VS + 0>(vb_); va[1] = tr_read16<(S_) * 32 * VS + 32>(vb_); vh[1] = tr_read16<(S_) * 32 * VS + 16 * VS + 32>(vb_); \
        va[2] = tr_read16<(S_) * 32 * VS + 64>(vb_); vh[2] = tr_read16<(S_) * 32 * VS + 16 * VS + 64>(vb_); va[3] = tr_read16<(S_) * 32 * VS + 96>(vb_); vh[3] = tr_read16<(S_) * 32 * VS + 16 * VS + 96>(vb_); \
        asm volatile("s_waitcnt lgkmcnt(0)" ::: "memory"); SBAR(); \
        _Pragma("unroll") for (int dvb = 0; dvb < 4; ++dvb) { const bf16x8 vf = (bf16x8){va[dvb][0], va[dvb][1], va[dvb][2], va[dvb][3], vh[dvb][0], vh[dvb][1], vh[dvb][2], vh[dvb][3]}; \
            _Pragma("unroll") for (int qb = 0; qb < 2; ++qb) o[dvb][qb] = __builtin_amdgcn_mfma_f32_16x16x32_bf16(vf, pb[(S_)][qb], o[dvb][qb], 0, 0, 0); } } while (0)
    f32x4_ scA[4][2], scB[4][2]; bf16x8 pb[2][2];
    asm volatile("s_waitcnt vmcnt(0) lgkmcnt(0)\n\ts_barrier" ::: "memory");
    DMA_TILE(0, 0, 0); DMA_TILE(1, 1, 1); DMA_TILE(2, 2, 2);
    WAIT_BAR4(8);
    QK16(scA, K_lds); MASK16(scA, 0); EXPH(scA, 0);
    int kn = 1, vc = 0, k3 = 0, v3 = 3;
#define STEP_A(t_) do { WAIT_BAR4(4); DMA_TILE((t_) + 3, k3, v3); \
        SBAR(); QK16(scB, K_lds + kn * SHM_K); MASK16(scB, (t_) + 1); FINISH16(scA); SBAR(); \
        { const int vb_ = vrd + vc * SHM_V; PVS(0, vb_); PVS(1, vb_); } EXPH(scB, 0); \
        kn = kn == 2 ? 0 : kn + 1; vc = (vc + 1) & 3; k3 = k3 == 2 ? 0 : k3 + 1; v3 = (v3 + 1) & 3; } while (0)
#define STEP_B(t_, HAS_NEXT) do { WAIT_BAR4(4); DMA_TILE((t_) + 4, k3, v3); \
        SBAR(); if (HAS_NEXT) { QK16(scA, K_lds + kn * SHM_K); MASK16(scA, (t_) + 2); } FINISH16(scB); SBAR(); \
        { const int vb_ = vrd + vc * SHM_V; PVS(0, vb_); PVS(1, vb_); } if (HAS_NEXT) EXPH(scA, 0); \
        kn = kn == 2 ? 0 : kn + 1; vc = (vc + 1) & 3; k3 = k3 == 2 ? 0 : k3 + 1; v3 = (v3 + 1) & 3; } while (0)
    int t = 0;
    for (; t + 2 < NT; t += 2) { STEP_A(t); STEP_B(t, true); }
    STEP_A(t); STEP_B(t, false);
#undef STEP_A
#undef STEP_B
    asm volatile("s_waitcnt vmcnt(0)" ::: "memory");
    const float snk = U.has_sink ? __builtin_amdgcn_exp2f(U.sink * LOG2E) : 0.f;
#pragma unroll
    for (int qb = 0; qb < 2; ++qb) { float l = lsum[qb]; l += __shfl_xor(l, 16); l += __shfl_xor(l, 32); const float rl = __builtin_amdgcn_rcpf(l + snk);
        bf16* orow = U.O + (size_t)(wid * 32 + 16 * qb + c) * U.ldo + 4 * g;
#pragma unroll
        for (int dvb = 0; dvb < 4; ++dvb) { const f32x4_ v = o[dvb][qb] * rl; *(u32x2*)(orow + 16 * dvb) = (u32x2){pk2(v[0], v[1]), pk2(v[2], v[3])}; } }
#undef DMA_TILE
#undef WAIT_BAR4
#undef QK16
#undef MASK16
#undef EXPH
#undef FINISH16
#undef PVS
}
}

constexpr float SWA_C2 = 0.125f * LOG2E;
__device__ __forceinline__ bool swa_fast(const Frame& F, int li) {
    float mq = 0.f, mk = 0.f, ms = -1e30f;
    for (int j = 0; j < 64; ++j) { mq = fmaxf(mq, fabsf(inp(F, I_SWAQG)[li * 64 + j])); mk = fmaxf(mk, fabsf(inp(F, I_SWAKG)[li * 64 + j])); }
    for (int j = 0; j < 12; ++j) ms = fmaxf(ms, inp(F, I_SINK)[li * 12 + j]);
    const float Mref = 8.f * LOG2E * mq * mk * 1.01f;
    return (Mref < 40.f) && (ms * LOG2E < 40.f);
}
__device__ __forceinline__ void phase_even_qk(Frame& F, int li, bool dry = false) {
    bf16* P = (bf16*)(F.ws + A_P); bf16* MIX = (bf16*)(F.ws + A_MIX);
    const f32x2* r64 = (const f32x2*)(F.ws + WS_ROPE);
    {
        const bool fast = swa_fast(F, li);
        const int head = fast ? 12 + ((F.lane >> 2) & 3) : F.lane >> 2, qt = F.lane & 3, RP = fast ? 4 : 1, sub = fast ? F.lane >> 4 : 0, NR = T / RP;
        const float* gain = (head < 12 ? inp(F, I_SWAQG) : inp(F, I_SWAKG)) + li * 64 + 16 * qt;
        float gn[16];
#pragma unroll
        for (int j = 0; j < 16; ++j) gn[j] = gain[j] * (head < 12 ? SWA_C2 : 1.f);
        u32x4 na = {0u, 0u, 0u, 0u}, nb = na;
        if (F.gw < NR) { const bf16* p = P + (size_t)(F.gw * RP + sub) * EV_N + 256 + 64 * head + 16 * qt; na = *(const u32x4*)p; nb = *(const u32x4*)(p + 8); }
        for (int rq = F.gw; rq < NR; rq += F.NGW) {
            const int r = rq * RP + sub;
            bf16* p = P + (size_t)r * EV_N + 256 + 64 * head + 16 * qt;
            const u32x4 a = na, b = nb;
            if (rq + F.NGW < NR) { const bf16* pn = P + (size_t)((rq + F.NGW) * RP + sub) * EV_N + 256 + 64 * head + 16 * qt; na = *(const u32x4*)pn; nb = *(const u32x4*)(pn + 8); }
            float v[16] = {bflo(a.x), bfhi(a.x), bflo(a.y), bfhi(a.y), bflo(a.z), bfhi(a.z), bflo(a.w), bfhi(a.w), bflo(b.x), bfhi(b.x), bflo(b.y), bfhi(b.y), bflo(b.z), bfhi(b.z), bflo(b.w), bfhi(b.w)};
            float ss = 0.f;
#pragma unroll
            for (int j = 0; j < 16; ++j) ss += v[j] * v[j];
            ss += dpp_f<0xB1>(ss); ss += dpp_f<0x4E>(ss);
            const float rstd = 1.f / sqrtf(ss * (1.f / 64.f) + EPS);
#pragma unroll
            for (int j = 0; j < 16; ++j) v[j] = v[j] * rstd * gn[j];
            if (r < TL) { const int s = r % S; const f32x2* cs = r64 + (size_t)s * 32 + 16 * (qt & 1);
#pragma unroll
                for (int j = 0; j < 16; ++j) { const float pr = dpp_f<0x4E>(v[j]); const f32x2 c = cs[j]; v[j] = (qt < 2) ? v[j] * c.x - pr * c.y : v[j] * c.x + pr * c.y; } }
            if (!dry) { *(u32x4*)p = (u32x4){pk2(v[0], v[1]), pk2(v[2], v[3]), pk2(v[4], v[5]), pk2(v[6], v[7])};
            *(u32x4*)(p + 8) = (u32x4){pk2(v[8], v[9]), pk2(v[10], v[11]), pk2(v[12], v[13]), pk2(v[14], v[15])}; }
        }
    }
}
__device__ __forceinline__ void phase_even_pool(Frame& F, int li, int t_begin = 0, int t_end = T / 32, int c_ = -1) {
    const bf16* P = (const bf16*)(F.ws + A_P); bf16* MIX = (bf16*)(F.ws + A_MIX);
    __syncthreads();
    constexpr int LPS = 264;
    LAS float* la = (LAS float*)F.lds;
    LAS bf16* lpb = (LAS bf16*)(la + 48 * 256);
    const int d = F.tid & 255, g = d >> 6, hh = F.tid >> 8, hw = 1 << g;
    const int gw_ = F.wave >> 1, nb = F.wave & 1, r32 = F.lane & 31, hi = F.lane >> 5;
    const bf16* wpt = (const bf16*)(F.ws + WS_WPT) + ((size_t)(li * 4 + gw_) * 64 + 32 * nb + r32) * 64 + 8 * hi;
    bf16x8 bfr[4];
#pragma unroll
    for (int ks = 0; ks < 4; ++ks) bfr[ks] = *(const bf16x8*)(wpt + 16 * ks);
    float ps[16];
#pragma unroll
    for (int r = 0; r < 16; ++r) ps[r] = inp(F, I_POOLS)[li * 256 + 64 * gw_ + 32 * nb + (r & 3) + 8 * (r >> 2) + 4 * hi];
    u32x4 nw[3];
    auto tile_geo = [&](int tile, int& r0, int& L, int& seq0, int& t0) { r0 = tile * 32; const bool lat = r0 < TL; L = lat ? S : CL; seq0 = lat ? (r0 / S) * S : TL + ((r0 - TL) / CL) * CL; t0 = r0 - seq0; };
    auto fetch = [&](int tile) { int r0, L, seq0, t0; tile_geo(tile, r0, L, seq0, t0);
#pragma unroll
        for (int k = 0; k < 3; ++k) { const int i = F.tid + NTHR * k, rr = i >> 5, c8 = (i & 31) * 8, t = t0 - 8 + rr;
            nw[k] = (u32x4){0u, 0u, 0u, 0u}; if (t >= 0 && t < L) nw[k] = *(const u32x4*)(P + (size_t)(seq0 + t) * EV_N + c8); } };
    const int tfirst = t_begin + (c_ < 0 ? F.vcu : c_);
    if (tfirst < t_end) fetch(tfirst);
    for (int tile = tfirst; tile < t_end; tile += F.G) {
        int r0, L, seq0, t0; tile_geo(tile, r0, L, seq0, t0);
        __syncthreads();
#pragma unroll
        for (int k = 0; k < 3; ++k) { const int i = F.tid + NTHR * k, rr = i >> 5, c8 = (i & 31) * 8; const u32x4 w = nw[k];
            LAS f32x4* dst = (LAS f32x4*)(la + rr * 256 + c8); dst[0] = (f32x4){bflo(w.x), bfhi(w.x), bflo(w.y), bfhi(w.y)}; dst[1] = (f32x4){bflo(w.z), bfhi(w.z), bflo(w.w), bfhi(w.w)}; }
        if (tile + F.G < t_end) fetch(tile + F.G);
        __syncthreads();
        { const int R0 = hh * 16; const bool inner = (t0 >= 8) && (t0 + 40 <= L);
          const LAS float* pM = la + (R0 + 8 - hw) * 256 + d; const LAS float* pC = la + (R0 + 8) * 256 + d; const LAS float* pP = la + (R0 + 8 + hw) * 256 + d;
          float s = 0.f; for (int k = 0; k < 2 * hw; ++k) s += pM[k * 256];
          const float rin = 1.f / (float)(2 * hw);
#pragma unroll
          for (int i = 0; i < 16; ++i) { float rc = rin;
              if (!inner) { const int t = t0 + R0 + i; int lo = t - hw, hi_ = t + hw; lo = lo < 0 ? 0 : lo; hi_ = hi_ > L ? L : hi_; rc = 1.f / (float)(hi_ - lo); }
              lpb[(R0 + i) * LPS + d] = (bf16)f2bf(s * rc - pC[i * 256]);
              if (i < 15) s += pP[i * 256] - pM[i * 256]; } }
        __syncthreads();
        { f32x16 acc = {};
#pragma unroll
          for (int ks = 0; ks < 4; ++ks) { const bf16x8 af = *(const LAS bf16x8*)(lpb + r32 * LPS + 64 * gw_ + 16 * ks + 8 * hi); acc = __builtin_amdgcn_mfma_f32_32x32x16_bf16(bfr[ks], af, acc, 0, 0, 0); }
          bf16* orow = MIX + (size_t)(r0 + r32) * D + 64 * gw_ + 32 * nb + 4 * hi;
#pragma unroll
          for (int q = 0; q < 4; ++q) *(u32x2*)(orow + 8 * q) = (u32x2){pk2(acc[4 * q] * ps[4 * q], acc[4 * q + 1] * ps[4 * q + 1]), pk2(acc[4 * q + 2] * ps[4 * q + 2], acc[4 * q + 3] * ps[4 * q + 3])}; }
    }
    __syncthreads();
}

__device__ __forceinline__ void phase_swa(Frame& F, int li, bool need_ctx) {
    const bf16* P = (const bf16*)(F.ws + A_P); bf16* MIX = (bf16*)(F.ws + A_MIX);
    const int nlat = NB * 12 * (S / 256), nctx = need_ctx ? NB * 12 : 0;
    const bool fast = swa_fast(F, li);
    asm volatile("s_waitcnt vmcnt(0)" ::: "memory");
    for (int u = F.vcu; u < nlat + nctx; u += F.G) {
        att::Unit U; U.ldq = EV_N; U.ldk = EV_N; U.ldo = D; U.has_sink = 1; U.qprep = fast ? 1 : 0; U.qgain = inp(F, I_SWAQG) + li * 64; U.ropet = (const f32x2*)(F.ws + WS_ROPE); U.qc2 = SWA_C2;
        if (u < nlat) { const int qb = u % (S / 256), qh = (u / (S / 256)) % 12, b = u / (12 * (S / 256)), kvh = qh / 3, row0 = b * S + qb * 256;
            U.Q = P + (size_t)row0 * EV_N + 256 + 64 * qh; U.K = P + 1024 + 64 * kvh; U.V = P + 1280 + 64 * kvh;
            U.nA = 4; U.rowA = TL + b * CL; U.nB = 8; U.rowB = row0 - 128; U.rlo = b * S; U.rhi = b * S + S - 64; U.mask = 1; U.kb0 = -128; U.q0 = qb * 256; U.qrope = 1; U.qpos0 = qb * 256;
            U.sink = inp(F, I_SINK)[li * 12 + qh]; U.O = MIX + (size_t)row0 * D + 256 + 64 * qh; }
        else { const int uu = u - nlat, qh = uu % 12, b = uu / 12, kvh = qh / 3, row0 = TL + b * CL;
            U.Q = P + (size_t)row0 * EV_N + 256 + 64 * qh; U.K = P + 1024 + 64 * kvh; U.V = P + 1280 + 64 * kvh;
            U.nA = 4; U.rowA = row0; U.nB = 0; U.rowB = 0; U.rlo = 0; U.rhi = 0; U.mask = 0; U.kb0 = 0; U.q0 = 0; U.qrope = 0; U.qpos0 = 0;
            U.sink = inp(F, I_SINK)[li * 12 + qh]; U.O = MIX + (size_t)row0 * D + 256 + 64 * qh; }
        if (fast) att::ATTN_FAST<64>(U, (LAS char*)F.lds, F.tid); else att::attn_unit<64>(U, (LAS char*)F.lds, F.tid);
    }
    __syncthreads();
    if (need_ctx && F.G >= 64 && F.vcu >= 24 && F.vcu < 40) phase_even_pool(F, li, TL / 32, T / 32, F.vcu - 24);
}

namespace fft {
constexpr int N = 16384, IMG_BYTES = 17408 * 8;
__device__ __forceinline__ int phys(int i) { return i + 4 * (i >> 6); }
__device__ __forceinline__ f32x2 cmul(f32x2 a, f32x2 b) { return (f32x2){a.x * b.x - a.y * b.y, a.x * b.y + a.y * b.x}; }
__device__ __forceinline__ f32x2 cconj(f32x2 a) { return (f32x2){a.x, -a.y}; }
__device__ __forceinline__ void init_tables(LAS f32x2* tw, int tid) {
    if (tid < 384) { const int m = tid < 256 ? 128 * tid : tid - 256; float s, c; sincospif(-(float)m * (1.f / 16384.f), &s, &c); tw[tid] = (f32x2){c, s}; }
}
__device__ __forceinline__ f32x2 tw32k(const LAS f32x2* tw, int m) { return cmul(tw[(m >> 7) & 255], tw[256 + (m & 127)]); }
__device__ __forceinline__ void dft4(f32x2& x0, f32x2& x1, f32x2& x2, f32x2& x3) {
    const f32x2 a = x0 + x2, b = x0 - x2, c = x1 + x3, d = x1 - x3;
    x0 = a + c; x2 = a - c; x1 = (f32x2){b.x + d.y, b.y - d.x}; x3 = (f32x2){b.x - d.y, b.y + d.x};
}
__device__ __forceinline__ void dft16(f32x2 (&v)[16]) {
#pragma unroll
    for (int b = 0; b < 4; ++b) dft4(v[b], v[4 + b], v[8 + b], v[12 + b]);
    const float C1 = 0.92387953251128674f, S1 = 0.38268343236508977f, R2 = 0.70710678118654752f;
    const f32x2 W1 = {C1, -S1}, W2 = {R2, -R2}, W3 = {S1, -C1}, W4 = {0.f, -1.f}, W6 = {-R2, -R2}, W9 = {-C1, S1};
    v[4 * 1 + 1] = cmul(v[4 * 1 + 1], W1); v[4 * 1 + 2] = cmul(v[4 * 1 + 2], W2); v[4 * 1 + 3] = cmul(v[4 * 1 + 3], W3);
    v[4 * 2 + 1] = cmul(v[4 * 2 + 1], W2); v[4 * 2 + 2] = cmul(v[4 * 2 + 2], W4); v[4 * 2 + 3] = cmul(v[4 * 2 + 3], W6);
    v[4 * 3 + 1] = cmul(v[4 * 3 + 1], W3); v[4 * 3 + 2] = cmul(v[4 * 3 + 2], W6); v[4 * 3 + 3] = cmul(v[4 * 3 + 3], W9);
    f32x2 o[16];
#pragma unroll
    for (int c = 0; c < 4; ++c) { f32x2 y0 = v[4 * c], y1 = v[4 * c + 1], y2 = v[4 * c + 2], y3 = v[4 * c + 3]; dft4(y0, y1, y2, y3); o[c] = y0; o[c + 4] = y1; o[c + 8] = y2; o[c + 12] = y3; }
#pragma unroll
    for (int r = 0; r < 16; ++r) v[r] = o[r];
}
template <bool INV> __device__ __forceinline__ void pass16(LAS f32x2* X, const LAS f32x2* tw, int Sd, int tid) {
#pragma unroll 1
    for (int q = 0; q < 2; ++q) {
        const int g = tid + 512 * q, blk = (g / Sd) * (16 * Sd), j = g % Sd; f32x2 v[16];
#pragma unroll
        for (int k = 0; k < 16; ++k) v[k] = X[phys(blk + j + Sd * k)];
        const f32x2 w1 = tw32k(tw, 2 * j * (1024 / Sd));
        const f32x2 w2 = cmul(w1, w1), w3 = cmul(w2, w1), w4 = cmul(w2, w2), w5 = cmul(w4, w1), w6 = cmul(w4, w2), w7 = cmul(w4, w3), w8 = cmul(w4, w4);
        const f32x2 w9 = cmul(w8, w1), w10 = cmul(w8, w2), w11 = cmul(w8, w3), w12 = cmul(w8, w4), w13 = cmul(w8, w5), w14 = cmul(w8, w6), w15 = cmul(w8, w7);
#define TWALL(OP) OP(1, w1) OP(2, w2) OP(3, w3) OP(4, w4) OP(5, w5) OP(6, w6) OP(7, w7) OP(8, w8) OP(9, w9) OP(10, w10) OP(11, w11) OP(12, w12) OP(13, w13) OP(14, w14) OP(15, w15)
#define TWMUL(r, w) v[r] = cmul(v[r], w);
        if (INV) {
#pragma unroll
            for (int k = 0; k < 16; ++k) v[k] = cconj(v[k]);
            TWALL(TWMUL)
            dft16(v);
#pragma unroll
            for (int k = 0; k < 16; ++k) v[k] = cconj(v[k]);
        } else { dft16(v); TWALL(TWMUL) }
#undef TWMUL
#undef TWALL
#pragma unroll
        for (int k = 0; k < 16; ++k) X[phys(blk + j + Sd * k)] = v[k];
    }
}
template <bool INV> __device__ __forceinline__ void pass4(LAS f32x2* X, int tid) {
#pragma unroll 1
    for (int q = 0; q < 8; ++q) {
        const int g = tid + 512 * q; LAS f32x2* p = X + phys(4 * g);
        f32x2 a = p[0], b = p[1], c = p[2], d = p[3];
        if (INV) { a = cconj(a); b = cconj(b); c = cconj(c); d = cconj(d); }
        dft4(a, b, c, d);
        if (INV) { a = cconj(a); b = cconj(b); c = cconj(c); d = cconj(d); }
        p[0] = a; p[1] = b; p[2] = c; p[3] = d;
    }
}
__device__ __forceinline__ void fwd(LAS f32x2* X, const LAS f32x2* tw, int tid) {
    __syncthreads(); pass16<false>(X, tw, 1024, tid); __syncthreads(); pass16<false>(X, tw, 64, tid); __syncthreads(); pass16<false>(X, tw, 4, tid); __syncthreads(); pass4<false>(X, tid); __syncthreads();
}
__device__ __forceinline__ void inv(LAS f32x2* X, const LAS f32x2* tw, int tid) {
    __syncthreads(); pass4<true>(X, tid); __syncthreads(); pass16<true>(X, tw, 4, tid); __syncthreads(); pass16<true>(X, tw, 64, tid); __syncthreads(); pass16<true>(X, tw, 1024, tid); __syncthreads();
}
}

namespace dft {
constexpr int RS = 136, PLANE = 128 * RS * 2;
__device__ __forceinline__ LAS bf16* DRp(LAS unsigned char* l) { return (LAS bf16*)l; }
__device__ __forceinline__ LAS bf16* DIp(LAS unsigned char* l) { return (LAS bf16*)(l + PLANE); }
__device__ __forceinline__ LAS bf16* FRp(LAS unsigned char* l) { return (LAS bf16*)(l + 2 * PLANE); }
__device__ __forceinline__ LAS bf16* FIp(LAS unsigned char* l) { return (LAS bf16*)(l + 3 * PLANE); }
static_assert(4 * PLANE == fft::IMG_BYTES, "planes fill the FFT image region exactly");
__device__ __forceinline__ void load_F(LAS unsigned char* l, const unsigned char* ws, int tid) {
    for (int i = tid; i < 2 * 128 * 16; i += NTHR) { const int pl = i >> 11, r = (i >> 4) & 127, ch = i & 15;
        *(LAS u32x4*)(l + (2 + pl) * PLANE + (r * RS + ch * 8) * 2) = *(const u32x4*)(ws + WS_F128 + ((size_t)pl * 128 * 128 + r * 128 + ch * 8) * 2); }
}
template <bool CA, bool CB> __device__ __forceinline__ void cstage(const LAS bf16* Ar, const LAS bf16* Ai, const LAS bf16* Br, const LAS bf16* Bi, f32x16 (&cr)[2], f32x16 (&ci)[2], int wave, int lane) {
    const int r32 = lane & 31, hi = lane >> 5, rb = wave >> 1, cb0 = 2 * (wave & 1);
    const int ao = (32 * rb + r32) * RS + 8 * hi, bo = (32 * cb0 + r32) * RS + 8 * hi;
    const u32x4 M = {0x80008000u, 0x80008000u, 0x80008000u, 0x80008000u};
    cr[0] = f32x16{}; cr[1] = f32x16{}; ci[0] = f32x16{}; ci[1] = f32x16{};
#pragma unroll 2
    for (int ks = 0; ks < 8; ++ks) {
        const u32x4 ar = *(const LAS u32x4*)(Ar + ao + 16 * ks); u32x4 ai = *(const LAS u32x4*)(Ai + ao + 16 * ks); if (CA) ai ^= M; const u32x4 nai = ai ^ M;
#pragma unroll
        for (int t = 0; t < 2; ++t) { const u32x4 br = *(const LAS u32x4*)(Br + bo + t * 32 * RS + 16 * ks); u32x4 bi = *(const LAS u32x4*)(Bi + bo + t * 32 * RS + 16 * ks); if (CB) bi ^= M;
#define BF8(x) __builtin_bit_cast(bf16x8, x)
            cr[t] = __builtin_amdgcn_mfma_f32_32x32x16_bf16(BF8(ar), BF8(br), cr[t], 0, 0, 0); cr[t] = __builtin_amdgcn_mfma_f32_32x32x16_bf16(BF8(nai), BF8(bi), cr[t], 0, 0, 0);
            ci[t] = __builtin_amdgcn_mfma_f32_32x32x16_bf16(BF8(ar), BF8(bi), ci[t], 0, 0, 0); ci[t] = __builtin_amdgcn_mfma_f32_32x32x16_bf16(BF8(ai), BF8(br), ci[t], 0, 0, 0);
#undef BF8
        } }
}
__device__ __forceinline__ int erow(int wave, int lane, int r) { return 32 * (wave >> 1) + (r & 3) + 8 * (r >> 2) + 4 * (lane >> 5); }
__device__ __forceinline__ int ecol(int wave, int lane, int t) { return 32 * (2 * (wave & 1) + t) + (lane & 31); }
__device__ __forceinline__ void put_rowmajor(LAS unsigned char* l, const f32x16 (&cr)[2], const f32x16 (&ci)[2], int wave, int lane) {
#pragma unroll
    for (int t = 0; t < 2; ++t)
#pragma unroll
        for (int r = 0; r < 16; ++r) { const int o = erow(wave, lane, r) * RS + ecol(wave, lane, t); DRp(l)[o] = (bf16)f2bf(cr[t][r]); DIp(l)[o] = (bf16)f2bf(ci[t][r]); }
}
__device__ __forceinline__ void put_transposed(LAS unsigned char* l, const f32x16 (&cr)[2], const f32x16 (&ci)[2], int wave, int lane) {
#pragma unroll
    for (int t = 0; t < 2; ++t)
#pragma unroll
        for (int q = 0; q < 4; ++q) { const int o = ecol(wave, lane, t) * RS + erow(wave, lane, 4 * q);
            *(LAS u32x2*)(DRp(l) + o) = (u32x2){pk2(cr[t][4 * q], cr[t][4 * q + 1]), pk2(cr[t][4 * q + 2], cr[t][4 * q + 3])};
            *(LAS u32x2*)(DIp(l) + o) = (u32x2){pk2(ci[t][4 * q], ci[t][4 * q + 1]), pk2(ci[t][4 * q + 2], ci[t][4 * q + 3])}; }
}
template <bool CONJ> __device__ __forceinline__ void twiddle(f32x16 (&cr)[2], f32x16 (&ci)[2], const LAS f32x2* tw, int wave, int lane) {
#pragma unroll
    for (int t = 0; t < 2; ++t)
#pragma unroll
        for (int r = 0; r < 16; ++r) { f32x2 w = fft::tw32k(tw, 2 * erow(wave, lane, r) * ecol(wave, lane, t)); if (CONJ) w.y = -w.y;
            const float a = cr[t][r], b = ci[t][r]; cr[t][r] = a * w.x - b * w.y; ci[t][r] = a * w.y + b * w.x; }
}
__device__ __forceinline__ void forward_a(LAS unsigned char* l, const LAS f32x2* tw, f32x16 (&cr)[2], f32x16 (&ci)[2], int wave, int lane) {
    __syncthreads();
    cstage<false, false>(DRp(l), DIp(l), FRp(l), FIp(l), cr, ci, wave, lane);
    twiddle<false>(cr, ci, tw, wave, lane);
    __syncthreads(); put_transposed(l, cr, ci, wave, lane); __syncthreads();
}
__device__ __forceinline__ void forward_b(LAS unsigned char* l, f32x16 (&cr)[2], f32x16 (&ci)[2], int wave, int lane) {
    cstage<false, false>(FRp(l), FIp(l), DRp(l), DIp(l), cr, ci, wave, lane);
}
__device__ __forceinline__ void forward(LAS unsigned char* l, const LAS f32x2* tw, f32x16 (&cr)[2], f32x16 (&ci)[2], int wave, int lane) { forward_a(l, tw, cr, ci, wave, lane); forward_b(l, cr, ci, wave, lane); }
__device__ __forceinline__ void inverse_a(LAS unsigned char* l, const LAS f32x2* tw, f32x16 (&cr)[2], f32x16 (&ci)[2], int wave, int lane) {
    __syncthreads(); put_transposed(l, cr, ci, wave, lane); __syncthreads();
    cstage<false, true>(DRp(l), DIp(l), FRp(l), FIp(l), cr, ci, wave, lane);
    twiddle<true>(cr, ci, tw, wave, lane);
    __syncthreads(); put_transposed(l, cr, ci, wave, lane); __syncthreads();
}
__device__ __forceinline__ void inverse_b(LAS unsigned char* l, f32x16 (&cr)[2], f32x16 (&ci)[2], int wave, int lane) {
    cstage<true, false>(FRp(l), FIp(l), DRp(l), DIp(l), cr, ci, wave, lane);
}
}

__device__ __forceinline__ void hyena_filter_task(Frame& F, int i, int L, int n0, float* gh, int npos = 64) {
    LAS float* lz = (LAS float*)F.lds;
    LAS float* l1 = lz + 64 * 33;
    LAS float* l2 = l1 + 64 * 64;
    LAS bf16* l2b = (LAS bf16*)(l2 + 64 * 64);
    const float* w1 = inp(F, I_HYW1) + i * 33 * 64; const float* b1 = inp(F, I_HYB1) + i * 64; const float* w2 = inp(F, I_HYW2) + i * 64 * 64; const float* b2 = inp(F, I_HYB2) + i * 64;
    const float* w3 = inp(F, I_HYW3) + (size_t)i * 64 * 1024; const float* fq = inp(F, I_HYFREQ) + i * 128;
    __syncthreads();
    for (int idx = F.tid; idx < npos * 33; idx += NTHR) { const int p = idx / 33, e = idx % 33; const float pos = (float)(n0 + p);
        float val;
        if (e == 0) val = pos / (float)(L - 1);
        else { const int jj = (e - 1) & 15; const float fr = 1e-4f + (float)jj * ((15.f - 1e-4f) / 15.f); const float ang = (6.283185307179586f / (float)L) * pos * fr; val = e <= 16 ? cosf(ang) : -sinf(ang); }
        lz[idx] = val; }
    __syncthreads();
    { const int k = F.tid & 63, pg = F.tid >> 6;
      float wr[33];
#pragma unroll
      for (int e = 0; e < 33; ++e) wr[e] = w1[e * 64 + k];
      const float bb = b1[k], ff = fq[k];
#pragma unroll 1
      for (int p = pg * (npos >> 3); p < (pg + 1) * (npos >> 3); ++p) { float s = bb;
#pragma unroll
          for (int e = 0; e < 33; ++e) s += lz[p * 33 + e] * wr[e];
          l1[p * 64 + k] = sinf(ff * s); } }
    __syncthreads();
    { const int k = F.tid & 63, pg = F.tid >> 6;
      float wr[64];
#pragma unroll
      for (int e = 0; e < 64; ++e) wr[e] = w2[e * 64 + k];
      const float bb = b2[k], ff = fq[64 + k];
#pragma unroll 1
      for (int p = pg * (npos >> 3); p < (pg + 1) * (npos >> 3); ++p) { float s = bb;
#pragma unroll
          for (int e4 = 0; e4 < 64; e4 += 4) { const f32x4 h = *(const LAS f32x4*)(l1 + p * 64 + e4); s += h.x * wr[e4] + h.y * wr[e4 + 1] + h.z * wr[e4 + 2] + h.w * wr[e4 + 3]; }
          const float hv = sinf(ff * s); l2[p * 64 + k] = hv; l2b[p * 64 + k] = (bf16)f2bf(hv); } }
    __syncthreads();
    if (npos == 64) {
        const bf16* wt3 = (const bf16*)(F.ws + WS_WT3) + (size_t)i * 1024 * 64; const int r32 = F.lane & 31, hi = F.lane >> 5;
        const float d0 = logf(1e-2f) / 0.3f, d1 = logf(1e-2f) / 1.5f;
        bf16x8 bfr[2][4];
#pragma unroll
        for (int pb = 0; pb < 2; ++pb)
#pragma unroll
            for (int ks = 0; ks < 4; ++ks) bfr[pb][ks] = *(const LAS bf16x8*)(l2b + (32 * pb + r32) * 64 + 16 * ks + 8 * hi);
#pragma unroll 1
        for (int cbi = 0; cbi < 4; ++cbi) { const int cb = 4 * F.wave + cbi; bf16x8 af[4];
#pragma unroll
            for (int ks = 0; ks < 4; ++ks) af[ks] = *(const bf16x8*)(wt3 + (size_t)(32 * cb + r32) * 64 + 16 * ks + 8 * hi);
#pragma unroll
            for (int pb = 0; pb < 2; ++pb) { f32x16 acc = {};
#pragma unroll
                for (int ks = 0; ks < 4; ++ks) acc = __builtin_amdgcn_mfma_f32_32x32x16_bf16(af[ks], bfr[pb][ks], acc, 0, 0, 0);
                const int pos = 32 * pb + r32; const float nt = -((float)(n0 + pos) / (float)(L - 1)) * LOG2E;
#pragma unroll
                for (int r = 0; r < 16; ++r) { const int col = 32 * cb + (r & 3) + 8 * (r >> 2) + 4 * hi, c = col & 511, dir = col >> 9;
                    const float delta = fabsf(d0 + (d1 - d0) * ((float)c / 511.f));
                    gh[((size_t)dir * 512 + c) * L + n0 + pos] = acc[r] * __builtin_amdgcn_exp2f(nt * delta); } } }
    } else
    {
      const int c = F.tid;
      const float d0 = logf(1e-2f) / 0.3f, d1 = logf(1e-2f) / 1.5f; const float delta = fabsf(d0 + (d1 - d0) * ((float)c / 511.f));
#pragma unroll 1
      for (int dir = 0; dir < 2; ++dir) { float w[64];
#pragma unroll
          for (int e = 0; e < 64; ++e) w[e] = w3[e * 1024 + dir * 512 + c];
          float* go = gh + ((size_t)dir * 512 + c) * L + n0;
#pragma unroll 1
          for (int p4 = 0; p4 < npos; p4 += 4) { f32x4 o;
#pragma unroll 1
              for (int pp = 0; pp < 4; ++pp) { const int p = p4 + pp; float sa = 0.f, sb = 0.f; asm volatile("" ::: "memory");
#pragma unroll
                  for (int e4 = 0; e4 < 64; e4 += 8) { const f32x4 h = *(const LAS f32x4*)(l2 + p * 64 + e4), g = *(const LAS f32x4*)(l2 + p * 64 + e4 + 4);
                      sa += h.x * w[e4] + h.y * w[e4 + 1] + h.z * w[e4 + 2] + h.w * w[e4 + 3]; sb += g.x * w[e4 + 4] + g.y * w[e4 + 5] + g.z * w[e4 + 6] + g.w * w[e4 + 7]; }
                  const float val = (sa + sb) * expf(-((float)(n0 + p) / (float)(L - 1)) * delta);
                  o.x = pp == 0 ? val : o.x; o.y = pp == 1 ? val : o.y; o.z = pp == 2 ? val : o.z; o.w = pp == 3 ? val : o.w; }
              *(f32x4*)(go + p4) = o; } } }
    __syncthreads();
}

constexpr size_t GHC_OFF = 12 * MiB;
constexpr size_t ZC_OFF = 10 * MiB + 1536 * 1024;
__device__ __forceinline__ float sconv(const bf16* P, int seq0, int L, int t, int col, float w0, float w1, float w2, float bias) {
    const bf16* p = P + (size_t)(seq0 + t) * OD_N + col;
    float s = bias + w1 * bf2f(p[0]);
    if (t > 0) s += w0 * bf2f(p[-OD_N]);
    if (t + 1 < L) s += w2 * bf2f(p[OD_N]);
    return s;
}
__device__ __forceinline__ void hyena_z_tile(Frame& F, int li, int seq0, int L, int t0, int c0, bf16* Zrow0  , int Lz) {
    LAS bf16* l1 = (LAS bf16*)F.lds;
    LAS bf16* l2 = l1 + 130 * 64;
    const bf16* P = (const bf16*)(F.ws + A_P);
    __syncthreads();
    for (int i = F.tid; i < 130 * 8 * 2; i += NTHR) { const int which = i / (130 * 8), r = (i % (130 * 8)) / 8, c8 = (i % 8) * 8, t = t0 - 1 + r;
        u32x4 w = {0u, 0u, 0u, 0u}; if (t >= 0 && t < L) w = *(const u32x4*)(P + (size_t)(seq0 + t) * OD_N + (which ? 1024 : 512) + c0 + c8);
        *(LAS u32x4*)((which ? l2 : l1) + r * 64 + c8) = w; }
    __syncthreads();
    const int c = F.tid & 63, tc = F.tid >> 6;
    const float* cw = inp(F, I_HYCW) + (size_t)li * 3 * 1536; const float* cb = inp(F, I_HYCB) + (size_t)li * 1536;
    const int ca = 512 + c0 + c, cv = 1024 + c0 + c;
    const float a0 = cw[ca], a1 = cw[1536 + ca], a2 = cw[3072 + ca], ab = cb[ca], v0 = cw[cv], v1 = cw[1536 + cv], v2 = cw[3072 + cv], vb = cb[cv];
    float xr[18], vr[18];
#pragma unroll
    for (int i = 0; i < 18; ++i) { xr[i] = bf2f(l1[(tc * 16 + i) * 64 + c]); vr[i] = bf2f(l2[(tc * 16 + i) * 64 + c]); }
    unsigned o[8];
#pragma unroll
    for (int i = 0; i < 16; i += 2) { float z[2];
#pragma unroll
        for (int k = 0; k < 2; ++k) { const int r = i + k + 1;
            const float x1 = ab + a0 * xr[r - 1] + a1 * xr[r] + a2 * xr[r + 1];
            const float vv = vb + v0 * vr[r - 1] + v1 * vr[r] + v2 * vr[r + 1];
            z[k] = x1 * vv; }
        o[i / 2] = pk2(z[0], z[1]); }
    bf16* dst = Zrow0 + (size_t)(c0 + c) * Lz + t0 + tc * 16;
    *(u32x4*)dst = (u32x4){o[0], o[1], o[2], o[3]}; *(u32x4*)(dst + 8) = (u32x4){o[4], o[5], o[6], o[7]};
}
__device__ __forceinline__ void hyena_z_compute(Frame& F, int li, int t0, int c0, bf16* Zrow0, int Lz) {
    LAS bf16* l1 = (LAS bf16*)F.lds; LAS bf16* l2 = l1 + 130 * 64;
    const int c = F.tid & 63, tc = F.tid >> 6;
    const float* cw = inp(F, I_HYCW) + (size_t)li * 3 * 1536; const float* cb = inp(F, I_HYCB) + (size_t)li * 1536;
    const int ca = 512 + c0 + c, cv = 1024 + c0 + c;
    const float a0 = cw[ca], a1 = cw[1536 + ca], a2 = cw[3072 + ca], ab = cb[ca], v0 = cw[cv], v1 = cw[1536 + cv], v2 = cw[3072 + cv], vb = cb[cv];
    float xr[18], vr[18];
#pragma unroll
    for (int i = 0; i < 18; ++i) { xr[i] = bf2f(l1[(tc * 16 + i) * 64 + c]); vr[i] = bf2f(l2[(tc * 16 + i) * 64 + c]); }
    unsigned o[8];
#pragma unroll
    for (int i = 0; i < 16; i += 2) { float z[2];
#pragma unroll
        for (int k = 0; k < 2; ++k) { const int r = i + k + 1;
            const float x1 = ab + a0 * xr[r - 1] + a1 * xr[r] + a2 * xr[r + 1];
            const float vv = vb + v0 * vr[r - 1] + v1 * vr[r] + v2 * vr[r + 1];
            z[k] = x1 * vv; }
        o[i / 2] = pk2(z[0], z[1]); }
    bf16* dst = Zrow0 + (size_t)(c0 + c) * Lz + t0 + tc * 16;
    *(u32x4*)dst = (u32x4){o[0], o[1], o[2], o[3]}; *(u32x4*)(dst + 8) = (u32x4){o[4], o[5], o[6], o[7]};
}
__device__ __forceinline__ void hyena_filter_fft_unit(Frame& F, int c, int par) {
    LAS unsigned char* l = F.lds; LAS f32x2* tw = (LAS f32x2*)(F.lds + fft::IMG_BYTES); LAS float* red = (LAS float*)(F.lds + fft::IMG_BYTES + 3072);
    const float* hf = (const float*)(F.ws + A_KVU) + (size_t)c * S; const float* hb = hf + (size_t)512 * S;
    __syncthreads();
    float an = 0.f;
    { const int n2 = F.tid & 127, g = F.tid >> 7;
#pragma unroll 1
      for (int it = 0; it < 4; ++it) { const int n1b = 32 * it + 8 * g; float fv[8], gv[8];
#pragma unroll
          for (int i = 0; i < 8; ++i) { const int n = 128 * (n1b + i) + n2; fv[i] = hf[n]; gv[i] = hb[n ? S - n : 0]; }
          float vr[8], vi[8];
#pragma unroll
          for (int i = 0; i < 8; ++i) { const int n = 128 * (n1b + i) + n2; const float f = fv[i], gg = n ? gv[i] : 0.f; an += fabsf(f) + fabsf(gg);
              if (par == 0) { vr[i] = f + gg; vi[i] = 0.f; } else { const f32x2 tt = fft::tw32k(tw, n); vr[i] = (f - gg) * tt.x; vi[i] = (f - gg) * tt.y; } }
          const int o = n2 * dft::RS + n1b;
          *(LAS u32x4*)(dft::DRp(l) + o) = (u32x4){pk2(vr[0], vr[1]), pk2(vr[2], vr[3]), pk2(vr[4], vr[5]), pk2(vr[6], vr[7])};
          *(LAS u32x4*)(dft::DIp(l) + o) = (u32x4){pk2(vi[0], vi[1]), pk2(vi[2], vi[3]), pk2(vi[4], vi[5]), pk2(vi[6], vi[7])}; } }
    an = wave_sum(an); if (F.lane == 0) red[F.wave] = an;
    f32x16 cr[2], ci[2];
    int ln = F.lane; asm volatile("" : "+v"(ln));
    dft::forward(l, tw, cr, ci, F.wave, ln);
    float nrm = 0.f;
#pragma unroll
    for (int w = 0; w < 8; ++w) nrm += red[w];
    const float sc = 1.f / (nrm * 2.f * (float)S);
    unsigned* G = (unsigned*)(F.ws + A_G) + ((size_t)c * 2 + par) * S;
#pragma unroll
    for (int t = 0; t < 2; ++t)
#pragma unroll
        for (int r = 0; r < 16; ++r) G[dft::erow(F.wave, ln, r) * 128 + dft::ecol(F.wave, ln, t)] = pk2(cr[t][r] * sc, ci[t][r] * sc);
}
__device__ __forceinline__ void hyena_conv_unit(Frame& F, int c, bool dry) {
    LAS unsigned char* l = F.lds; LAS f32x2* tw = (LAS f32x2*)(F.lds + fft::IMG_BYTES);
    bf16* z0 = (bf16*)(F.ws + A_ZY) + (size_t)c * S; bf16* z1 = z0 + (size_t)512 * S;
    const unsigned* G = (const unsigned*)(F.ws + A_G) + (size_t)c * 2 * S;
    unsigned* yeg = (unsigned*)(F.ws + WS_H) + (size_t)F.bx * S;
    f32x16 cr[2], ci[2];
#define EOFF(t, r) (32 * (t) + 128 * (((r) & 3) + 8 * ((r) >> 2)))
#pragma unroll 1
    for (int par = 0; par < 2; ++par) {
        int nb = 128 * (32 * (F.wave >> 1) + 4 * (F.lane >> 5)) + 64 * (F.wave & 1) + (F.lane & 31); asm volatile("" : "+v"(nb));
        int ln = F.lane; asm volatile("" : "+v"(ln));
        __syncthreads();
        { const int nb2 = F.tid & 15, g1 = F.tid >> 4; u32x4 a[4], b[4];
#pragma unroll
          for (int j = 0; j < 4; ++j) { const int n0 = 128 * (4 * g1 + j) + 8 * nb2; a[j] = *(const u32x4*)(z0 + n0); b[j] = *(const u32x4*)(z1 + n0); }
#pragma unroll
          for (int i = 0; i < 8; ++i) { float vr[4], vi[4];
#pragma unroll
              for (int j = 0; j < 4; ++j) { const unsigned wa = a[j][i >> 1], wb = b[j][i >> 1]; f32x2 v = {(i & 1) ? bfhi(wa) : bflo(wa), (i & 1) ? bfhi(wb) : bflo(wb)};
                  if (par) v = fft::cmul(v, fft::tw32k(tw, 128 * (4 * g1 + j) + 8 * nb2 + i)); vr[j] = v.x; vi[j] = v.y; }
              const int o = (8 * nb2 + i) * dft::RS + 4 * g1;
              *(LAS u32x2*)(dft::DRp(l) + o) = (u32x2){pk2(vr[0], vr[1]), pk2(vr[2], vr[3])}; *(LAS u32x2*)(dft::DIp(l) + o) = (u32x2){pk2(vi[0], vi[1]), pk2(vi[2], vi[3])}; } }
        dft::forward_a(l, tw, cr, ci, F.wave, ln);
        unsigned gq[2][16];
        { const unsigned* Gp = G + (size_t)par * S + nb;
#pragma unroll
          for (int t = 0; t < 2; ++t)
#pragma unroll
            for (int r = 0; r < 16; ++r) gq[t][r] = Gp[EOFF(t, r)]; }
        dft::forward_b(l, cr, ci, F.wave, ln);
#pragma unroll
        for (int t = 0; t < 2; ++t)
#pragma unroll
            for (int r = 0; r < 16; ++r) { const float gx = bflo(gq[t][r]), gy = bfhi(gq[t][r]); const float x = cr[t][r], y = ci[t][r]; cr[t][r] = x * gx - y * gy; ci[t][r] = x * gy + y * gx; }
        asm volatile("" : "+v"(ln));
        dft::inverse_a(l, tw, cr, ci, F.wave, ln);
        asm volatile("" : "+v"(nb));
        if (par == 0) { dft::inverse_b(l, cr, ci, F.wave, ln); unsigned* yp = yeg + nb;
#pragma unroll
            for (int t = 0; t < 2; ++t)
#pragma unroll
                for (int r = 0; r < 16; ++r) yp[EOFF(t, r)] = pk2(cr[t][r], ci[t][r]);
        } else { const unsigned* yp = yeg + nb; bf16* zp0 = z0 + nb; bf16* zp1 = z1 + nb;
#pragma unroll
            for (int t = 0; t < 2; ++t)
#pragma unroll
                for (int r = 0; r < 16; ++r) gq[t][r] = yp[EOFF(t, r)];
            dft::inverse_b(l, cr, ci, F.wave, ln);
#pragma unroll
            for (int t = 0; t < 2; ++t)
#pragma unroll
                for (int r = 0; r < 16; ++r) { const f32x2 v = fft::cmul((f32x2){cr[t][r], ci[t][r]}, fft::cconj(fft::tw32k(tw, nb + EOFF(t, r)))); const float ex = bflo(gq[t][r]), ey = bfhi(gq[t][r]);
                    if (!dry) { zp0[EOFF(t, r)] = (bf16)f2bf(ex + v.x); zp1[EOFF(t, r)] = (bf16)f2bf(ey + v.y); } }
        }
    }
#undef EOFF
}
__device__ __forceinline__ void hyena_ctx_conv_unit(Frame& F, int c_lo, int c_hi) {
    LAS float* lf = (LAS float*)F.lds; LAS float* lb = lf + 256; LAS float* lz = lb + 256; LAS float* red = lz + 512;
    const float* ghc = (const float*)(F.ws + GHC_OFF); bf16* zc = (bf16*)(F.ws + ZC_OFF);
    const int t = F.tid & 255, b = F.tid >> 8;
    for (int c = c_lo; c < c_hi; ++c) {
        __syncthreads();
        float an = 0.f;
        if (F.tid < 256) { const float f = ghc[(size_t)c * CL + t], g = ghc[((size_t)512 + c) * CL + t]; lf[t] = f; lb[t] = g; an = fabsf(f) + (t ? fabsf(g) : 0.f); }
        lz[b * 256 + t] = bf2f(zc[((size_t)b * 512 + c) * CL + t]);
        an = wave_sum(an); if (F.lane == 0) red[F.wave] = an;
        __syncthreads();
        float nrm = 0.f;
#pragma unroll
        for (int w = 0; w < 8; ++w) nrm += red[w];
        float y = 0.f;
        for (int s = 0; s <= t; ++s) y += lf[t - s] * lz[b * 256 + s];
        for (int s = t + 1; s < CL; ++s) y += lb[s - t] * lz[b * 256 + s];
        __syncthreads();
        zc[((size_t)b * 512 + c) * CL + t] = (bf16)f2bf(y / nrm);
    }
}
__device__ __forceinline__ void hyena_gate_tile(Frame& F, int li, int seq0, int L, int t0, int c0, const bf16* Yrow0, int Lz) {
    LAS bf16* l0 = (LAS bf16*)F.lds; LAS bf16* l1 = l0 + 130 * 64; LAS bf16* l2 = l1 + 130 * 64;
    const bf16* P = (const bf16*)(F.ws + A_P); bf16* MIX = (bf16*)(F.ws + A_MIX);
    __syncthreads();
    for (int i = F.tid; i < 130 * 8 * 3; i += NTHR) { const int which = i / (130 * 8), r = (i % (130 * 8)) / 8, c8 = (i % 8) * 8, t = t0 - 1 + r;
        u32x4 w = {0u, 0u, 0u, 0u}; if (t >= 0 && t < L) w = *(const u32x4*)(P + (size_t)(seq0 + t) * OD_N + which * 512 + c0 + c8);
        *(LAS u32x4*)((which == 0 ? l0 : which == 1 ? l1 : l2) + r * 64 + c8) = w; }
    __syncthreads();
    const int c = F.tid & 63, tc = F.tid >> 6;
    const float* cw = inp(F, I_HYCW) + (size_t)li * 3 * 1536; const float* cb = inp(F, I_HYCB) + (size_t)li * 1536;
    const int c0_ = c0 + c, ca = 512 + c0 + c, cv = 1024 + c0 + c;
    const float x0w0 = cw[c0_], x0w1 = cw[1536 + c0_], x0w2 = cw[3072 + c0_], x0b = cb[c0_];
    const float a0 = cw[ca], a1 = cw[1536 + ca], a2 = cw[3072 + ca], ab = cb[ca], v0 = cw[cv], v1 = cw[1536 + cv], v2 = cw[3072 + cv], vb = cb[cv];
    const float skip = inp(F, I_HYSKIP)[li * 512 + c0_];
    const bf16* ysrc = Yrow0 + (size_t)c0_ * Lz + t0 + tc * 16;
    const u32x4 ya = *(const u32x4*)ysrc, yb = *(const u32x4*)(ysrc + 8);
    const float yv[16] = {bflo(ya.x), bfhi(ya.x), bflo(ya.y), bfhi(ya.y), bflo(ya.z), bfhi(ya.z), bflo(ya.w), bfhi(ya.w), bflo(yb.x), bfhi(yb.x), bflo(yb.y), bfhi(yb.y), bflo(yb.z), bfhi(yb.z), bflo(yb.w), bfhi(yb.w)};
    float xr0[18], xr[18], vr[18];
#pragma unroll
    for (int i = 0; i < 18; ++i) { xr0[i] = bf2f(l0[(tc * 16 + i) * 64 + c]); xr[i] = bf2f(l1[(tc * 16 + i) * 64 + c]); vr[i] = bf2f(l2[(tc * 16 + i) * 64 + c]); }
#pragma unroll
    for (int i = 0; i < 16; ++i) { const int r = i + 1;
        const float x0 = x0b + x0w0 * xr0[r - 1] + x0w1 * xr0[r] + x0w2 * xr0[r + 1];
        const float x1 = ab + a0 * xr[r - 1] + a1 * xr[r] + a2 * xr[r + 1];
        const float vv = vb + v0 * vr[r - 1] + v1 * vr[r] + v2 * vr[r + 1];
        const float z = x1 * vv;
        MIX[(size_t)(seq0 + t0 + tc * 16 + i) * D + c0_] = (bf16)f2bf(x0 * (yv[i] + skip * z)); }
}

__device__ __forceinline__ void phase_odd_prep(Frame& F, int li, bool need_ctx) {
    const bf16* P = (const bf16*)(F.ws + A_P); float* rs = (float*)(F.ws + WS_MISC + MISC_RSTD);
    for (int r = F.gw; r < T; r += 8 * F.NGW) {
        u32x2 a[8]; unsigned b[8];
#pragma unroll
        for (int q = 0; q < 8; ++q) { const int rq = r + q * F.NGW; a[q] = (u32x2){0u, 0u}; b[q] = 0u;
            if (rq < T) { const bf16* p = P + (size_t)rq * OD_N + 1536; a[q] = *(const u32x2*)(p + 4 * F.lane); b[q] = *(const unsigned*)(p + 256 + 2 * F.lane); } }
#pragma unroll
        for (int q = 0; q < 8; ++q) { const int rq = r + q * F.NGW;
            if (rq < T) {
                float s1 = bflo(a[q].x) * bflo(a[q].x) + bfhi(a[q].x) * bfhi(a[q].x) + bflo(a[q].y) * bflo(a[q].y) + bfhi(a[q].y) * bfhi(a[q].y), s2 = bflo(b[q]) * bflo(b[q]) + bfhi(b[q]) * bfhi(b[q]);
                s1 = wave_sum(s1); s2 = wave_sum(s2);
                if (F.lane == 0) { rs[rq] = 1.f / sqrtf(s1 * (1.f / 256.f) + EPS); rs[T + rq] = 1.f / sqrtf(s2 * (1.f / 128.f) + EPS); } } }
    }
    const int nz = 2048 + (need_ctx ? 32 : 0);
    {
        const bf16* Pz = (const bf16*)(F.ws + A_P);
        LAS bf16* l1 = (LAS bf16*)F.lds; LAS bf16* l2 = l1 + 130 * 64;
        auto zgeo = [&](int u, int& seq0, int& L, int& t0, int& c0, bf16*& Zr, int& Lz) {
            if (u < 2048) { const int cc = u & 7, tt = (u >> 3) & 127, b = u >> 10; seq0 = b * S; L = S; t0 = tt * 128; c0 = cc * 64; Zr = (bf16*)(F.ws + A_ZY) + (size_t)b * 512 * S; Lz = S; }
            else { const int uu = u - 2048, cc = uu & 7, tt = (uu >> 3) & 1, b = uu >> 4; seq0 = TL + b * CL; L = CL; t0 = tt * 128; c0 = cc * 64; Zr = (bf16*)(F.ws + ZC_OFF) + (size_t)b * 512 * CL; Lz = CL; } };
        u32x4 nw[5];
        auto zfetch = [&](int u) { int seq0, L, t0, c0, Lz; bf16* Zr; zgeo(u, seq0, L, t0, c0, Zr, Lz);
#pragma unroll
            for (int k = 0; k < 5; ++k) { const int i = F.tid + NTHR * k; nw[k] = (u32x4){0u, 0u, 0u, 0u};
                if (i < 130 * 8 * 2) { const int which = i / (130 * 8), r = (i % (130 * 8)) / 8, c8 = (i % 8) * 8, t = t0 - 1 + r;
                    if (t >= 0 && t < L) nw[k] = *(const u32x4*)(Pz + (size_t)(seq0 + t) * OD_N + (which ? 1024 : 512) + c0 + c8); } } };
        if (F.vcu < nz) zfetch(F.vcu);
        for (int u = F.vcu; u < nz; u += F.G) {
            int seq0, L, t0, c0, Lz; bf16* Zr; zgeo(u, seq0, L, t0, c0, Zr, Lz);
            __syncthreads();
#pragma unroll
            for (int k = 0; k < 5; ++k) { const int i = F.tid + NTHR * k;
                if (i < 130 * 8 * 2) { const int which = i / (130 * 8), r = (i % (130 * 8)) / 8, c8 = (i % 8) * 8; *(LAS u32x4*)((which ? l2 : l1) + r * 64 + c8) = nw[k]; } }
            if (u + F.G < nz) zfetch(u + F.G);
            __syncthreads();
            hyena_z_compute(F, li, t0, c0, Zr, Lz);
        }
    }
    __syncthreads(); dft::load_F(F.lds, F.ws, F.tid); fft::init_tables((LAS f32x2*)(F.lds + fft::IMG_BYTES), F.tid); __syncthreads();
    for (int u = F.vcu; u < 1024; u += F.G) hyena_filter_fft_unit(F, u >> 1, u & 1);
    __syncthreads();
}
constexpr float MLA_C2 = 0.10206207261596577f * LOG2E;
__device__ __forceinline__ bool mla_fast(const Frame& F, int li) {
    float mq = 0.f, mk = 0.f;
    for (int j = 0; j < 96; ++j) { mq = fmaxf(mq, fabsf(inp(F, I_MQG)[li * 96 + j])); mk = fmaxf(mk, fabsf(inp(F, I_MKG)[li * 96 + j])); }
    return 9.797958971f * LOG2E * mq * mk * 1.01f < 40.f;
}
__device__ __forceinline__ void phase_mla_prep(Frame& F, int li, bool dry = false) {
    const bf16* P = (const bf16*)(F.ws + A_P); bf16* QU = (bf16*)(F.ws + A_QU); bf16* KVU = (bf16*)(F.ws + A_KVU);
    const f32x2* r32t = (const f32x2*)(F.ws + WS_ROPE) + (size_t)S * 32;
    const bool fast = mla_fast(F, li);
    const int hd = fast ? 8 + ((F.lane >> 2) & 7) : F.lane >> 2, qt = F.lane & 3, isk = hd >= 8, h = hd & 7, RP = fast ? 2 : 1, sub = fast ? F.lane >> 5 : 0, NR = T / RP;
    const float* gain = (isk ? inp(F, I_MKG) : inp(F, I_MQG)) + li * 96 + 24 * qt;
    float gn[24];
#pragma unroll
    for (int j = 0; j < 24; ++j) gn[j] = gain[j] * (isk ? 1.f : MLA_C2);
    u32x4 nw[3];
    auto ld3 = [&](int rr, u32x4 (&w3)[3]) { const bf16* bs = isk ? KVU + (size_t)rr * KVU_N + 160 * h : QU + (size_t)rr * QU_N + 96 * h;
#pragma unroll
        for (int j8 = 0; j8 < 3; ++j8) { const int e0 = 24 * qt + 8 * j8;
            if (isk && e0 >= 64) w3[j8] = *(const u32x4*)(P + (size_t)rr * OD_N + 1920 + (e0 - 64)); else w3[j8] = *(const u32x4*)(bs + e0); } };
    if (F.gw < NR) ld3(F.gw * RP + sub, nw);
    for (int rq = F.gw; rq < NR; rq += F.NGW) {
        const int r = rq * RP + sub;
        bf16* base = isk ? KVU + (size_t)r * KVU_N + 160 * h : QU + (size_t)r * QU_N + 96 * h;
        float v[24]; u32x4 cw[3];
#pragma unroll
        for (int j8 = 0; j8 < 3; ++j8) cw[j8] = nw[j8];
        if (rq + F.NGW < NR) ld3((rq + F.NGW) * RP + sub, nw);
#pragma unroll
        for (int j8 = 0; j8 < 3; ++j8) { const u32x4 w = cw[j8];
            v[8 * j8 + 0] = bflo(w.x); v[8 * j8 + 1] = bfhi(w.x); v[8 * j8 + 2] = bflo(w.y); v[8 * j8 + 3] = bfhi(w.y); v[8 * j8 + 4] = bflo(w.z); v[8 * j8 + 5] = bfhi(w.z); v[8 * j8 + 6] = bflo(w.w); v[8 * j8 + 7] = bfhi(w.w); }
        float ss = 0.f;
#pragma unroll
        for (int j = 0; j < 24; ++j) ss += v[j] * v[j];
        ss += dpp_f<0xB1>(ss); ss += dpp_f<0x4E>(ss);
        const float rstd = 1.f / sqrtf(ss * (1.f / 96.f) + EPS);
#pragma unroll
        for (int j = 0; j < 24; ++j) v[j] *= rstd * gn[j];
        if (r < TL) {
            const int s = r % S; const f32x2* cs = r32t + (size_t)s * 16;
            float x2lo[8], x1lo[8];
#pragma unroll
            for (int i = 0; i < 8; ++i) { x2lo[i] = dpp_f<0xB1>(v[8 + i]); x1lo[i] = dpp_f<0xB1>(v[16 + i]); }
            if (qt == 2) {
#pragma unroll
                for (int i = 0; i < 8; ++i) { const f32x2 c = cs[i]; v[16 + i] = v[16 + i] * c.x - x2lo[i] * c.y; }
            } else if (qt == 3) {
#pragma unroll
                for (int i = 0; i < 8; ++i) { const f32x2 c = cs[i]; const float x2 = v[8 + i]; v[8 + i] = x2 * c.x + x1lo[i] * c.y; }
#pragma unroll
                for (int i = 0; i < 8; ++i) { const f32x2 c = cs[8 + i]; const float x1 = v[i], x2 = v[16 + i]; v[i] = x1 * c.x - x2 * c.y; v[16 + i] = x2 * c.x + x1 * c.y; }
            }
        }
#pragma unroll
        for (int j8 = 0; j8 < 3; ++j8) if (!dry) *(u32x4*)(base + 24 * qt + 8 * j8) = (u32x4){pk2(v[8 * j8], v[8 * j8 + 1]), pk2(v[8 * j8 + 2], v[8 * j8 + 3]), pk2(v[8 * j8 + 4], v[8 * j8 + 5]), pk2(v[8 * j8 + 6], v[8 * j8 + 7])};
    }
}
template <int EX = 0> __device__ __forceinline__ void phase_mla(Frame& F, int li, bool need_ctx) {
    const bf16* QU = (const bf16*)(F.ws + A_QU); const bf16* KVU = (const bf16*)(F.ws + A_KVU); bf16* MIX = (bf16*)(F.ws + A_MIX);
    const int nlat = NB * MLA_H * (S / 256), nctx = need_ctx ? NB * MLA_H : 0;
    const bool fast = mla_fast(F, li);
    asm volatile("s_waitcnt vmcnt(0)" ::: "memory");
    for (int u = F.vcu; u < nlat + nctx; u += F.G) {
        att::Unit U; U.ldq = QU_N; U.ldk = KVU_N; U.ldo = D; U.has_sink = 0; U.sink = 0.f; U.mask = 0; U.kb0 = 0; U.q0 = 0; U.rlo = 0; U.rhi = T;
        U.qprep = fast ? 1 : 0; U.qgain = inp(F, I_MQG) + li * 96; U.ropet = (const f32x2*)(F.ws + WS_ROPE) + (size_t)S * 32; U.qc2 = MLA_C2;
        if (u < nlat) { const int qb = u % (S / 256), h = (u / (S / 256)) % MLA_H, b = u / (MLA_H * (S / 256)), row0 = b * S + qb * 256;
            U.Q = QU + (size_t)row0 * QU_N + 96 * h; U.K = KVU + 160 * h; U.V = KVU + 160 * h + 96;
            U.nA = S / 64; U.rowA = b * S; U.nB = CL / 64; U.rowB = TL + b * CL; U.O = MIX + (size_t)row0 * D + 512 + 64 * h; U.qrope = 1; U.qpos0 = qb * 256; }
        else { const int uu = u - nlat, h = uu % MLA_H, b = uu / MLA_H, row0 = TL + b * CL;
            U.Q = QU + (size_t)row0 * QU_N + 96 * h; U.K = KVU + 160 * h; U.V = KVU + 160 * h + 96;
            U.nA = CL / 64; U.rowA = row0; U.nB = 0; U.rowB = 0; U.O = MIX + (size_t)row0 * D + 512 + 64 * h; U.qrope = 0; U.qpos0 = 0; }
        if constexpr (EX > 0) att::attn_unit_dma_x<96, EX>(U, (LAS char*)F.lds, F.tid);
        else { if (fast) att::ATTN_FAST<96>(U, (LAS char*)F.lds, F.tid); else att::attn_unit<96>(U, (LAS char*)F.lds, F.tid); }
    }
    __syncthreads();
}
__device__ __forceinline__ void phase_hyena_conv(Frame& F, int li, bool need_ctx, bool dry = false) {
    __syncthreads(); dft::load_F(F.lds, F.ws, F.tid); fft::init_tables((LAS f32x2*)(F.lds + fft::IMG_BYTES), F.tid); __syncthreads();
    unsigned* ctr = (unsigned*)(F.ws + WS_CTL) + CW_WQ + 64 * (li * 2 + (dry ? 1 : 0)); LAS int* sh = (LAS int*)(F.lds + fft::IMG_BYTES + 3584);
    for (;;) {
        __syncthreads();
        if (F.tid == 0) *sh = (int)atomicAdd(ctr, 1u);
        __syncthreads();
        const int c = *sh;
        if (c >= 512) break;
        hyena_conv_unit(F, c, dry);
    }
    __syncthreads();
}
__device__ __forceinline__ void phase_hyena_ctx_conv(Frame& F, int li, bool need_ctx) {
    if (need_ctx) for (int c = F.vcu; c < 512; c += F.G) hyena_ctx_conv_unit(F, c, c + 1);
    __syncthreads();
}
__device__ __forceinline__ void phase_hyena_gate(Frame& F, int li, bool need_ctx) {
    const int nz = 2048 + (need_ctx ? 32 : 0);
    for (int u = F.vcu; u < nz; u += F.G) {
        if (u < 2048) { const int cc = u & 7, tt = (u >> 3) & 127, b = u >> 10; hyena_gate_tile(F, li, b * S, S, tt * 128, cc * 64, (const bf16*)(F.ws + A_ZY) + (size_t)b * 512 * S, S); }
        else { const int uu = u - 2048, cc = uu & 7, tt = (uu >> 3) & 1, b = uu >> 4; hyena_gate_tile(F, li, TL + b * CL, CL, tt * 128, cc * 64, (const bf16*)(F.ws + ZC_OFF) + (size_t)b * 512 * CL, CL); }
    }
    __syncthreads();
}


__device__ __forceinline__ void ph_gemm_store(Frame& F, const bf16* A, const bf16* Bt, int lda, int K, int M, int N, bf16* O, int ldc, const float* rowscale, bool rev = false) {
    asm volatile("" : "+s"(K), "+s"(lda)); pg8::Gemm g{A, Bt, lda, K}; pg8::StaticOrder So; So.init(M, N, F.G, rev ? F.G - 1 - F.bx : F.bx); pg8::EpiStoreBf16 E{O, ldc, rowscale}; pg8::gemm_phase(F.lds, g, So, E, F.tid);
}
__device__ __forceinline__ void ph_gemm_res(Frame& F, const bf16* A, const bf16* Bt, int M, const float* srcL, float* dstL, const float* srcC, float* dstC, const float* gate, float on) {
    pg8::Gemm g{A, Bt, D, D}; pg8::StaticOrder So; So.init(M, D, F.G, F.bx); pg8::EpiResidual E{srcL, dstL, srcC, dstC, gate, on}; pg8::gemm_phase(F.lds, g, So, E, F.tid);
}
__device__ __forceinline__ void ph_gemm_res2(Frame& F, const bf16* A, int M) {
    pg8::Gemm g{A, (const bf16*)(F.ws + WS_WOS), D, D}; pg8::ResOrder So; So.init(M, D, F.G, F.bx); pg8::EpiResInit E{(const bf16*)(F.ws + WS_HB), (bf16*)(F.ws + WS_HB)}; pg8::gemm_phase(F.lds, g, So, E, F.tid);
}
__device__ __forceinline__ void ph_gemm_moe_gu(Frame& F, int l) {
    const int ntiles = moe_tile_table(F, l); pg8::Gemm g{(const bf16*)(F.ws + WS_H), (const bf16*)(F.ws + WS_WMOE), D, D};
    pg8::MoeGatherOrder So; So.tab = (const LAS i32x4*)(F.lds + 131072); So.ntiles = ntiles; So.nN = 4; So.G = F.G; So.c = F.vcu; So.list = (const int*)(F.ws + WS_LIST);
    pg8::EpiSwiglu E{(bf16*)(F.ws + A_ACT)}; pg8::gemm_phase_gather(F.lds, g, So, E, F.tid);
}
__device__ __forceinline__ void ph_gemm_moe_down(Frame& F, int l) {
    const int ntiles = moe_tile_table(F, l); pg8::Gemm g{(const bf16*)(F.ws + A_ACT), (const bf16*)(F.ws + WS_WMOE) + (size_t)NE * 1024 * 1024, FF, FF};
    pg8::MoeOrder So; So.tab = (const LAS i32x4*)(F.lds + 131072); So.ntiles = ntiles; So.nN = 4; So.G = F.G; So.c = F.vcu;
    pg8::EpiStoreBf16 E{(bf16*)(F.ws + A_YS), D, nullptr}; pg8::gemm_phase<pg8::EpiStoreBf16, pg8::MoeOrder, GEMM_ALIGN_MD>(F.lds, g, So, E, F.tid);
}


__device__ __forceinline__ void ph_gemm_moe_down_x(Frame& F, int l) {
    const int ntiles = moe_tile_table(F, l); pg8::Gemm g{(const bf16*)(F.ws + A_ACT), (const bf16*)(F.ws + WS_WMOE) + (size_t)NE * 1024 * 1024, FF, FF};
    pg8::MoeOrder So; So.tab = (const LAS i32x4*)(F.lds + 131072); So.ntiles = ntiles; So.nN = 4; So.G = F.G; So.c = F.vcu;
    pg8::EpiNull E{}; pg8::gemm_phase(F.lds, g, So, E, F.tid);
}
template <int MODE>
__device__ __forceinline__ void ctx_gemm(Frame& F, const bf16* A, int lda, int K, const bf16* Wt, int N, bf16* O, int ldc, const float* rowscale, const float* xsrc, float* xdst, bool rev = false) {
    LAS float* part = (LAS float*)F.lds;
    const int lane = F.lane, w = F.wave, r32 = lane & 31, hi = lane >> 5, kw = K / 8, npieces = 16 * (N / 64);
    for (int pc = rev ? F.G - 1 - F.vcu : F.vcu; pc < npieces; pc += F.G) {
        const int row0 = (pc & 15) * 32, n0 = (pc >> 4) * 64;
        f32x16 a0 = {}, a1 = {};
        const bf16* ap = A + (size_t)(row0 + r32) * lda + w * kw + 8 * hi;
        const bf16* bp0 = Wt + (size_t)(n0 + r32) * K + w * kw + 8 * hi; const bf16* bp1 = bp0 + (size_t)32 * K;
#pragma unroll 2
        for (int ks = 0; ks < kw; ks += 16) { const bf16x8 af = *(const bf16x8*)(ap + ks), b0 = *(const bf16x8*)(bp0 + ks), b1 = *(const bf16x8*)(bp1 + ks);
            a0 = __builtin_amdgcn_mfma_f32_32x32x16_bf16(af, b0, a0, 0, 0, 0); a1 = __builtin_amdgcn_mfma_f32_32x32x16_bf16(af, b1, a1, 0, 0, 0); }
        __syncthreads();
#pragma unroll
        for (int r = 0; r < 16; ++r) { part[(w * 32 + r) * 64 + lane] = a0[r]; part[(w * 32 + 16 + r) * 64 + lane] = a1[r]; }
        __syncthreads();
#pragma unroll
        for (int q = 0; q < 4; ++q) { const int idx = F.tid + NTHR * q, reg = idx >> 6, ln = idx & 63; float s = 0.f;
#pragma unroll
            for (int ww = 0; ww < 8; ++ww) s += part[(ww * 32 + reg) * 64 + ln];
            const int r16 = reg & 15, col = 32 * (reg >> 4) + (ln & 31), row = (r16 & 3) + 8 * (r16 >> 2) + 4 * (ln >> 5), gr = row0 + row, gc = n0 + col;
            if (MODE == 0) O[(size_t)(TL + gr) * ldc + gc] = (bf16)f2bf(s * (rowscale ? rowscale[TL + gr] : 1.f));
            else xdst[(size_t)gr * D + gc] = xsrc[(size_t)gr * D + gc] + s; }
    }
    __syncthreads();
}

__global__ void __launch_bounds__(NTHR, 2) mk_fwd(Args args) {
    extern __shared__ __attribute__((aligned(16))) unsigned char lds_raw[];
    Frame F;
    F.lds = (LAS unsigned char*)lds_raw; F.in = (const LAS unsigned long long*)(F.lds + LDSCTL_OFF + 512); F.out = args.out; F.ws = args.ws;
    F.tid = threadIdx.x; F.lane = F.tid & 63; F.wave = __builtin_amdgcn_readfirstlane(F.tid >> 6);
    F.G = gridDim.x; F.bx = blockIdx.x; F.vcu = F.bx; F.gw = 0; F.NGW = F.G * NWAVES;
    volatile LAS unsigned* MISC = (volatile LAS unsigned*)(F.lds + MISC_OFF);
    for (int u = F.tid; u < (LDS_BYTES - LDSCTL_OFF) / 4; u += NTHR) ((LAS unsigned*)(F.lds + LDSCTL_OFF))[u] = 0u;
    __syncthreads();
    if (F.tid == 0) { LAS unsigned long long* tab = (LAS unsigned long long*)(F.lds + LDSCTL_OFF + 512);
#pragma unroll
        for (int i = 0; i < 36; ++i) tab[i] = (unsigned long long)args.in[i]; }
    __syncthreads();
    const int lo = args.ph_lo, hi = args.ph_hi;
    XcdBarrier bar; bar.bar = (unsigned*)(F.ws + WS_CTL) + CW_BAR; bar.x = 0; bar.st = nullptr;
    if (hi - lo > 1) bar = xcd_barrier_post((unsigned*)(F.ws + WS_CTL) + CW_BAR, MISC + 8);
    int k = 0;
#if PROBE_KIND >= 0
#define pacc ((LAS float*)(F.lds + LDSCTL_OFF + 1024))
#define plast ((LAS unsigned long long*)(F.lds + LDSCTL_OFF + 1024 + 256))
    if (threadIdx.x == 0) { plast[0] = __builtin_amdgcn_s_memrealtime(); plast[1] = plast[0]; }
#define PROBE_ADD(kind) do { if (threadIdx.x == 0) { const unsigned long long n_ = __builtin_amdgcn_s_memrealtime(); pacc[kind] += (float)(n_ - plast[0]); plast[0] = n_; } } while (0)
#define pwait ((LAS float*)(F.lds + LDSCTL_OFF + 1536))
#define PROBE_WAIT(kind, stmt) do { if (threadIdx.x == 0) plast[2] = __builtin_amdgcn_s_memrealtime(); stmt; if (threadIdx.x == 0) { const float w_ = (float)(__builtin_amdgcn_s_memrealtime() - plast[2]); pacc[31] += w_; pwait[kind] += w_; } } while (0)
#else
#define PROBE_ADD(kind) do {} while (0)
#define PROBE_WAIT(kind, stmt) stmt
#endif
#define REOPAQUE { int t_ = threadIdx.x; asm volatile("" : "+v"(t_)); F.tid = t_; F.lane = t_ & 63; F.wave = __builtin_amdgcn_readfirstlane(t_ >> 6); \
        int b_ = blockIdx.x; asm volatile("" : "+s"(b_)); F.bx = b_; F.vcu = (F.G % 8 == 0) ? (b_ % 8) * (F.G / 8) + b_ / 8 : b_; F.gw = F.vcu * NWAVES + F.wave; \
        unsigned char* w_ = args.ws; asm volatile("" : "+s"(w_)); F.ws = w_; float* o_ = args.out; asm volatile("" : "+s"(o_)); F.out = o_; int g_ = gridDim.x; asm volatile("" : "+s"(g_)); F.G = g_; F.NGW = g_ * NWAVES; }
#define PH_BEGIN if (lo <= k && k < hi) { REOPAQUE
#define PH_END_K(kind) if (k + 1 < hi) PROBE_WAIT(kind, xcd_barrier(bar)); PROBE_ADD(kind); } ++k;
#define PH_END PH_END_K(30)
#define DUP2(kind, ...) { __VA_ARGS__; } if ((DUP_MASK >> (kind)) & 1) { __syncthreads(); REOPAQUE __VA_ARGS__; }
#define DUPX(kind, ...) if ((DUP_MASK >> (kind)) & 1) { __syncthreads(); REOPAQUE __VA_ARGS__; }
#define PH_END_NOBAR_K(kind) __syncthreads(); PROBE_ADD(kind); }
#define PH_END_NOBAR PH_END_NOBAR_K(30)
    LAS unsigned char* glds = F.lds;
#define wsm ((bf16*)(F.ws + WS_WSM))
#define H ((bf16*)(F.ws + WS_H))
#define P ((bf16*)(F.ws + A_P))
#define MIX ((bf16*)(F.ws + A_MIX))
#define XC ((float*)(F.ws + WS_XC))

    PH_BEGIN DUP2(0, phase_prologue(F)) PH_END_K(0)

#pragma unroll 1
    for (int lp = 0; lp < 2; ++lp) {
        {
            const int l = 2 * lp, li = lp; const bool need_ctx = true;
            PH_BEGIN phase_norm1(F, l); DUPX(12, phase_norm1(F, l, 0.f)) __syncthreads(); DUP2(11, moe_weight_convert(F, l)) __syncthreads(); wout_scaled_convert(F, l, (STOP_AFTER >= 2 * l + 1) ? 1.f : 0.f); PH_END_K(1)
            PH_BEGIN DUP2(1, (ph_gemm_store(F, H, (const bf16*)((const char*)wsm + W_EIN) + (size_t)li * EV_N * D, D, D, TL, EV_N, P, EV_N, nullptr), ctx_gemm<0>(F, H + (size_t)TL * D, D, D, (const bf16*)((const char*)wsm + W_EIN) + (size_t)li * EV_N * D, EV_N, P, EV_N, nullptr, nullptr, nullptr))) PH_END_K(3)
            PH_BEGIN phase_even_qk(F, li); DUPX(17, phase_even_qk(F, li, true)) PH_END_NOBAR_K(5)
            PH_BEGIN DUP2(15, phase_even_pool(F, li, 0, F.G >= 64 ? TL / 32 : T / 32)) PH_END_K(5)
            PH_BEGIN DUP2(2, phase_swa(F, li, need_ctx)) PH_END_K(6)
            PH_BEGIN ph_gemm_res2(F, MIX, TL); ctx_gemm<1>(F, MIX + (size_t)TL * D, D, D, (const bf16*)(F.ws + WS_WOS) + (size_t)2 * D * D, D, nullptr, 0, nullptr, l == 0 ? inp(F, I_CTX) : XC, XC); PH_END_K(7)
            PH_BEGIN phase_norm2_route(F, l); DUPX(13, phase_norm2_route(F, l, true)) PH_END_K(8)
            PH_BEGIN DUP2(4, ph_gemm_moe_gu(F, l)) PH_END_K(10)
            PH_BEGIN ph_gemm_moe_down(F, l); DUPX(5, ph_gemm_moe_down(F, l)) DUPX(20, ph_gemm_moe_down_x(F, l)) PH_END_K(11)
        }
        {
            const int l = 2 * lp + 1, li = lp; const bool need_ctx = (l < DEPTH - 1); const int Mx = need_ctx ? T : TL;
            PH_BEGIN phase_norm1(F, l); DUPX(12, phase_norm1(F, l, 0.f)) __syncthreads(); DUP2(11, moe_weight_convert(F, l)) __syncthreads(); wout_scaled_convert(F, l, (STOP_AFTER >= 2 * l + 1) ? 1.f : 0.f);
                DUP2(10, for (int t = F.vcu; t < S / 64 + (need_ctx ? CL / 8 : 0); t += F.G) { if (t < S / 64) hyena_filter_task(F, li, S, t * 64, (float*)(F.ws + A_KVU)); else hyena_filter_task(F, li, CL, (t - S / 64) * 8, (float*)(F.ws + GHC_OFF), 8); })
            PH_END_K(2)
            PH_BEGIN DUP2(1, (ph_gemm_store(F, H, (const bf16*)((const char*)wsm + W_OIN) + (size_t)li * OD_N * D, D, D, TL, OD_N, P, OD_N, nullptr), ctx_gemm<0>(F, H + (size_t)TL * D, D, D, (const bf16*)((const char*)wsm + W_OIN) + (size_t)li * OD_N * D, OD_N, P, OD_N, nullptr, nullptr, nullptr))) PH_END_K(4)
            PH_BEGIN DUP2(7, phase_odd_prep(F, li, need_ctx)) PH_END_K(12)
            PH_BEGIN DUP2(9, (ph_gemm_store(F, P + 1536, (const bf16*)((const char*)wsm + W_UQ) + (size_t)li * QU_N * 256, OD_N, 256, TL, QU_N, (bf16*)(F.ws + A_QU), QU_N, (const float*)(F.ws + WS_MISC + MISC_RSTD)), ctx_gemm<0>(F, P + (size_t)TL * OD_N + 1536, OD_N, 256, (const bf16*)((const char*)wsm + W_UQ) + (size_t)li * QU_N * 256, QU_N, (bf16*)(F.ws + A_QU), QU_N, (const float*)(F.ws + WS_MISC + MISC_RSTD), nullptr, nullptr))) PH_END_NOBAR_K(13)
            PH_BEGIN DUP2(9, (ph_gemm_store(F, P + 1792, (const bf16*)((const char*)wsm + W_UKV) + (size_t)li * KVU_N * 256, OD_N, 256, TL, KVU_N, (bf16*)(F.ws + A_KVU), KVU_N, (const float*)(F.ws + WS_MISC + MISC_RSTD) + T, true), ctx_gemm<0>(F, P + (size_t)TL * OD_N + 1792, OD_N, 256, (const bf16*)((const char*)wsm + W_UKV) + (size_t)li * KVU_N * 256, KVU_N, (bf16*)(F.ws + A_KVU), KVU_N, (const float*)(F.ws + WS_MISC + MISC_RSTD) + T, nullptr, nullptr, true))) PH_END_K(13)
            PH_BEGIN phase_mla_prep(F, li); DUPX(16, phase_mla_prep(F, li, true)) PH_END_K(14)
            PH_BEGIN phase_mla(F, li, need_ctx); DUPX(3, phase_mla<MLA_EXPT>(F, li, need_ctx)) PH_END_NOBAR_K(15)
            PH_BEGIN phase_hyena_ctx_conv(F, li, need_ctx); PH_END_NOBAR_K(20)
            PH_BEGIN phase_hyena_conv(F, li, need_ctx); DUPX(14, phase_hyena_conv(F, li, need_ctx, true)) PH_END_K(19)
            PH_BEGIN DUP2(8, phase_hyena_gate(F, li, need_ctx)) PH_END_K(16)
            PH_BEGIN ph_gemm_res2(F, MIX, TL); if (need_ctx) ctx_gemm<1>(F, MIX + (size_t)TL * D, D, D, (const bf16*)(F.ws + WS_WOS) + (size_t)2 * D * D, D, nullptr, 0, nullptr, XC, XC); PH_END_K(17)
            PH_BEGIN phase_norm2_route(F, l); DUPX(13, phase_norm2_route(F, l, true)) PH_END_K(8)
            PH_BEGIN DUP2(4, ph_gemm_moe_gu(F, l)) PH_END_K(10)
            PH_BEGIN ph_gemm_moe_down(F, l); DUPX(5, ph_gemm_moe_down(F, l)) DUPX(20, ph_gemm_moe_down_x(F, l)) PH_END_K(11)
        }
    }
    PH_BEGIN phase_final(F); DUPX(19, phase_final(F, 0.f)) PH_END_K(18)
#if PROBE_KIND >= 0
    {
        float* diag = (float*)(F.ws + WS_MISC + 900 * 1024);
        if (threadIdx.x == 0) { pacc[29] = (float)(__builtin_amdgcn_s_memrealtime() - plast[1]); __hip_atomic_store(diag + 2 * blockIdx.x, PROBE_KIND >= 100 ? pwait[PROBE_KIND - 100] : pacc[PROBE_KIND >= 100 ? 0 : PROBE_KIND], __ATOMIC_RELAXED, __HIP_MEMORY_SCOPE_AGENT); __hip_atomic_store(diag + 2 * blockIdx.x + 1, pacc[29], __ATOMIC_RELAXED, __HIP_MEMORY_SCOPE_AGENT); }
        xcd_barrier(bar);
        float a = 0.f, b = 0.f; for (int i = 0; i < (int)gridDim.x; ++i) { a += __hip_atomic_load(diag + 2 * i, __ATOMIC_RELAXED, __HIP_MEMORY_SCOPE_AGENT); b += __hip_atomic_load(diag + 2 * i + 1, __ATOMIC_RELAXED, __HIP_MEMORY_SCOPE_AGENT); }
        float fr_ = a / b; if (PROBE_Q > 0) fr_ = floorf(fr_ * PROBE_Q + 0.5f) / PROBE_Q; const float sc = 1.f + 0.1f + PROBE_MUL * fr_;
        for (size_t i = (size_t)blockIdx.x * NTHR + threadIdx.x; i < (size_t)TL * D / 4; i += (size_t)gridDim.x * NTHR) { f32x4 v = ((f32x4*)args.out)[i]; ((f32x4*)args.out)[i] = v * sc; }
    }
#endif
#undef PH_BEGIN
#undef PH_END
#undef DUP2
#undef DUPX
#undef REOPAQUE
#undef PH_END_NOBAR
#undef wsm
#undef H
#undef P
#undef MIX
#undef XC
}
constexpr int N_PHASES = 1 + 2 * (8 + 11) + 1;

extern "C" void kernel_launch(void* const* d_in, const int* in_sizes, int n_in, void* d_out, int out_size, void* d_ws, size_t ws_size, hipStream_t stream) {
    static int grid = 0;
    if (grid == 0) {
        if (n_in != 36 || out_size != TL * D || ws_size < WS_END) { fprintf(stderr, "kernel_launch: shape mismatch: n_in %d out %d ws %zu (need %zu)\n", n_in, out_size, ws_size, (size_t)WS_END); grid = -1; return; }
        int dev = 0, cus = 0, per_cu = 0;
        if (hipGetDevice(&dev) != hipSuccess || hipDeviceGetAttribute(&cus, hipDeviceAttributeMultiprocessorCount, dev) != hipSuccess) { grid = -1; return; }
        if (hipFuncSetAttribute((const void*)mk_fwd, hipFuncAttributeMaxDynamicSharedMemorySize, LDS_BYTES) != hipSuccess) { fprintf(stderr, "kernel_launch: hipFuncSetAttribute failed\n"); grid = -1; return; }
        if (hipOccupancyMaxActiveBlocksPerMultiprocessor(&per_cu, (const void*)mk_fwd, NTHR, LDS_BYTES) != hipSuccess || per_cu < 1) fprintf(stderr, "kernel_launch: occupancy query says %d\n", per_cu);
        (void)hipGetLastError();
        grid = cus;
    }
    if (grid < 0) return;
    if (hipMemsetAsync((char*)d_ws + WS_CTL, 0, CTL_ZERO_BYTES, stream) != hipSuccess) return;
    Args a{};
    for (int i = 0; i < 36; ++i) a.in[i] = (const float*)d_in[i];
    a.out = (float*)d_out; a.ws = (unsigned char*)d_ws;
#if MK_MULTI
    for (int p = 0; p < N_PHASES; ++p) { a.ph_lo = p; a.ph_hi = p + 1; hipLaunchKernelGGL(mk_fwd, dim3(grid), dim3(NTHR), LDS_BYTES, stream, a); }
#else
    a.ph_lo = 0; a.ph_hi = N_PHASES; hipLaunchKernelGGL(mk_fwd, dim3(grid), dim3(NTHR), LDS_BYTES, stream, a);
#endif
    const hipError_t le = hipPeekAtLastError();
    if (le != hipSuccess) fprintf(stderr, "kernel_launch: launch failed: %s\n", hipGetErrorName(le));
}
```

```cpp
#include <hip/hip_runtime.h>
#include <cstdio>
#include <cstdint>

#ifndef MK_MULTI
#define MK_MULTI 0
#endif
#ifndef DUP_MASK
#define DUP_MASK 0
#endif
#ifndef DUP_N
#define DUP_N 1
#endif
#ifndef PROBE_KIND
#define PROBE_KIND -1
#endif
#ifndef PROBE_Q
#define PROBE_Q 0
#endif
#ifndef PROBE_MUL
#define PROBE_MUL 2.f
#endif
#ifndef ATTN_FAST
#define ATTN_FAST attn_unit_dma
#endif
#ifndef MLA_EXPT
#define MLA_EXPT 0
#endif
#ifndef GEMM_ALIGN_MD
#define GEMM_ALIGN_MD true
#endif
#ifndef STOP_AFTER
#define STOP_AFTER 99
#endif

#define GAS __attribute__((address_space(1)))
#define LAS __attribute__((address_space(3)))
typedef unsigned short bf16;
typedef unsigned u32x4 __attribute__((ext_vector_type(4)));
typedef unsigned u32x2 __attribute__((ext_vector_type(2)));
typedef float f32x4 __attribute__((ext_vector_type(4)));
typedef float f32x2 __attribute__((ext_vector_type(2)));
typedef float f32x16 __attribute__((ext_vector_type(16)));
typedef float f32x8 __attribute__((ext_vector_type(8)));
typedef short bf16x8 __attribute__((ext_vector_type(8)));
typedef short s16x4 __attribute__((ext_vector_type(4)));
typedef int i32x4 __attribute__((ext_vector_type(4)));

constexpr int D = 1024, NB = 2, S = 16384, CL = 256, DEPTH = 4;
constexpr int TL = NB * S, TC = NB * CL, T = TL + TC;
constexpr int GRID_W = 64;
constexpr float EPS = 1e-6f;
constexpr int EV_N = 1536, OD_N = 2048  , OD_NR = 1952;
constexpr int NE = 16, FF = 512;
constexpr int HYW = 512;
constexpr int MLA_H = 8, MLA_QK = 96, MLA_V = 64, QU_N = 768, KVU_N = 1280  ;
constexpr int MOE_ROWS = 70656;
constexpr float LOG2E = 1.4426950408889634f;

constexpr size_t MiB = 1u << 20;
constexpr size_t WS_CTL = 0, CTL_ZERO_BYTES = 1 * MiB;
constexpr int CW_BAR = 4096;
constexpr int CW_WQ = 131072;
constexpr int CW_CNT = 65536;
constexpr size_t WS_MISC = 1 * MiB;
constexpr size_t MISC_MOD = 0, MISC_TILEE = 512 * 1024, MISC_RSTD = 600 * 1024  ;
constexpr size_t WS_ROPE = 2 * MiB;
constexpr size_t WS_XC = 8 * MiB;
constexpr size_t WS_ROUTE = 10 * MiB;
constexpr size_t WS_WSM = 13 * MiB;
constexpr size_t W_EIN = 0, W_EOUT = W_EIN + 2 * (size_t)EV_N * D * 2, W_OIN = W_EOUT + 2 * (size_t)D * D * 2, W_OOUT = W_OIN + 2 * (size_t)OD_N * D * 2,
                 W_UQ = W_OOUT + 2 * (size_t)D * D * 2, W_UKV = W_UQ + 2 * (size_t)QU_N * 256 * 2, W_SM_END = W_UKV + 2 * (size_t)KVU_N * 256 * 2;
static_assert(W_SM_END <= 24 * MiB, "small weights");
constexpr size_t WS_WMOE = 37 * MiB;
constexpr size_t WS_H = 85 * MiB;
constexpr size_t WS_ARENA = 150 * MiB;
constexpr size_t A_P = WS_ARENA;
constexpr size_t A_MIX = A_P + 130 * MiB;
constexpr size_t A_KVU = A_MIX + 65 * MiB;
constexpr size_t A_ZY = A_KVU + 82 * MiB;
constexpr size_t A_QU = A_ZY + 32 * MiB;
constexpr size_t A_G = A_QU + 49 * MiB;
constexpr size_t WS_HB = A_G + 64 * MiB;
constexpr size_t WS_LIST = A_G + 128 * MiB;
constexpr size_t WS_WOS = WS_LIST + 3 * MiB;
constexpr size_t WS_WT3 = WS_WOS + 6 * MiB;
constexpr size_t WS_F128 = WS_WT3 + 640 * 1024;
constexpr size_t WS_WPT = WS_WT3 + 512 * 1024;
constexpr size_t WS_END = WS_WT3 + 1 * MiB;
constexpr size_t A_H2S = A_P;
constexpr size_t A_ACT = A_KVU;
constexpr size_t A_YS = A_ZY;
static_assert(A_ACT + (size_t)MOE_ROWS * 1024 <= A_ZY && A_YS + (size_t)MOE_ROWS * 2048 <= WS_LIST, "moe aliases");
static_assert((size_t)T * 2048 * 2 <= 130 * MiB && (size_t)T * 1280 * 2 <= 82 * MiB && (size_t)T * 768 * 2 <= 49 * MiB, "arena");

constexpr int NWAVES = 8, NTHR = 512;
constexpr int RING_BYTES = 139264 + 4096;
constexpr int LDSCTL_OFF = RING_BYTES, MISC_OFF = LDSCTL_OFF + 64;
constexpr int LDS_BYTES = 147456;
static_assert(MISC_OFF + 128 <= LDS_BYTES, "lds");

#define LDS_WAIT() asm volatile("s_waitcnt lgkmcnt(0)" ::: "memory")
#define VM_WAIT() asm volatile("s_waitcnt vmcnt(0)" ::: "memory")
__device__ __forceinline__ unsigned f2bf(float f) { unsigned u = __builtin_bit_cast(unsigned, f); return (u + 0x7fffu + ((u >> 16) & 1u)) >> 16; }
__device__ __forceinline__ unsigned pk2(float lo, float hi) { return f2bf(lo) | (f2bf(hi) << 16); }
__device__ __forceinline__ float bf2f(unsigned short h) { return __builtin_bit_cast(float, (unsigned)h << 16); }
__device__ __forceinline__ float bflo(unsigned w) { return __builtin_bit_cast(float, w << 16); }
__device__ __forceinline__ float bfhi(unsigned w) { return __builtin_bit_cast(float, w & 0xffff0000u); }
template <int CTRL> __device__ __forceinline__ float dpp_f(float x) { return __builtin_bit_cast(float, __builtin_amdgcn_update_dpp(0, __builtin_bit_cast(int, x), CTRL, 0xf, 0xf, true)); }
__device__ __forceinline__ float wave_sum(float v) {
    v += dpp_f<0xB1>(v);
    v += dpp_f<0x4E>(v);
    v += dpp_f<0x141>(v);
    v += dpp_f<0x140>(v);
    const int b = __builtin_bit_cast(int, v);
    const float r0 = __builtin_bit_cast(float, __builtin_amdgcn_readlane(b, 0)), r1 = __builtin_bit_cast(float, __builtin_amdgcn_readlane(b, 16));
    const float r2 = __builtin_bit_cast(float, __builtin_amdgcn_readlane(b, 32)), r3 = __builtin_bit_cast(float, __builtin_amdgcn_readlane(b, 48));
    return (r0 + r1) + (r2 + r3);
}

namespace pg8 {
#define PG8_LAS __attribute__((address_space(3)))
typedef unsigned short bf16_t;
constexpr int BM = 256, BK = 64, HALF = 128, HTB = HALF * BK * 2, STAGE_BYTES = 8 * HTB, NXCD = 8, WGM = 8;
__host__ __device__ __forceinline__ int lds_byte(int r, int c) { const int st = (r >> 4) * 2 + (c >> 5), rr = r & 15, cc = c & 31, ob = rr * 64 + cc * 2; return st * 1024 + (ob ^ (((ob >> 9) & 1) << 5)); }
__host__ __device__ __forceinline__ void stage_rc(int b, int& R, int& C) { const int st = b / 1024, sb = b % 1024, swz = sb ^ (((sb >> 9) & 1) << 5); R = (st >> 1) * 16 + swz / 64; C = (st & 1) * 32 + (swz % 64) / 2; }
__host__ __device__ __forceinline__ int perm32(int rho) { const int n = rho >> 4, i = rho & 15; return 8 * (i >> 2) + 4 * n + (i & 3); }

struct Unit { int pm, pn; };
struct Gemm { const bf16_t* A; const bf16_t* Bt; int lda, K; };

struct StaticOrder {
    static constexpr bool GATHER = false;
    int nM, nN, nwg, G, c;
    __host__ __device__ void init(int M, int N, int G_, int c_) { nM = M / BM; nN = N / BM; nwg = nM * nN; G = G_; c = c_; }
    __host__ __device__ bool next(int i, Unit& u) const {
        const long L = (long)i * G + c; if (L >= nwg) return false;
        int wgid = (int)L; { const int q = nwg / NXCD, r = nwg % NXCD, xcd = wgid % NXCD, off = wgid / NXCD; wgid = (xcd < r ? xcd * (q + 1) : r * (q + 1) + (xcd - r) * q) + off; }
        const int nig = WGM * nN, gid = wgid / nig, fm = gid * WGM, gsz = (nM - fm) < WGM ? (nM - fm) : WGM;
        u.pm = fm + ((wgid % nig) % gsz); u.pn = (wgid % nig) / gsz; return true;
    }
    __device__ __forceinline__ size_t b_off(const Unit& u, int K) const { return (size_t)u.pn * BM * K * 2; }
};
struct MoeOrder {
    static constexpr bool GATHER = false;
    const PG8_LAS i32x4* tab; int ntiles, nN, G, c;
    __device__ bool next(int i, Unit& u) const { const int L = i * G + c; if (L >= ntiles * 4) return false; u.pm = L >> 2; u.pn = L & 3; return true; }
    __device__ __forceinline__ size_t b_off(const Unit& u, int K) const { const int e = __builtin_amdgcn_readfirstlane(tab[u.pm].x); return ((size_t)e * nN + u.pn) * BM * K * 2; }
};
struct MoeGatherOrder : MoeOrder {
    static constexpr bool GATHER = true;
    const int* list;
    __device__ __forceinline__ int a_row(const Unit& u, int r) const { const i32x4 t = tab[u.pm]; const int i = t.y + r; return i < t.z ? list[(size_t)t.x * T + i] : 0; }
};
__device__ __forceinline__ unsigned cvt_pk_bf16(float lo, float hi) { unsigned r; asm volatile("v_cvt_pk_bf16_f32 %0, %1, %2" : "=v"(r) : "v"(lo), "v"(hi)); return r; }

struct EpiStoreBf16 {
    static constexpr bool PERM = true;
    bf16_t* O; int ldc; const float* rowscale;
    __device__ __forceinline__ void operator()(const f32x4 (&acc)[2][2][4][2], const Unit& u, int wr, int wc, int fr, int fq) const {
        const int row0 = u.pm * BM + wr * 64 + fr, col0 = u.pn * BM + wc * 32 + 8 * fq;
#pragma unroll
        for (int ai = 0; ai < 2; ++ai)
#pragma unroll
            for (int m = 0; m < 4; ++m) { const int row = row0 + ai * HALF + m * 16; bf16_t* rowp = O + (size_t)row * ldc + col0; const float sc = rowscale ? rowscale[row] : 1.f;
#pragma unroll
                for (int bj = 0; bj < 2; ++bj) { f32x4 v0 = acc[ai][bj][m][0] * sc, v1 = acc[ai][bj][m][1] * sc;
                    u32x4 w; w.x = cvt_pk_bf16(v0[0], v0[1]); w.y = cvt_pk_bf16(v0[2], v0[3]); w.z = cvt_pk_bf16(v1[0], v1[1]); w.w = cvt_pk_bf16(v1[2], v1[3]);
                    *(u32x4*)(rowp + bj * HALF) = w; } }
    }
};
struct EpiNull {
    static constexpr bool PERM = true;
    __device__ __forceinline__ void operator()(const f32x4 (&acc)[2][2][4][2], const Unit& u, int wr, int wc, int fr, int fq) const {
#pragma unroll
        for (int ai = 0; ai < 2; ++ai)
#pragma unroll
            for (int bj = 0; bj < 2; ++bj)
#pragma unroll
                for (int m = 0; m < 4; ++m)
#pragma unroll
                    for (int n = 0; n < 2; ++n) asm volatile("" :: "v"(acc[ai][bj][m][n]));
    }
};
struct EpiSwiglu {
    static constexpr bool PERM = true;
    bf16_t* O;
    __device__ __forceinline__ void operator()(const f32x4 (&acc)[2][2][4][2], const Unit& u, int wr, int wc, int fr, int fq) const {
        const int row0 = u.pm * BM + wr * 64 + fr, col0 = u.pn * HALF + wc * 32 + 8 * fq;
#pragma unroll
        for (int ai = 0; ai < 2; ++ai)
#pragma unroll
            for (int m = 0; m < 4; ++m) { bf16_t* rowp = O + (size_t)(row0 + ai * HALF + m * 16) * FF + col0; float o[8];
#pragma unroll
                for (int n = 0; n < 2; ++n)
#pragma unroll
                    for (int j = 0; j < 4; ++j) { const float g = acc[ai][0][m][n][j], up = acc[ai][1][m][n][j]; o[4 * n + j] = g * __builtin_amdgcn_rcpf(1.f + __expf(-g)) * up; }
                u32x4 w; w.x = cvt_pk_bf16(o[0], o[1]); w.y = cvt_pk_bf16(o[2], o[3]); w.z = cvt_pk_bf16(o[4], o[5]); w.w = cvt_pk_bf16(o[6], o[7]);
                *(u32x4*)rowp = w; }
    }
};
struct EpiResidual {
    static constexpr bool PERM = false;
    const float* srcL; float* dstL; const float* srcC; float* dstC; const float* gate; float on;
    __device__ __forceinline__ void operator()(const f32x4 (&acc)[2][2][4][2], const Unit& u, int wr, int wc, int fr, int fq) const {
        const int row0 = u.pm * BM + wr * 64 + fr, col0 = u.pn * BM + wc * 32 + 4 * fq;
        const bool lat = (u.pm * BM) < TL; const int mrow = lat ? (u.pm * BM) / S : 2;
        const float* gp = gate + (size_t)mrow * 6 * D + col0;
        f32x4 gv[2][2];
#pragma unroll
        for (int bj = 0; bj < 2; ++bj)
#pragma unroll
            for (int n = 0; n < 2; ++n) gv[bj][n] = *(const f32x4*)(gp + bj * HALF + n * 16) * on;
        const float* sb = lat ? srcL : srcC - (size_t)TL * D; float* db = lat ? dstL : dstC - (size_t)TL * D;
#pragma unroll
        for (int ai = 0; ai < 2; ++ai)
#pragma unroll
            for (int m = 0; m < 4; ++m) { const size_t ro = (size_t)(row0 + ai * HALF + m * 16) * D + col0;
#pragma unroll
                for (int bj = 0; bj < 2; ++bj)
#pragma unroll
                    for (int n = 0; n < 2; ++n) { const f32x4 xv = *(const f32x4*)(sb + ro + bj * HALF + n * 16); *(f32x4*)(db + ro + bj * HALF + n * 16) = xv + gv[bj][n] * acc[ai][bj][m][n]; } }
    }
};

struct EpiResInit {
    static constexpr bool PERM = true;
    const bf16_t* src; bf16_t* dst;
    __device__ __forceinline__ void init(f32x4 (&acc)[2][2][4][2], const Unit& u, int wr, int wc, int fr, int fq) const {
        const int row0 = u.pm * BM + wr * 64 + fr, col0 = u.pn * BM + wc * 32 + 8 * fq;
#pragma unroll
        for (int ai = 0; ai < 2; ++ai)
#pragma unroll
            for (int m = 0; m < 4; ++m) { const bf16_t* rowp = src + (size_t)(row0 + ai * HALF + m * 16) * D + col0;
#pragma unroll
                for (int bj = 0; bj < 2; ++bj) { const u32x4 w = *(const u32x4*)(rowp + bj * HALF);
                    acc[ai][bj][m][0] = (f32x4){bflo(w.x), bfhi(w.x), bflo(w.y), bfhi(w.y)}; acc[ai][bj][m][1] = (f32x4){bflo(w.z), bfhi(w.z), bflo(w.w), bfhi(w.w)}; } }
    }
    __device__ __forceinline__ void operator()(const f32x4 (&acc)[2][2][4][2], const Unit& u, int wr, int wc, int fr, int fq) const {
        const int row0 = u.pm * BM + wr * 64 + fr, col0 = u.pn * BM + wc * 32 + 8 * fq;
#pragma unroll
        for (int ai = 0; ai < 2; ++ai)
#pragma unroll
            for (int m = 0; m < 4; ++m) { bf16_t* rowp = dst + (size_t)(row0 + ai * HALF + m * 16) * D + col0;
#pragma unroll
                for (int bj = 0; bj < 2; ++bj) { const f32x4 v0 = acc[ai][bj][m][0], v1 = acc[ai][bj][m][1];
                    u32x4 w; w.x = cvt_pk_bf16(v0[0], v0[1]); w.y = cvt_pk_bf16(v0[2], v0[3]); w.z = cvt_pk_bf16(v1[0], v1[1]); w.w = cvt_pk_bf16(v1[2], v1[3]);
                    *(u32x4*)(rowp + bj * HALF) = w; } }
    }
};
struct ResOrder : StaticOrder {
    __device__ __forceinline__ size_t b_off(const Unit& u, int K) const { const int m = (u.pm * BM) < TL ? (u.pm * BM) / S : 2; return ((size_t)m * 4 + u.pn) * BM * K * 2; }
};
template <class E_> struct has_init { template <class T_> static auto test(int) -> decltype(&T_::init, char()); template <class> static long test(...); static constexpr bool value = sizeof(test<E_>(0)) == 1; };
template <class Epi, class Sched, bool ALIGN_EPI = true>
__device__ __forceinline__ void gemm_phase(PG8_LAS unsigned char* lds, const Gemm g, const Sched& S_, const Epi& E, const int tid) {
    const int wid = __builtin_amdgcn_readfirstlane(tid >> 6), lane = tid & 63, wr = wid >> 2, wc = wid & 3, fr = lane & 15, fq = lane >> 4;
    const int K = g.K, lda = g.lda, nt = K / BK;
    unsigned voffA[2], voffB[2];
#pragma unroll
    for (int i = 0; i < 2; ++i) { int R, C; stage_rc(tid * 16 + i * 8192, R, C); const int Rb = Epi::PERM ? ((R & ~31) + perm32(R & 31)) : R;
        voffA[i] = (unsigned)(R * lda + C) * 2u; voffB[i] = (unsigned)(Rb * K + C) * 2u; }
    const size_t kstep = (size_t)(BK * 2);
    const size_t hsA = (size_t)HALF * lda * 2, hsB = (size_t)HALF * K * 2;
    const size_t tstepA = 2 * hsA;
    const unsigned ldsw = (unsigned)wid * 1024u;
    const int aoff = lds_byte(wr * 64 + fr, fq * 8), boff = lds_byte(wc * 32 + fr, fq * 8);
#define PG8_SA(b, h) (((b) * 2 + (h)) * HTB)
#define PG8_SB(b, h) ((4 + (b) * 2 + (h)) * HTB)
#define PG8_STAGE(bufoff, gbase, voff) do { _Pragma("unroll") for (int _i = 0; _i < 2; ++_i) \
        __builtin_amdgcn_global_load_lds((const unsigned*)((const char*)(gbase) + (voff)[_i]), (PG8_LAS unsigned*)(lds + (bufoff) + ldsw + _i * 8192), 16, 0, 0); } while (0)
#define PG8_LDA(dst, b, h) do { _Pragma("unroll") for (int m = 0; m < 4; ++m) _Pragma("unroll") for (int k = 0; k < 2; ++k) dst[m][k] = *(const PG8_LAS bf16x8*)(lds + PG8_SA(b, h) + aoff + m * 2048 + k * 1024); } while (0)
#define PG8_LDB(dst, b, h) do { _Pragma("unroll") for (int n = 0; n < 2; ++n) _Pragma("unroll") for (int k = 0; k < 2; ++k) dst[n][k] = *(const PG8_LAS bf16x8*)(lds + PG8_SB(b, h) + boff + n * 2048 + k * 1024); } while (0)
#define PG8_MMA(ai, bj, At, Bt) do { __builtin_amdgcn_s_setprio(1); _Pragma("unroll") for (int m = 0; m < 4; ++m) _Pragma("unroll") for (int n = 0; n < 2; ++n) _Pragma("unroll") for (int k = 0; k < 2; ++k) \
        acc[ai][bj][m][n] = __builtin_amdgcn_mfma_f32_16x16x32_bf16(Bt[n][k], At[m][k], acc[ai][bj][m][n], 0, 0, 0); __builtin_amdgcn_s_setprio(0); } while (0)
#define PG8_WAIT_V(n) asm volatile("s_waitcnt vmcnt(" #n ")" ::: "memory")
#define PG8_WAIT_L(n) asm volatile("s_waitcnt lgkmcnt(" #n ")" ::: "memory")
#define PG8_BAR __builtin_amdgcn_s_barrier()
#define PG8_SCHED __builtin_amdgcn_sched_barrier(0)
    Unit cur, nxt; int ui = 0;
    if (!S_.next(0, cur)) return;
    f32x4 acc[2][2][4][2];
    if constexpr (has_init<Epi>::value) E.init(acc, cur, wr, wc, fr, fq); else {
#pragma unroll
    for (int a = 0; a < 2; ++a)
#pragma unroll
        for (int b = 0; b < 2; ++b)
#pragma unroll
            for (int m = 0; m < 4; ++m)
#pragma unroll
                for (int n = 0; n < 2; ++n) acc[a][b][m][n] = (f32x4){0.f, 0.f, 0.f, 0.f}; }
    bf16x8 At[4][2], B0[2][2], B1[2][2];
    const char* cA = (const char*)g.A + (size_t)cur.pm * tstepA; const char* cB = (const char*)g.Bt + S_.b_off(cur, K);
    PG8_STAGE(PG8_SB(0, 0), cB, voffB); PG8_STAGE(PG8_SB(0, 1), cB + hsB, voffB); PG8_STAGE(PG8_SA(0, 0), cA, voffA); PG8_STAGE(PG8_SA(0, 1), cA + hsA, voffA);
    if (wr == 1) PG8_BAR;
    PG8_WAIT_V(2); PG8_BAR;
    PG8_STAGE(PG8_SB(1, 0), cB + kstep, voffB); PG8_STAGE(PG8_SA(1, 0), cA + kstep, voffA); PG8_STAGE(PG8_SB(1, 1), cB + hsB + kstep, voffB);
    PG8_WAIT_V(6); PG8_BAR;
    for (;;) {
        const bool has_next = S_.next(ui + 1, nxt);
        const char* nA = has_next ? (const char*)g.A + (size_t)nxt.pm * tstepA : cA; const char* nB = has_next ? (const char*)g.Bt + S_.b_off(nxt, K) : cB;
        for (int t = 0; t < nt; t += 2) {
            const bool last = (t == nt - 2);
            const char* a1 = cA + (size_t)(t + 1) * kstep;
            const char* a2 = last ? nA : cA + (size_t)(t + 2) * kstep; const char* b2 = last ? nB : cB + (size_t)(t + 2) * kstep;
            const char* a3 = a2 + kstep; const char* b3 = b2 + kstep;
            PG8_LDB(B0, 0, 0); PG8_LDB(B1, 0, 1); PG8_SCHED; PG8_LDA(At, 0, 0); PG8_STAGE(PG8_SA(1, 1), a1 + hsA, voffA);
            PG8_WAIT_V(8); PG8_WAIT_L(0); PG8_BAR; PG8_MMA(0, 0, At, B0); PG8_MMA(0, 1, At, B1); PG8_BAR; PG8_SCHED;
            PG8_LDA(At, 0, 1); PG8_STAGE(PG8_SB(0, 0), b2, voffB); PG8_STAGE(PG8_SB(0, 1), b2 + hsB, voffB); PG8_STAGE(PG8_SA(0, 0), a2, voffA);
            PG8_WAIT_V(8); PG8_WAIT_L(0); PG8_BAR; PG8_MMA(1, 0, At, B0); PG8_MMA(1, 1, At, B1); PG8_BAR; PG8_SCHED;
            PG8_LDB(B0, 1, 0); PG8_LDB(B1, 1, 1); PG8_SCHED; PG8_LDA(At, 1, 0); PG8_STAGE(PG8_SA(0, 1), a2 + hsA, voffA);
            PG8_WAIT_V(8); PG8_WAIT_L(0); PG8_BAR; PG8_MMA(0, 0, At, B0); PG8_MMA(0, 1, At, B1); PG8_BAR; PG8_SCHED;
            PG8_LDA(At, 1, 1); PG8_STAGE(PG8_SB(1, 0), b3, voffB); PG8_STAGE(PG8_SB(1, 1), b3 + hsB, voffB); PG8_STAGE(PG8_SA(1, 0), a3, voffA);
            PG8_WAIT_V(8); PG8_WAIT_L(0); PG8_BAR; PG8_MMA(1, 0, At, B0); PG8_MMA(1, 1, At, B1); PG8_BAR; PG8_SCHED;
        }
        if constexpr (ALIGN_EPI) { if (wr == 0) PG8_BAR; }
        E(acc, cur, wr, wc, fr, fq);
        if (!has_next) break;
        if constexpr (has_init<Epi>::value) E.init(acc, nxt, wr, wc, fr, fq); else {
#pragma unroll
        for (int a = 0; a < 2; ++a)
#pragma unroll
            for (int b = 0; b < 2; ++b)
#pragma unroll
                for (int m = 0; m < 4; ++m)
#pragma unroll
                    for (int n = 0; n < 2; ++n) acc[a][b][m][n] = (f32x4){0.f, 0.f, 0.f, 0.f}; }
        cur = nxt; cA = nA; cB = nB; ++ui;
        if constexpr (ALIGN_EPI) { if (wr == 1) PG8_BAR; }
    }
    PG8_WAIT_V(0);
    if constexpr (!ALIGN_EPI) { if (wr == 0) PG8_BAR; }
    PG8_BAR;
#undef PG8_SA
#undef PG8_SB
#undef PG8_STAGE
#undef PG8_LDA
#undef PG8_LDB
#undef PG8_MMA
#undef PG8_WAIT_V
#undef PG8_WAIT_L
#undef PG8_BAR
#undef PG8_SCHED
}
template <class Epi, class Sched, bool ALIGN_EPI = true>
__device__ __forceinline__ void gemm_phase_gather(PG8_LAS unsigned char* lds, const Gemm g, const Sched& S_, const Epi& E, const int tid) {
    const int wid = __builtin_amdgcn_readfirstlane(tid >> 6), lane = tid & 63, wr = wid >> 2, wc = wid & 3, fr = lane & 15, fq = lane >> 4;
    const int K = g.K, lda = g.lda, nt = K / BK;
    unsigned voffB[2], cofs[2]; int rA[2];
#pragma unroll
    for (int i = 0; i < 2; ++i) { int R, C; stage_rc(tid * 16 + i * 8192, R, C); const int Rb = Epi::PERM ? ((R & ~31) + perm32(R & 31)) : R;
        rA[i] = R; cofs[i] = (unsigned)C * 2u; voffB[i] = (unsigned)(Rb * K + C) * 2u; }
    unsigned vc[2][2], vn[2][2];
#define PG8_ROWS(dst, unit) do { _Pragma("unroll") for (int h_ = 0; h_ < 2; ++h_) _Pragma("unroll") for (int i_ = 0; i_ < 2; ++i_) dst[h_][i_] = (unsigned)S_.a_row(unit, 128 * h_ + rA[i_]) * (unsigned)(lda * 2) + cofs[i_]; } while (0)
#define PG8_STAGE_G(bufoff, kbyte, v) do { _Pragma("unroll") for (int _i = 0; _i < 2; ++_i) \
        __builtin_amdgcn_global_load_lds((const unsigned*)((const char*)g.A + (kbyte) + (v)[_i]), (PG8_LAS unsigned*)(lds + (bufoff) + ldsw + _i * 8192), 16, 0, 0); } while (0)
    const size_t kstep = (size_t)(BK * 2);
    const size_t hsB = (size_t)HALF * K * 2;
    const unsigned ldsw = (unsigned)wid * 1024u;
    const int aoff = lds_byte(wr * 64 + fr, fq * 8), boff = lds_byte(wc * 32 + fr, fq * 8);
#define PG8_SA(b, h) (((b) * 2 + (h)) * HTB)
#define PG8_SB(b, h) ((4 + (b) * 2 + (h)) * HTB)
#define PG8_STAGE(bufoff, gbase, voff) do { _Pragma("unroll") for (int _i = 0; _i < 2; ++_i) \
        __builtin_amdgcn_global_load_lds((const unsigned*)((const char*)(gbase) + (voff)[_i]), (PG8_LAS unsigned*)(lds + (bufoff) + ldsw + _i * 8192), 16, 0, 0); } while (0)
#define PG8_LDA(dst, b, h) do { _Pragma("unroll") for (int m = 0; m < 4; ++m) _Pragma("unroll") for (int k = 0; k < 2; ++k) dst[m][k] = *(const PG8_LAS bf16x8*)(lds + PG8_SA(b, h) + aoff + m * 2048 + k * 1024); } while (0)
#define PG8_LDB(dst, b, h) do { _Pragma("unroll") for (int n = 0; n < 2; ++n) _Pragma("unroll") for (int k = 0; k < 2; ++k) dst[n][k] = *(const PG8_LAS bf16x8*)(lds + PG8_SB(b, h) + boff + n * 2048 + k * 1024); } while (0)
#define PG8_MMA(ai, bj, At, Bt) do { __builtin_amdgcn_s_setprio(1); _Pragma("unroll") for (int m = 0; m < 4; ++m) _Pragma("unroll") for (int n = 0; n < 2; ++n) _Pragma("unroll") for (int k = 0; k < 2; ++k) \
        acc[ai][bj][m][n] = __builtin_amdgcn_mfma_f32_16x16x32_bf16(Bt[n][k], At[m][k], acc[ai][bj][m][n], 0, 0, 0); __builtin_amdgcn_s_setprio(0); } while (0)
#define PG8_WAIT_V(n) asm volatile("s_waitcnt vmcnt(" #n ")" ::: "memory")
#define PG8_WAIT_L(n) asm volatile("s_waitcnt lgkmcnt(" #n ")" ::: "memory")
#define PG8_BAR __builtin_amdgcn_s_barrier()
#define PG8_SCHED __builtin_amdgcn_sched_barrier(0)
    Unit cur, nxt; int ui = 0;
    if (!S_.next(0, cur)) return;
    f32x4 acc[2][2][4][2];
#pragma unroll
    for (int a = 0; a < 2; ++a)
#pragma unroll
        for (int b = 0; b < 2; ++b)
#pragma unroll
            for (int m = 0; m < 4; ++m)
#pragma unroll
                for (int n = 0; n < 2; ++n) acc[a][b][m][n] = (f32x4){0.f, 0.f, 0.f, 0.f};
    bf16x8 At[4][2], B0[2][2], B1[2][2];
    const char* cB = (const char*)g.Bt + S_.b_off(cur, K); PG8_ROWS(vc, cur);
    PG8_STAGE(PG8_SB(0, 0), cB, voffB); PG8_STAGE(PG8_SB(0, 1), cB + hsB, voffB); PG8_STAGE_G(PG8_SA(0, 0), 0, vc[0]); PG8_STAGE_G(PG8_SA(0, 1), 0, vc[1]);
    if (wr == 1) PG8_BAR;
    PG8_WAIT_V(2); PG8_BAR;
    PG8_STAGE(PG8_SB(1, 0), cB + kstep, voffB); PG8_STAGE_G(PG8_SA(1, 0), kstep, vc[0]); PG8_STAGE(PG8_SB(1, 1), cB + hsB + kstep, voffB);
    PG8_WAIT_V(6); PG8_BAR;
    for (;;) {
        const bool has_next = S_.next(ui + 1, nxt);
        const char* nB = has_next ? (const char*)g.Bt + S_.b_off(nxt, K) : cB;
        if (has_next) PG8_ROWS(vn, nxt); else { _Pragma("unroll") for (int h_ = 0; h_ < 2; ++h_) _Pragma("unroll") for (int i_ = 0; i_ < 2; ++i_) vn[h_][i_] = vc[h_][i_]; }
        for (int t = 0; t < nt; t += 2) {
            const bool last = (t == nt - 2);
            const size_t a1 = (size_t)(t + 1) * kstep, a2 = last ? 0 : (size_t)(t + 2) * kstep, a3 = a2 + kstep; const char* b2 = last ? nB : cB + (size_t)(t + 2) * kstep; const char* b3 = b2 + kstep;
            unsigned w0[2], w1[2];
#pragma unroll
            for (int i_ = 0; i_ < 2; ++i_) { w0[i_] = last ? vn[0][i_] : vc[0][i_]; w1[i_] = last ? vn[1][i_] : vc[1][i_]; }
            PG8_LDB(B0, 0, 0); PG8_LDB(B1, 0, 1); PG8_SCHED; PG8_LDA(At, 0, 0); PG8_STAGE_G(PG8_SA(1, 1), a1, vc[1]);
            PG8_WAIT_V(8); PG8_WAIT_L(0); PG8_BAR; PG8_MMA(0, 0, At, B0); PG8_MMA(0, 1, At, B1); PG8_BAR; PG8_SCHED;
            PG8_LDA(At, 0, 1); PG8_STAGE(PG8_SB(0, 0), b2, voffB); PG8_STAGE(PG8_SB(0, 1), b2 + hsB, voffB); PG8_STAGE_G(PG8_SA(0, 0), a2, w0);
            PG8_WAIT_V(8); PG8_WAIT_L(0); PG8_BAR; PG8_MMA(1, 0, At, B0); PG8_MMA(1, 1, At, B1); PG8_BAR; PG8_SCHED;
            PG8_LDB(B0, 1, 0); PG8_LDB(B1, 1, 1); PG8_SCHED; PG8_LDA(At, 1, 0); PG8_STAGE_G(PG8_SA(0, 1), a2, w1);
            PG8_WAIT_V(8); PG8_WAIT_L(0); PG8_BAR; PG8_MMA(0, 0, At, B0); PG8_MMA(0, 1, At, B1); PG8_BAR; PG8_SCHED;
            PG8_LDA(At, 1, 1); PG8_STAGE(PG8_SB(1, 0), b3, voffB); PG8_STAGE(PG8_SB(1, 1), b3 + hsB, voffB); PG8_STAGE_G(PG8_SA(1, 0), a3, w0);
            PG8_WAIT_V(8); PG8_WAIT_L(0); PG8_BAR; PG8_MMA(1, 0, At, B0); PG8_MMA(1, 1, At, B1); PG8_BAR; PG8_SCHED;
        }
        if constexpr (ALIGN_EPI) { if (wr == 0) PG8_BAR; }
        E(acc, cur, wr, wc, fr, fq);
        if (!has_next) break;
#pragma unroll
        for (int a = 0; a < 2; ++a)
#pragma unroll
            for (int b = 0; b < 2; ++b)
#pragma unroll
                for (int m = 0; m < 4; ++m)
#pragma unroll
                    for (int n = 0; n < 2; ++n) acc[a][b][m][n] = (f32x4){0.f, 0.f, 0.f, 0.f};
        cur = nxt; cB = nB; ++ui;
#pragma unroll
        for (int h_ = 0; h_ < 2; ++h_)
#pragma unroll
            for (int i_ = 0; i_ < 2; ++i_) vc[h_][i_] = vn[h_][i_];
        if constexpr (ALIGN_EPI) { if (wr == 1) PG8_BAR; }
    }
    PG8_WAIT_V(0);
    if constexpr (!ALIGN_EPI) { if (wr == 0) PG8_BAR; }
    PG8_BAR;
#undef PG8_SA
#undef PG8_SB
#undef PG8_STAGE
#undef PG8_STAGE_G
#undef PG8_ROWS
#undef PG8_LDA
#undef PG8_LDB
#undef PG8_MMA
#undef PG8_WAIT_V
#undef PG8_WAIT_L
#undef PG8_BAR
#undef PG8_SCHED
}
}

#define XB_TMO      128
#define XB_XCNT(j)  (256  + 64 * (j))
#define XB_XSUB(j)  (1280 + 64 * (j))
#define XB_XGEN(j)  (2304 + 64 * (j))
#define XB_TOP      3328
#define XB_TOPGEN   3392
#define XCD_BAR_WORDS 3456
#define XB_SPIN_CAP (1u << 20)
__device__ __forceinline__ unsigned xb_ld(unsigned* p)              { return __hip_atomic_load(p, __ATOMIC_RELAXED, __HIP_MEMORY_SCOPE_AGENT); }
__device__ __forceinline__ unsigned xb_add(unsigned* p, unsigned v) { return __hip_atomic_fetch_add(p, v, __ATOMIC_RELAXED, __HIP_MEMORY_SCOPE_AGENT); }
__device__ __forceinline__ unsigned xb_xcc_id() { return (unsigned)__builtin_amdgcn_s_getreg((3 << 11) | 20) & 0xFu; }
#define XB_SPIN(cond, bar) do { unsigned _sp = 0; while (cond) { __builtin_amdgcn_s_sleep(1); \
    if ((++_sp & 255u) == 0u) { if (xb_ld(&(bar)[XB_TMO])) break; if (_sp > XB_SPIN_CAP) { atomicAdd(&(bar)[XB_TMO], 1u); break; } } } } while (0)
struct XcdBarrier { unsigned* bar; unsigned x; volatile LAS unsigned* st; };
__device__ __forceinline__ XcdBarrier xcd_barrier_post(unsigned* bar, volatile LAS unsigned* st) {
    XcdBarrier b; b.bar = bar; b.x = xb_xcc_id(); b.st = st;
    if (threadIdx.x == 0) (void)xb_add(&bar[XB_XCNT(b.x)], 1u);
    return b;
}
__device__ __forceinline__ void xcd_barrier_complete(unsigned* bar, unsigned x, unsigned& nloc, unsigned& nx) {
    const unsigned G = gridDim.x * gridDim.y * gridDim.z;
    unsigned sum, cnt, mine, sp = 0u;
    for (;;) {
        sum = 0u; cnt = 0u; mine = 0u;
#pragma unroll
        for (unsigned j = 0; j < 16; ++j) { const unsigned c = xb_ld(&bar[XB_XCNT(j)]); sum += c; cnt += (c > 0u) ? 1u : 0u; mine = (j == x) ? c : mine; }
        if (sum == G) break;
        __builtin_amdgcn_s_sleep(1);
        if ((++sp & 255u) == 0u) { if (xb_ld(&bar[XB_TMO])) break; if (sp > XB_SPIN_CAP) { atomicAdd(&bar[XB_TMO], 1u); break; } }
    }
    nloc = mine > 0u ? mine : 1u; nx = cnt > 0u ? cnt : 1u;
}
__device__ __forceinline__ void xcd_barrier(const XcdBarrier& b) {
    asm volatile("s_waitcnt vmcnt(0)" ::: "memory");
    __syncthreads();
    if (threadIdx.x == 0) {
        unsigned* bar = b.bar;
        __builtin_amdgcn_s_waitcnt(0);
        unsigned nloc = b.st[0], nx = b.st[1];
        if (nloc == 0u) { xcd_barrier_complete(bar, b.x, nloc, nx); b.st[0] = nloc; b.st[1] = nx; }
        const unsigned old = xb_add(&bar[XB_XSUB(b.x)], 1u);
        const unsigned gen = old / nloc;
        if (old + 1u == (gen + 1u) * nloc) {
            __builtin_amdgcn_fence(__ATOMIC_RELEASE, "agent");
            asm volatile("s_waitcnt vmcnt(0)" ::: "memory");
            const unsigned og = xb_add(&bar[XB_TOP], 1u);
            const unsigned tg = og / nx;
            if (og + 1u == (tg + 1u) * nx) xb_add(&bar[XB_TOPGEN], 1u);
            else XB_SPIN(xb_ld(&bar[XB_TOPGEN]) == tg, bar);
            __builtin_amdgcn_fence(__ATOMIC_ACQUIRE, "agent");
            xb_add(&bar[XB_XGEN(b.x)], 1u);
            asm volatile("s_waitcnt vmcnt(0)" ::: "memory");
        } else {
            XB_SPIN(xb_ld(&bar[XB_XGEN(b.x)]) == gen, bar);
            __builtin_amdgcn_fence(__ATOMIC_ACQUIRE, "agent");
            asm volatile("s_waitcnt vmcnt(0)" ::: "memory");
        }
    }
    __syncthreads();
}

struct Args { const float* in[36]; float* out; unsigned char* ws; int ph_lo, ph_hi; };
struct Frame {
    LAS unsigned char* lds;
    const LAS unsigned long long* in; float* out; unsigned char* ws;
    int tid, lane, wave, vcu, G, gw, NGW, bx;
};
enum { I_X = 0, I_C, I_CTX, I_CCTX, I_ADAW, I_ADAB, I_NORMG, I_EVWIN, I_EVWOUT, I_POOLW, I_POOLS, I_SWAQG, I_SWAKG, I_SINK, I_ODWIN, I_ODWOUT, I_HYCW, I_HYCB,
       I_HYW1, I_HYB1, I_HYW2, I_HYB2, I_HYW3, I_HYFREQ, I_HYSKIP, I_CQG, I_CKVG, I_WUQ, I_WUKV, I_MQG, I_MKG, I_RW, I_RB, I_MG, I_MU, I_MD };

__device__ __forceinline__ const float* inp(const Frame& F, int i) { const unsigned long long v = F.in[i];
    const unsigned lo = __builtin_amdgcn_readfirstlane((unsigned)v), hi = __builtin_amdgcn_readfirstlane((unsigned)(v >> 32)); return (const float*)(((unsigned long long)hi << 32) | lo); }
__device__ __forceinline__ float* mod_ptr(const Frame& F, int l, int m) { return (float*)(F.ws + WS_MISC + MISC_MOD) + ((size_t)l * 3 + m) * 6 * D; }
__device__ __forceinline__ int* tile_e_ptr(const Frame& F, int l) { return (int*)(F.ws + WS_MISC + MISC_TILEE) + l * 288; }
__device__ __forceinline__ unsigned* cnt_ptr(const Frame& F, int l) { return (unsigned*)(F.ws + WS_CTL) + CW_CNT + 64 * NE * l; }
__device__ __forceinline__ const float* xsrc_row(const Frame& F, int l, int r) {
    if (r < TL) return (l == 0 ? inp(F, I_X) : F.out) + (size_t)r * D;
    return (l == 0 ? inp(F, I_CTX) : (const float*)(F.ws + WS_XC)) + (size_t)(r - TL) * D;
}
__device__ __forceinline__ bf16* hb_row(const Frame& F, int r) { return (bf16*)(F.ws + WS_HB) + (size_t)r * D; }
__device__ __forceinline__ float* xdst_row(const Frame& F, int r) { return r < TL ? F.out + (size_t)r * D : (float*)(F.ws + WS_XC) + (size_t)(r - TL) * D; }

template <class RowMap>
__device__ __forceinline__ void tr_item(const float* W, int N, bf16* WT, int Kd, int k0, int n0, LAS float* scr, int lane, RowMap rm) {
#pragma unroll 8
    for (int i = 0; i < 32; ++i) { const int kk = 2 * i + (lane >> 5); scr[kk * 33 + (lane & 31)] = W[(size_t)(k0 + kk) * N + n0 + (lane & 31)]; }
    LDS_WAIT(); asm volatile("" ::: "memory");
    const int c = lane & 7;
#pragma unroll
    for (int j = 0; j < 4; ++j) { const int n = (lane >> 3) + 8 * j; const LAS float* s = scr + (8 * c) * 33 + n;
        u32x4 o; o.x = pk2(s[0 * 33], s[1 * 33]); o.y = pk2(s[2 * 33], s[3 * 33]); o.z = pk2(s[4 * 33], s[5 * 33]); o.w = pk2(s[6 * 33], s[7 * 33]);
        *(u32x4*)(WT + (size_t)rm(n0 + n) * Kd + k0 + 8 * c) = o; }
    LDS_WAIT(); asm volatile("" ::: "memory");
}
template <class RowMap>
__device__ __forceinline__ void tr_item64(const float* W, int N, bf16* WT, int Kd, int k0, int n0, int nvalid, LAS float* scr, int lane, RowMap rm, const float* colscale = nullptr, float on = 1.f) {
    const int c4 = (lane & 15) * 4; f32x4 cs4 = {1.f, 1.f, 1.f, 1.f}; if (colscale) cs4 = *(const f32x4*)(colscale + n0 + c4) * on;
#pragma unroll 4
    for (int i = 0; i < 16; ++i) { const int kk = 4 * i + (lane >> 4); f32x4 w = {0.f, 0.f, 0.f, 0.f};
        if (c4 < nvalid) w = *(const f32x4*)(W + (size_t)(k0 + kk) * N + n0 + c4) * cs4;
        LAS float* d = scr + kk * 65 + c4; d[0] = w.x; d[1] = w.y; d[2] = w.z; d[3] = w.w; }
    LDS_WAIT(); asm volatile("" ::: "memory");
    const int c = lane & 7;
#pragma unroll
    for (int j = 0; j < 8; ++j) { const int n = (lane >> 3) + 8 * j; const LAS float* s = scr + (8 * c) * 65 + n;
        u32x4 o; o.x = pk2(s[0 * 65], s[1 * 65]); o.y = pk2(s[2 * 65], s[3 * 65]); o.z = pk2(s[4 * 65], s[5 * 65]); o.w = pk2(s[6 * 65], s[7 * 65]);
        if (n < nvalid) *(u32x4*)(WT + (size_t)rm(n0 + n) * Kd + k0 + 8 * c) = o; }
    LDS_WAIT(); asm volatile("" ::: "memory");
}
struct RmId { __device__ __forceinline__ int operator()(int n) const { return n; } };
struct RmGate { int add; __device__ __forceinline__ int operator()(int n) const { return 256 * (n >> 7) + add + (n & 127); } };

__device__ __forceinline__ float silu_f(float v) { return v / (1.f + __expf(-v)); }

__device__ __forceinline__ void phase_prologue(Frame& F) {
    LAS float* scr = (LAS float*)(F.lds + F.wave * 16896);
    bf16* wsm = (bf16*)(F.ws + WS_WSM);
    {
        constexpr int I_EI = 16 * 24, I_EO = 16 * 16, I_OI = 16 * 31, I_OO = 16 * 16, PER = I_EI + I_EO + I_OI + I_OO;
        for (int it = F.gw; it < 2 * PER; it += F.NGW) {
            const int i = it / PER; int r = it % PER;
            if (r < I_EI) { tr_item64(inp(F, I_EVWIN) + (size_t)i * D * EV_N, EV_N, (bf16*)((char*)wsm + W_EIN) + (size_t)i * EV_N * D, D, 64 * (r / 24), 64 * (r % 24), 64, scr, F.lane, RmId{}); continue; } r -= I_EI;
            if (r < I_EO) { tr_item64(inp(F, I_EVWOUT) + (size_t)i * D * D, D, (bf16*)((char*)wsm + W_EOUT) + (size_t)i * D * D, D, 64 * (r / 16), 64 * (r % 16), 64, scr, F.lane, RmId{}); continue; } r -= I_EO;
            if (r < I_OI) { tr_item64(inp(F, I_ODWIN) + (size_t)i * D * OD_NR, OD_NR, (bf16*)((char*)wsm + W_OIN) + (size_t)i * OD_N * D, D, 64 * (r / 31), 64 * (r % 31), (r % 31) == 30 ? 32 : 64, scr, F.lane, RmId{}); continue; } r -= I_OI;
            tr_item64(inp(F, I_ODWOUT) + (size_t)i * D * D, D, (bf16*)((char*)wsm + W_OOUT) + (size_t)i * D * D, D, 64 * (r / 16), 64 * (r % 16), 64, scr, F.lane, RmId{});
        }
    }
    const int gt = F.gw * 64 + F.lane, NGT = F.NGW * 64;
    for (int idx = gt; idx < 2 * 96 * (D / 8); idx += NGT) { const int i = idx / (96 * (D / 8)), r = idx % (96 * (D / 8));
        *(u32x4*)((bf16*)((char*)wsm + W_OIN) + (size_t)i * OD_N * D + (size_t)(OD_NR + r / (D / 8)) * D + 8 * (r % (D / 8))) = (u32x4){0u, 0u, 0u, 0u}; }
    for (int idx = gt; idx < 2 * QU_N * 32; idx += NGT) { const int i = idx / (QU_N * 32), r = idx % (QU_N * 32), n = r / 32, kc = r % 32;
        const float* W = inp(F, I_WUQ) + (size_t)i * 256 * QU_N; const float* gn = inp(F, I_CQG) + i * 256; float v[8];
#pragma unroll
        for (int j = 0; j < 8; ++j) v[j] = W[(size_t)(8 * kc + j) * QU_N + n] * gn[8 * kc + j];
        *(u32x4*)((bf16*)((char*)wsm + W_UQ) + (size_t)i * QU_N * 256 + (size_t)n * 256 + 8 * kc) = (u32x4){pk2(v[0], v[1]), pk2(v[2], v[3]), pk2(v[4], v[5]), pk2(v[6], v[7])}; }
    for (int idx = gt; idx < 2 * KVU_N * 32; idx += NGT) { const int i = idx / (KVU_N * 32), r = idx % (KVU_N * 32), n = r / 32, kc = r % 32, h = n / 160, j = n % 160;
        const float* W = inp(F, I_WUKV) + (size_t)i * 128 * 1024; const float* gn = inp(F, I_CKVG) + i * 128; float v[8];
        const bool z = (kc >= 16) || (j >= 64 && j < 96); const int col = h * 128 + (j < 64 ? j : j - 32);
#pragma unroll
        for (int jj = 0; jj < 8; ++jj) v[jj] = z ? 0.f : W[(size_t)(8 * kc + jj) * 1024 + col] * gn[8 * kc + jj];
        *(u32x4*)((bf16*)((char*)wsm + W_UKV) + (size_t)i * KVU_N * 256 + (size_t)n * 256 + 8 * kc) = (u32x4){pk2(v[0], v[1]), pk2(v[2], v[3]), pk2(v[4], v[5]), pk2(v[6], v[7])}; }
    for (int idx = gt; idx < 128 * 128; idx += NGT) { const int kk = idx >> 7, nn = idx & 127; float sn, cs; sincospif(-(float)((kk * nn) & 127) * (1.f / 64.f), &sn, &cs);
        ((bf16*)(F.ws + WS_F128))[idx] = (bf16)f2bf(cs); ((bf16*)(F.ws + WS_F128))[128 * 128 + idx] = (bf16)f2bf(sn); }
    for (int idx = gt; idx < 2 * 4 * 64 * 8; idx += NGT) { const int lg = idx / 512, r = idx % 512, d = r / 8, kc = r % 8; const float* W = inp(F, I_POOLW) + (size_t)lg * 64 * 64; float v[8];
#pragma unroll
        for (int j = 0; j < 8; ++j) v[j] = W[(size_t)(8 * kc + j) * 64 + d];
        *(u32x4*)((bf16*)(F.ws + WS_WPT) + ((size_t)lg * 64 + d) * 64 + 8 * kc) = (u32x4){pk2(v[0], v[1]), pk2(v[2], v[3]), pk2(v[4], v[5]), pk2(v[6], v[7])}; }
    for (int idx = gt; idx < 2 * 1024 * 8; idx += NGT) { const int i = idx / 8192, r = idx % 8192, col = r / 8, kc = r % 8; const float* W = inp(F, I_HYW3) + (size_t)i * 64 * 1024; float v[8];
#pragma unroll
        for (int j = 0; j < 8; ++j) v[j] = W[(size_t)(8 * kc + j) * 1024 + col];
        *(u32x4*)((bf16*)(F.ws + WS_WT3) + ((size_t)i * 1024 + col) * 64 + 8 * kc) = (u32x4){pk2(v[0], v[1]), pk2(v[2], v[3]), pk2(v[4], v[5]), pk2(v[6], v[7])}; }
    { f32x2* r64 = (f32x2*)(F.ws + WS_ROPE); f32x2* r32 = r64 + (size_t)S * 32;
      for (int idx = gt; idx < S * 32; idx += NGT) { const int s = idx >> 5, i = idx & 31; const float pos = (float)(i < 16 ? s / GRID_W : s % GRID_W);
          const float inv = powf(10000.f, -(float)(i & 15) / 16.f); float sn, cs; sincosf(pos * inv, &sn, &cs); r64[idx] = (f32x2){cs, sn}; }
      for (int idx = gt; idx < S * 16; idx += NGT) { const int s = idx >> 4, i = idx & 15; const float pos = (float)(i < 8 ? s / GRID_W : s % GRID_W);
          const float inv = powf(10000.f, -(float)(i & 7) / 8.f); float sn, cs; sincosf(pos * inv, &sn, &cs); r32[idx] = (f32x2){cs, sn}; } }
    if (F.bx < 96) {
        __syncthreads();
        LAS float* sl = (LAS float*)(F.lds);
        LAS float* red = (LAS float*)(F.lds + 16384);
        for (int i = F.tid; i < 3 * D; i += NTHR) { const int m = i / D, k = i % D; sl[i] = silu_f(m < 2 ? inp(F, I_C)[m * D + k] : inp(F, I_CCTX)[k]); }
        __syncthreads();
        const int l = F.bx / 24, j0 = (F.bx % 24) * 256 + 4 * F.lane;
        const float* W = inp(F, I_ADAW) + (size_t)l * D * 6 * D + j0;
        f32x4 a0 = {0.f, 0.f, 0.f, 0.f}, a1 = a0, a2 = a0;
#pragma unroll 8
        for (int k = F.wave * 128; k < F.wave * 128 + 128; ++k) { const f32x4 w = *(const f32x4*)(W + (size_t)k * 6 * D); a0 += w * sl[k]; a1 += w * sl[D + k]; a2 += w * sl[2 * D + k]; }
        *(LAS f32x4*)(red + (F.wave * 3 + 0) * 256 + 4 * F.lane) = a0; *(LAS f32x4*)(red + (F.wave * 3 + 1) * 256 + 4 * F.lane) = a1; *(LAS f32x4*)(red + (F.wave * 3 + 2) * 256 + 4 * F.lane) = a2;
        __syncthreads();
        for (int i = F.tid; i < 3 * 256; i += NTHR) { const int m = i / 256, jj = i % 256; float s = inp(F, I_ADAB)[l * 6 * D + (F.bx % 24) * 256 + jj];
#pragma unroll
            for (int w = 0; w < 8; ++w) s += red[(w * 3 + m) * 256 + jj];
            mod_ptr(F, l, m)[(F.bx % 24) * 256 + jj] = s; }
        __syncthreads();
    }
}

__device__ __forceinline__ void moe_weight_convert(Frame& F, int l) {
    LAS float* scr = (LAS float*)(F.lds + F.wave * 16896);
    bf16* wgu = (bf16*)(F.ws + WS_WMOE); bf16* wd = wgu + (size_t)NE * 1024 * 1024;
    for (int it = F.gw; it < NE * 3 * 128; it += F.NGW) {
        const int e = it / 384, r = it % 384, which = r / 128, q = r % 128;
        if (which == 0)      tr_item64(inp(F, I_MG) + ((size_t)l * NE + e) * D * FF, FF, wgu + (size_t)e * 1024 * 1024, D, 64 * (q / 8), 64 * (q % 8), 64, scr, F.lane, RmGate{0});
        else if (which == 1) tr_item64(inp(F, I_MU) + ((size_t)l * NE + e) * D * FF, FF, wgu + (size_t)e * 1024 * 1024, D, 64 * (q / 8), 64 * (q % 8), 64, scr, F.lane, RmGate{128});
        else                 tr_item64(inp(F, I_MD) + ((size_t)l * NE + e) * FF * D, D, wd + (size_t)e * 1024 * FF, FF, 64 * (q / 16), 64 * (q % 16), 64, scr, F.lane, RmId{});
    }
}

__device__ __forceinline__ int moe_offsets(const Frame& F, int l, int (&off)[NE]) {
    const unsigned* cnt = cnt_ptr(F, l); int acc = 0;
#pragma unroll
    for (int e = 0; e < NE; ++e) { off[e] = acc; const int c = (int)__builtin_amdgcn_readfirstlane(__hip_atomic_load(cnt + 64 * e, __ATOMIC_RELAXED, __HIP_MEMORY_SCOPE_AGENT)); acc += ((c + 255) >> 8) << 8; }
    return acc >> 8;
}
__device__ __forceinline__ void wout_scaled_convert(Frame& F, int l, float on) {
    LAS float* scr = (LAS float*)(F.lds + F.wave * 16896);
    const float* W = (l & 1 ? inp(F, I_ODWOUT) : inp(F, I_EVWOUT)) + (size_t)(l >> 1) * D * D; bf16* wos = (bf16*)(F.ws + WS_WOS);
    for (int it = F.gw; it < 3 * 256; it += F.NGW) { const int m = it / 256, q = it % 256;
        tr_item64(W, D, wos + (size_t)m * D * D, D, 64 * (q / 16), 64 * (q % 16), 64, scr, F.lane, RmId{}, mod_ptr(F, l, m) + 2 * D, on); }
}
__device__ __forceinline__ int2 moe_pos(const int4 ri, const int (&off)[NE]) { int p0 = 0, p1 = 0;
#pragma unroll
    for (int e = 0; e < NE; ++e) { if (ri.x == e) p0 = off[e] + ri.y; if (ri.z == e) p1 = off[e] + ri.w; }
    return make_int2(p0, p1); }
__device__ __forceinline__ void moe_load_rows(const Frame& F, int2 pos, u32x2 (&y0)[4], u32x2 (&y1)[4]) {
    const bf16* ys = (const bf16*)(F.ws + A_YS);
#pragma unroll
    for (int j = 0; j < 4; ++j) { const int c = 4 * F.lane + 256 * j; y0[j] = *(const u32x2*)(ys + (size_t)pos.x * D + c); y1[j] = *(const u32x2*)(ys + (size_t)pos.y * D + c); }
}
__device__ __forceinline__ void moe_combine_row(const Frame& F, int lp, int r, f32x4 (&v)[4], float cs, const u32x2 (&y0a)[4], const u32x2 (&y1a)[4], f32x2 w) {
    const float* g2 = mod_ptr(F, lp, r < TL ? r / S : 2) + 5 * D;
#pragma unroll
    for (int j = 0; j < 4; ++j) { const int c = 4 * F.lane + 256 * j; const u32x2 y0 = y0a[j], y1 = y1a[j]; const f32x4 g = *(const f32x4*)(g2 + c) * cs;
        v[j].x += g.x * (w.x * bflo(y0.x) + w.y * bflo(y1.x)); v[j].y += g.y * (w.x * bfhi(y0.x) + w.y * bfhi(y1.x));
        v[j].z += g.z * (w.x * bflo(y0.y) + w.y * bflo(y1.y)); v[j].w += g.w * (w.x * bfhi(y0.y) + w.y * bfhi(y1.y)); }
}
__device__ __forceinline__ float row_rstd(const f32x4 (&v)[4]) {
    float s = 0.f;
#pragma unroll
    for (int j = 0; j < 4; ++j) s += (v[j].x * v[j].x + v[j].y * v[j].y) + (v[j].z * v[j].z + v[j].w * v[j].w);
    return 1.f / sqrtf(wave_sum(s) * (1.f / D) + EPS);
}
__device__ __forceinline__ void modulate_row(const Frame& F, int l, int which, int r, const f32x4 (&v)[4], float rstd, f32x4 (&h)[4]) {
    const float* gn = inp(F, I_NORMG) + ((size_t)l * 2 + which) * D; const float* mp = mod_ptr(F, l, r < TL ? r / S : 2) + (which ? 3 : 0) * D;
#pragma unroll
    for (int j = 0; j < 4; ++j) { const int c = 4 * F.lane + 256 * j; const f32x4 g = *(const f32x4*)(gn + c), sh = *(const f32x4*)(mp + c), sc = *(const f32x4*)(mp + D + c);
        h[j] = v[j] * rstd * g * (sc + 1.f) + sh; }
}
__device__ __forceinline__ void store_row_bf16(bf16* dst, int lane, const f32x4 (&h)[4]) {
#pragma unroll
    for (int j = 0; j < 4; ++j) *(u32x2*)(dst + 4 * lane + 256 * j) = (u32x2){pk2(h[j].x, h[j].y), pk2(h[j].z, h[j].w)};
}
struct ModCache { f32x4 gs[4], sh[4], g2[4]; int m; };
__device__ __forceinline__ void modc_load(const Frame& F, ModCache& c, int l, int which, int lp, bool comb, float cs, int m) {
    const float* gn = inp(F, I_NORMG) + ((size_t)l * 2 + which) * D; const float* mp = mod_ptr(F, l, m) + (which ? 3 : 0) * D; const float* g2 = mod_ptr(F, comb ? lp : 0, m) + 5 * D;
#pragma unroll
    for (int j = 0; j < 4; ++j) { const int col = 4 * F.lane + 256 * j; const f32x4 g = *(const f32x4*)(gn + col), sc = *(const f32x4*)(mp + D + col);
        c.gs[j] = g * (sc + 1.f); c.sh[j] = *(const f32x4*)(mp + col); c.g2[j] = comb ? *(const f32x4*)(g2 + col) * cs : (f32x4){0.f, 0.f, 0.f, 0.f}; }
    c.m = m;
}
__device__ __forceinline__ void combine_c(const ModCache& c, f32x4 (&v)[4], const u32x2 (&y0a)[4], const u32x2 (&y1a)[4], f32x2 w) {
#pragma unroll
    for (int j = 0; j < 4; ++j) { const u32x2 y0 = y0a[j], y1 = y1a[j]; const f32x4 g = c.g2[j];
        v[j].x += g.x * (w.x * bflo(y0.x) + w.y * bflo(y1.x)); v[j].y += g.y * (w.x * bfhi(y0.x) + w.y * bfhi(y1.x));
        v[j].z += g.z * (w.x * bflo(y0.y) + w.y * bflo(y1.y)); v[j].w += g.w * (w.x * bfhi(y0.y) + w.y * bfhi(y1.y)); }
}
__device__ __forceinline__ void modulate_c(const ModCache& c, const f32x4 (&v)[4], float rstd, f32x4 (&h)[4]) {
#pragma unroll
    for (int j = 0; j < 4; ++j) h[j] = v[j] * rstd * c.gs[j] + c.sh[j];
}
template <bool FINAL> __device__ __forceinline__ void norm1_deep(Frame& F, int l, float cs, const int (&off)[NE], int lp) {
    constexpr int KD = 3;
    bf16* H = (bf16*)(F.ws + WS_H);
    const int4* rip = (const int4*)(F.ws + WS_ROUTE); const f32x2* wp = (const f32x2*)(F.ws + WS_ROUTE + 600 * 1024);
    u32x2 nb[KD][4], y0[KD][4], y1[KD][4]; int4 ri[KD]; f32x2 rwn[KD], wcur[KD];
#pragma unroll
    for (int s = 0; s < KD; ++s) { ri[s] = make_int4(0, 0, 0, 0); rwn[s] = (f32x2){0.f, 0.f}; wcur[s] = (f32x2){0.f, 0.f};
#pragma unroll
        for (int j = 0; j < 4; ++j) { nb[s][j] = (u32x2){0u, 0u}; y0[s][j] = (u32x2){0u, 0u}; y1[s][j] = (u32x2){0u, 0u}; } }
#define N1D_REC(s, r) do { const int r_ = (r); if (r_ < TL) { ri[s] = rip[r_]; rwn[s] = wp[r_]; } } while (0)
#define N1D_DATA(s, r) do { const int r_ = (r); if (r_ < TL) { const bf16* hs = hb_row(F, r_); \
        _Pragma("unroll") for (int j = 0; j < 4; ++j) nb[s][j] = *(const u32x2*)(hs + 4 * F.lane + 256 * j); \
        moe_load_rows(F, moe_pos(ri[s], off), y0[s], y1[s]); wcur[s] = rwn[s]; } } while (0)
#pragma unroll
    for (int s = 0; s < KD; ++s) N1D_REC(s, F.gw + s * F.NGW);
#pragma unroll
    for (int s = 0; s < KD; ++s) { N1D_DATA(s, F.gw + s * F.NGW); N1D_REC(s, F.gw + (s + KD) * F.NGW); }
    ModCache mc; mc.m = -1;
    for (int rb = F.gw; rb < TL; rb += KD * F.NGW) {
#pragma unroll
        for (int s = 0; s < KD; ++s) { const int r = rb + s * F.NGW;
            if (r < TL) {
                { const int m = r / S; if (m != mc.m) modc_load(F, mc, FINAL ? 3 : l, 0, lp, true, cs, m); }
                f32x4 v[4];
#pragma unroll
                for (int j = 0; j < 4; ++j) { const u32x2 t = nb[s][j]; v[j] = (f32x4){bflo(t.x), bfhi(t.x), bflo(t.y), bfhi(t.y)}; }
                if (STOP_AFTER >= (FINAL ? 8 : 2 * l)) combine_c(mc, v, y0[s], y1[s], wcur[s]);
                N1D_DATA(s, r + KD * F.NGW); N1D_REC(s, r + 2 * KD * F.NGW);
                if (FINAL) { float* xd = F.out + (size_t)r * D;
#pragma unroll
                    for (int j = 0; j < 4; ++j) *(f32x4*)(xd + 4 * F.lane + 256 * j) = v[j]; }
                else { store_row_bf16(hb_row(F, r), F.lane, v);
                    const float rstd = row_rstd(v); f32x4 h[4]; modulate_c(mc, v, rstd, h); store_row_bf16(H + (size_t)r * D, F.lane, h); }
            } }
    }
#undef N1D_REC
#undef N1D_DATA
}
template <bool FINAL> __device__ __forceinline__ void norm1_rows(Frame& F, int l, float cs) {
    bf16* H = (bf16*)(F.ws + WS_H);
    const int4* rip = (const int4*)(F.ws + WS_ROUTE); const f32x2* wp = (const f32x2*)(F.ws + WS_ROUTE + 600 * 1024);
    const int Tn = FINAL ? TL : T; const bool comb = FINAL || l > 0; const int lp = FINAL ? 3 : l - 1;
    int off[NE];
    if (comb) (void)moe_offsets(F, lp, off); else {
#pragma unroll
        for (int e = 0; e < NE; ++e) off[e] = 0; }
    int r0 = F.gw;
    if (comb) { norm1_deep<FINAL>(F, l, cs, off, lp); r0 = TL + F.gw; }
    f32x4 nv[4]; u32x2 nb[4]; u32x2 ny0[4], ny1[4]; f32x2 nw = {0.f, 0.f}; int4 nri = make_int4(0, 0, 0, 0); f32x2 nnw = {0.f, 0.f};
#pragma unroll
    for (int j = 0; j < 4; ++j) { nv[j] = (f32x4){0.f, 0.f, 0.f, 0.f}; nb[j] = (u32x2){0u, 0u}; ny0[j] = (u32x2){0u, 0u}; ny1[j] = (u32x2){0u, 0u}; }
    auto isbf = [&](int r) -> bool { return FINAL || (l > 0 && r < TL); };
    auto xload = [&](int r) { if (isbf(r)) { const bf16* hs = hb_row(F, r);
#pragma unroll
            for (int j = 0; j < 4; ++j) nb[j] = *(const u32x2*)(hs + 4 * F.lane + 256 * j); }
        else { const float* xs = xsrc_row(F, l, r);
#pragma unroll
            for (int j = 0; j < 4; ++j) nv[j] = *(const f32x4*)(xs + 4 * F.lane + 256 * j); } };
    if (r0 < Tn) { xload(r0);
        if (comb) { const int4 ri = rip[r0]; nw = wp[r0]; moe_load_rows(F, moe_pos(ri, off), ny0, ny1); if (r0 + F.NGW < Tn) { nri = rip[r0 + F.NGW]; nnw = wp[r0 + F.NGW]; } } }
    ModCache mc; mc.m = -1;
    for (int r = r0; r < Tn; r += F.NGW) {
        { const int m = r < TL ? r / S : 2; if (m != mc.m) modc_load(F, mc, FINAL ? 3 : l, 0, lp, comb, cs, m); }
        f32x4 v[4]; u32x2 y0[4], y1[4]; const f32x2 w = nw;
        if (isbf(r)) {
#pragma unroll
            for (int j = 0; j < 4; ++j) { const u32x2 t = nb[j]; v[j] = (f32x4){bflo(t.x), bfhi(t.x), bflo(t.y), bfhi(t.y)}; } }
        else {
#pragma unroll
            for (int j = 0; j < 4; ++j) v[j] = nv[j]; }
#pragma unroll
        for (int j = 0; j < 4; ++j) { y0[j] = ny0[j]; y1[j] = ny1[j]; }
        const int rn = r + F.NGW;
        if (rn < Tn) { xload(rn);
            if (comb) { moe_load_rows(F, moe_pos(nri, off), ny0, ny1); nw = nnw; if (rn + F.NGW < Tn) { nri = rip[rn + F.NGW]; nnw = wp[rn + F.NGW]; } } }
        if (comb) { if (STOP_AFTER >= (FINAL ? 8 : 2 * l)) combine_c(mc, v, y0, y1, w);
            if (FINAL) { float* xd = F.out + (size_t)r * D;
#pragma unroll
                for (int j = 0; j < 4; ++j) *(f32x4*)(xd + 4 * F.lane + 256 * j) = v[j]; }
            else if (r < TL) store_row_bf16(hb_row(F, r), F.lane, v);
            else { float* xd = xdst_row(F, r);
#pragma unroll
                for (int j = 0; j < 4; ++j) *(f32x4*)(xd + 4 * F.lane + 256 * j) = v[j]; } }
        else if (r < TL) store_row_bf16(hb_row(F, r), F.lane, v);
        if (!FINAL) { const float rstd = row_rstd(v); f32x4 h[4]; modulate_c(mc, v, rstd, h); store_row_bf16(H + (size_t)r * D, F.lane, h); }
    }
}
__device__ __forceinline__ void phase_norm1(Frame& F, int l, float cs = 1.f) { norm1_rows<false>(F, l, cs); }
__device__ __forceinline__ void phase_final(Frame& F, float cs = 1.f) { norm1_rows<true>(F, 3, cs); }

__device__ __forceinline__ void phase_norm2_route(Frame& F, int l, bool dry = false) {
    bf16* H = (bf16*)(F.ws + WS_H);
    LAS float* rw = (LAS float*)F.lds;
    for (int i = F.tid; i < D * NE; i += NTHR) { const int k = i / NE, e = i % NE; rw[e * D + k] = inp(F, I_RW)[i]; }
    LAS unsigned* lcnt = (LAS unsigned*)(F.lds + 65536);
    if (F.tid < 32) lcnt[F.tid] = 0u;
    __syncthreads();
    const int Tm = (l < DEPTH - 1) ? T : TL;
    unsigned* cnt = cnt_ptr(F, l);
    int4* route_i = (int4*)(F.ws + WS_ROUTE); f32x2* route_w = (f32x2*)(F.ws + WS_ROUTE + 600 * 1024);
    f32x4 nv[4]; u32x2 nb[4];
#pragma unroll
    for (int j = 0; j < 4; ++j) { nv[j] = (f32x4){0.f, 0.f, 0.f, 0.f}; nb[j] = (u32x2){0u, 0u}; }
    auto xload = [&](int r) { if (r < TL) { const bf16* hs = hb_row(F, r);
#pragma unroll
            for (int j = 0; j < 4; ++j) nb[j] = *(const u32x2*)(hs + 4 * F.lane + 256 * j); }
        else { const float* xs = xdst_row(F, r);
#pragma unroll
            for (int j = 0; j < 4; ++j) nv[j] = *(const f32x4*)(xs + 4 * F.lane + 256 * j); } };
    if (F.gw < Tm) xload(F.gw);
    ModCache mc; mc.m = -1;
    float st[NE]; int idx = 0;
#pragma unroll
    for (int e = 0; e < NE; ++e) st[e] = 0.f;
    for (int r = F.gw; r < Tm; r += F.NGW) {
        { const int m = r < TL ? r / S : 2; if (m != mc.m) modc_load(F, mc, l, 1, 0, false, 0.f, m); }
        f32x4 v[4];
        if (r < TL) {
#pragma unroll
            for (int j = 0; j < 4; ++j) { const u32x2 t = nb[j]; v[j] = (f32x4){bflo(t.x), bfhi(t.x), bflo(t.y), bfhi(t.y)}; } }
        else {
#pragma unroll
            for (int j = 0; j < 4; ++j) v[j] = nv[j]; }
        if (r + F.NGW < Tm) xload(r + F.NGW);
        const float rstd = row_rstd(v); f32x4 h[4]; modulate_c(mc, v, rstd, h);
        store_row_bf16(H + (size_t)r * D, F.lane, h);
        const bool mine = (F.lane == idx);
#pragma unroll
        for (int e = 0; e < NE; ++e) { float s = 0.f; if ((e & 1) == 0) asm volatile("" ::: "memory");
            f32x2 a0 = {0.f, 0.f}, a1 = {0.f, 0.f};
#pragma unroll
            for (int j = 0; j < 4; ++j) { const f32x4 w = *(const LAS f32x4*)(rw + e * D + 4 * F.lane + 256 * j);
                a0 = (f32x2){h[j].x, h[j].y} * (f32x2){w.x, w.y} + a0; a1 = (f32x2){h[j].z, h[j].w} * (f32x2){w.z, w.w} + a1; }
            { const f32x2 a = a0 + a1; s = a.x + a.y; }
            const float lge = wave_sum(s); st[e] = mine ? lge : st[e]; }
        ++idx;
    }
    const int nrows = idx, myr = F.gw + F.lane * F.NGW; const bool act = (F.lane < nrows) && !dry;
    int e0, e1, r0 = 0, r1 = 0; float wn0, wn1;
    {
        float sc[NE], bi[NE];
#pragma unroll
        for (int e = 0; e < NE; ++e) { sc[e] = 1.f / (1.f + expf(-st[e])); bi[e] = sc[e] + inp(F, I_RB)[e]; }
        int sel = 0; float best = -INFINITY;
#pragma unroll
        for (int g = 0; g < 4; ++g) { float m1 = -INFINITY, m2 = -INFINITY;
#pragma unroll
            for (int i = 0; i < 4; ++i) { const float b = bi[4 * g + i]; if (b > m1) { m2 = m1; m1 = b; } else if (b > m2) m2 = b; }
            const float gs = m1 + m2; if (gs > best) { best = gs; sel = g; } }
        float b4[4], s4[4];
#pragma unroll
        for (int i = 0; i < 4; ++i) { b4[i] = bi[0 + i]; s4[i] = sc[0 + i]; }
#pragma unroll
        for (int g = 1; g < 4; ++g) if (sel == g) {
#pragma unroll
            for (int i = 0; i < 4; ++i) { b4[i] = bi[4 * g + i]; s4[i] = sc[4 * g + i]; } }
        int i0 = 0; float v0 = b4[0], w0 = s4[0];
#pragma unroll
        for (int i = 1; i < 4; ++i) if (b4[i] > v0) { v0 = b4[i]; w0 = s4[i]; i0 = i; }
        int i1 = 0; float v1 = -INFINITY, w1 = 0.f;
#pragma unroll
        for (int i = 0; i < 4; ++i) if (i != i0 && b4[i] > v1) { v1 = b4[i]; w1 = s4[i]; i1 = i; }
        const float ws_ = 1.f / (w0 + w1);
        e0 = 4 * sel + i0; e1 = 4 * sel + i1; wn0 = w0 * ws_; wn1 = w1 * ws_;
    }
    if (act) { r0 = (int)__hip_atomic_fetch_add(lcnt + e0, 1u, __ATOMIC_RELAXED, __HIP_MEMORY_SCOPE_WORKGROUP); r1 = (int)__hip_atomic_fetch_add(lcnt + e1, 1u, __ATOMIC_RELAXED, __HIP_MEMORY_SCOPE_WORKGROUP); }
    __syncthreads();
    if (F.tid < NE && !dry) lcnt[NE + F.tid] = atomicAdd(&cnt[64 * F.tid], lcnt[F.tid]);
    __syncthreads();
    if (act) { int* list = (int*)(F.ws + WS_LIST); r0 += (int)lcnt[NE + e0]; r1 += (int)lcnt[NE + e1];
        route_i[myr] = make_int4(e0, r0, e1, r1); route_w[myr] = (f32x2){wn0, wn1};
        list[(size_t)e0 * T + r0] = myr; list[(size_t)e1 * T + r1] = myr; }
    __syncthreads();
}
__device__ __forceinline__ int moe_tile_table(Frame& F, int l) {
    int off[NE]; const int ntiles = moe_offsets(F, l, off);
    LAS i32x4* tab = (LAS i32x4*)(F.lds + 131072); const unsigned* cnt = cnt_ptr(F, l);
    __syncthreads();
    for (int t = F.tid; t < ntiles; t += NTHR) { int e = 0, o = 0;
#pragma unroll
        for (int k = 1; k < NE; ++k) if (t * 256 >= off[k]) { e = k; o = off[k]; }
        tab[t] = (i32x4){e, t * 256 - o, (int)__hip_atomic_load(cnt + 64 * e, __ATOMIC_RELAXED, __HIP_MEMORY_SCOPE_AGENT), 0}; }
    __syncthreads();
    return ntiles;
}

namespace att {
#define SBAR() __builtin_amdgcn_sched_barrier(0)
__device__ __forceinline__ int crow(int r, int hi) { return (r & 3) + 8 * (r >> 2) + 4 * hi; }
__device__ __forceinline__ unsigned cvtpk(float lo, float hi) { unsigned r; asm volatile("v_cvt_pk_bf16_f32 %0, %1, %2" : "=v"(r) : "v"(lo), "v"(hi)); return r; }
constexpr float THRL = 8.f;
__device__ __forceinline__ void partialSM(f32x16& p0, f32x16& p1, float& m_reg, float& alpha) {
    float pmax = p0[0];
#pragma unroll
    for (int r = 1; r < 16; ++r) pmax = fmaxf(pmax, p0[r]);
#pragma unroll
    for (int r = 0; r < 16; ++r) pmax = fmaxf(pmax, p1[r]);
    { auto rr = __builtin_amdgcn_permlane32_swap(__float_as_uint(pmax), __float_as_uint(pmax), false, false); pmax = fmaxf(__uint_as_float(rr[0]), __uint_as_float(rr[1])); }
    float mn;
    if (__builtin_expect(__all(pmax - m_reg <= THRL), 1)) { mn = m_reg; alpha = 1.f; }
    else { mn = fmaxf(m_reg, pmax); alpha = __builtin_amdgcn_exp2f(m_reg - mn); m_reg = mn; }
#pragma unroll
    for (int r = 0; r < 16; ++r) p0[r] = __builtin_amdgcn_exp2f(p0[r] - mn);
#pragma unroll
    for (int r = 0; r < 16; ++r) p1[r] = p1[r] - mn;
}
__device__ __forceinline__ void finishSM(f32x16& p0, f32x16& p1, float alpha, float& l_reg, bf16x8& pa0, bf16x8& pa1, bf16x8& pa2, bf16x8& pa3) {
#pragma unroll
    for (int r = 0; r < 16; ++r) p1[r] = __builtin_amdgcn_exp2f(p1[r]);
    float ps = 0;
#pragma unroll
    for (int r = 0; r < 16; ++r) ps += p0[r];
#pragma unroll
    for (int r = 0; r < 16; ++r) ps += p1[r];
    { auto rr = __builtin_amdgcn_permlane32_swap(__float_as_uint(ps), __float_as_uint(ps), false, false); ps = __uint_as_float(rr[0]) + __uint_as_float(rr[1]); }
    l_reg = l_reg * alpha + ps;
#define PK4(P, BASE, OUT) do { unsigned a0 = cvtpk(P[BASE + 0], P[BASE + 1]), a1 = cvtpk(P[BASE + 2], P[BASE + 3]);   \
    unsigned b0 = cvtpk(P[BASE + 4], P[BASE + 5]), b1 = cvtpk(P[BASE + 6], P[BASE + 7]);                              \
    auto r0 = __builtin_amdgcn_permlane32_swap(a0, b0, false, false); auto r1 = __builtin_amdgcn_permlane32_swap(a1, b1, false, false); \
    u32x4 w = {r0[0], r1[0], r0[1], r1[1]}; OUT = *reinterpret_cast<bf16x8*>(&w); } while (0)
    PK4(p0, 0, pa0); PK4(p0, 8, pa1); PK4(p1, 0, pa2); PK4(p1, 8, pa3);
#undef PK4
}
template <int DK> __device__ __forceinline__ void qkt(f32x16& p0, f32x16& p1, const LAS char* Ks, const bf16x8* qr, int r32, int hi) {
    constexpr int KS = 2 * DK + 16;
    p0 = f32x16{}; p1 = f32x16{};
#pragma unroll
    for (int d0 = 0; d0 < DK / 16; ++d0) { const int cb = (d0 * 16 + hi * 8) * 2;
        const bf16x8 b0 = *(const LAS bf16x8*)(Ks + r32 * KS + cb);
        const bf16x8 b1 = *(const LAS bf16x8*)(Ks + (32 + r32) * KS + cb);
        p0 = __builtin_amdgcn_mfma_f32_32x32x16_bf16(b0, qr[d0], p0, 0, 0, 0);
        p1 = __builtin_amdgcn_mfma_f32_32x32x16_bf16(b1, qr[d0], p1, 0, 0, 0); }
}
__device__ __forceinline__ int v_st(int k, int c) { const int kk = (k & ~0xC) | ((k & 4) << 1) | ((k & 8) >> 1); return ((kk >> 3) * 2 + (c >> 5)) * 512 + ((kk & 7) * 32 + (c & 31)) * 2; }
__device__ __forceinline__ int v_rd_base(int lane) { return ((lane & 3) << 3) | (((lane >> 2) & 3) << 6) | (((lane >> 4) & 1) << 5) | (((lane >> 5) & 1) << 8); }
constexpr int v_rd_off(int d0, int ks, int half) { return d0 * 512 + ks * 2048 + half * 1024; }
template <int OFF> __device__ __forceinline__ s16x4 tr_read(int vb) { s16x4 r; asm volatile("ds_read_b64_tr_b16 %0, %1 offset:%2" : "=&v"(r) : "v"(vb), "i"(OFF) : "memory"); return r; }
template <int D0> __device__ __forceinline__ void pv_one(f32x16& od, int vb, bf16x8 pa0, bf16x8 pa1, bf16x8 pa2, bf16x8 pa3) {
    const s16x4 l0 = tr_read<v_rd_off(D0, 0, 0)>(vb), h0 = tr_read<v_rd_off(D0, 0, 1)>(vb), l1 = tr_read<v_rd_off(D0, 1, 0)>(vb), h1 = tr_read<v_rd_off(D0, 1, 1)>(vb);
    const s16x4 l2 = tr_read<v_rd_off(D0, 2, 0)>(vb), h2 = tr_read<v_rd_off(D0, 2, 1)>(vb), l3 = tr_read<v_rd_off(D0, 3, 0)>(vb), h3 = tr_read<v_rd_off(D0, 3, 1)>(vb);
    asm volatile("s_waitcnt lgkmcnt(0)" ::: "memory"); SBAR();
#define PK(L, H) (bf16x8){L[0], L[1], L[2], L[3], H[0], H[1], H[2], H[3]}
    od = __builtin_amdgcn_mfma_f32_32x32x16_bf16(pa0, PK(l0, h0), od, 0, 0, 0);
    od = __builtin_amdgcn_mfma_f32_32x32x16_bf16(pa1, PK(l1, h1), od, 0, 0, 0);
    od = __builtin_amdgcn_mfma_f32_32x32x16_bf16(pa2, PK(l2, h2), od, 0, 0, 0);
    od = __builtin_amdgcn_mfma_f32_32x32x16_bf16(pa3, PK(l3, h3), od, 0, 0, 0);
#undef PK
}
struct Unit {
    const bf16* Q; int ldq;
    const bf16* K; const bf16* V; int ldk;
    int nA, rowA, nB, rowB, rlo, rhi;
    int mask;
    int kb0, q0;
    float sink; int has_sink;
    bf16* O; int ldo;
    int qprep, qrope, qpos0; const float* qgain; const f32x2* ropet; float qc2;
};
template <int DK> __device__ __forceinline__ void attn_unit(const Unit& U, LAS char* lds, const int tid) {
    constexpr int KS = 2 * DK + 16, SHM_V = 8192, SHM_K = 64 * KS, NKP = DK / 8;
    const int wid = __builtin_amdgcn_readfirstlane(tid >> 6), lane = tid & 63, r32 = lane & 31, hi = lane >> 5;
    LAS char* V_lds = lds; LAS char* K_lds = lds + 2 * SHM_V;
    LAS float* ws = (LAS float*)(lds + 2 * SHM_V + 2 * SHM_K) + wid * 64; LAS float* li_l = ws; LAS float* al_l = ws + 32;
    float m_reg = -1e30f, l_reg = 0; f32x16 o[2] = {}; bf16x8 qr[DK / 16];
    const bf16* Qw = U.Q + (size_t)(wid * 32 + r32) * U.ldq + hi * 8;
#pragma unroll
    for (int d0 = 0; d0 < DK / 16; ++d0) qr[d0] = *(const bf16x8*)(Qw + d0 * 16);
    const int vkey = tid >> 3, vc = (tid & 7) * 8, vst = v_st(vkey, vc);
    const int k0key = tid / NKP, k0ch = tid % NKP, k1key = (512 + tid) / NKP, k1ch = (512 + tid) % NKP;
    const bool k1on = (DK == 96) && (tid < 256);
    const int vb0 = (int)(uintptr_t)V_lds + v_rd_base(lane);
    const int NT = U.nA + U.nB;
    auto tile_row = [&](int j) -> int { if (j < U.nA) return U.rowA + 64 * j; int r = U.rowB + 64 * (j - U.nA); r = r < U.rlo ? U.rlo : r; return r > U.rhi ? U.rhi : r; };
    struct Slot { bf16x8 v, k0, k1; };
    Slot sE, sO;
#define SLOAD(sl, j) do { const int _row = tile_row(j); sl.v = *(const bf16x8*)(U.V + (size_t)(_row + vkey) * U.ldk + vc); sl.k0 = *(const bf16x8*)(U.K + (size_t)(_row + k0key) * U.ldk + k0ch * 8); \
        if (k1on) sl.k1 = *(const bf16x8*)(U.K + (size_t)(_row + k1key) * U.ldk + k1ch * 8); } while (0)
#define SWRITE(b, sl) do { *(LAS bf16x8*)(V_lds + (b) * SHM_V + vst) = sl.v; *(LAS bf16x8*)(K_lds + (b) * SHM_K + k0key * KS + k0ch * 16) = sl.k0; \
        if (k1on) *(LAS bf16x8*)(K_lds + (b) * SHM_K + k1key * KS + k1ch * 16) = sl.k1; } while (0)
#define RESC(a) do { if (__any((a) < 1.f)) { if (hi == 0) al_l[r32] = (a); asm volatile("s_waitcnt lgkmcnt(0)" ::: "memory"); \
        _Pragma("unroll") for (int d = 0; d < 2; ++d) _Pragma("unroll") for (int r = 0; r < 16; ++r) o[d][r] *= al_l[crow(r, hi)]; } } while (0)
#define MASK(P0, P1, j) do { if (U.mask && (j) >= U.nA) { const int kb = U.kb0 + 64 * ((j) - U.nA), dq = wid * 32 + r32; \
        _Pragma("unroll") for (int r = 0; r < 16; ++r) { const int k0_ = kb + crow(r, hi), k1_ = k0_ + 32; \
            const bool ok0 = (k0_ - dq <= 128) && (dq - k0_ <= 128) && ((unsigned)(U.q0 + k0_) < (unsigned)S); \
            const bool ok1 = (k1_ - dq <= 128) && (dq - k1_ <= 128) && ((unsigned)(U.q0 + k1_) < (unsigned)S); \
            P0[r] = ok0 ? P0[r] : -INFINITY; P1[r] = ok1 ? P1[r] : -INFINITY; } } } while (0)
    f32x16 pA0, pA1, pB0, pB1; float alA, alB; bf16x8 pa0, pa1, pa2, pa3;
    __syncthreads();
    SLOAD(sE, 0); SWRITE(0, sE); __syncthreads();
    qkt<DK>(pA0, pA1, K_lds, qr, r32, hi); MASK(pA0, pA1, 0); partialSM(pA0, pA1, m_reg, alA);
    SLOAD(sO, 1); if (2 < NT) SLOAD(sE, 2);
    SWRITE(1, sO); __syncthreads();
    for (int j = 1; j + 1 < NT; j += 2) {
        SBAR(); qkt<DK>(pB0, pB1, K_lds + SHM_K, qr, r32, hi); MASK(pB0, pB1, j);
        finishSM(pA0, pA1, alA, l_reg, pa0, pa1, pa2, pa3); SBAR();
        SLOAD(sO, j + 2); SBAR();
        pv_one<0>(o[0], vb0, pa0, pa1, pa2, pa3); pv_one<1>(o[1], vb0, pa0, pa1, pa2, pa3); partialSM(pB0, pB1, m_reg, alB);
        __syncthreads(); SWRITE(0, sE);
        RESC(alB); __syncthreads();
        SBAR(); qkt<DK>(pA0, pA1, K_lds, qr, r32, hi); MASK(pA0, pA1, j + 1);
        finishSM(pB0, pB1, alB, l_reg, pa0, pa1, pa2, pa3); SBAR();
        if (j + 3 < NT) SLOAD(sE, j + 3); SBAR();
        pv_one<0>(o[0], vb0 + SHM_V, pa0, pa1, pa2, pa3); pv_one<1>(o[1], vb0 + SHM_V, pa0, pa1, pa2, pa3); partialSM(pA0, pA1, m_reg, alA);
        __syncthreads(); SWRITE(1, sO);
        RESC(alA); __syncthreads();
    }
    SBAR(); qkt<DK>(pB0, pB1, K_lds + SHM_K, qr, r32, hi); MASK(pB0, pB1, NT - 1);
    finishSM(pA0, pA1, alA, l_reg, pa0, pa1, pa2, pa3); SBAR();
    pv_one<0>(o[0], vb0, pa0, pa1, pa2, pa3); pv_one<1>(o[1], vb0, pa0, pa1, pa2, pa3); partialSM(pB0, pB1, m_reg, alB);
    __syncthreads(); RESC(alB);
    finishSM(pB0, pB1, alB, l_reg, pa0, pa1, pa2, pa3); SBAR();
    pv_one<0>(o[0], vb0 + SHM_V, pa0, pa1, pa2, pa3); pv_one<1>(o[1], vb0 + SHM_V, pa0, pa1, pa2, pa3);
    if (U.has_sink) l_reg += __builtin_amdgcn_exp2f(U.sink * LOG2E - m_reg);
    if (hi == 0) li_l[r32] = l_reg; asm volatile("s_waitcnt lgkmcnt(0)" ::: "memory");
    float rli[16];
#pragma unroll
    for (int r = 0; r < 16; ++r) rli[r] = __builtin_amdgcn_rcpf(li_l[crow(r, hi)]);
    bf16* Ow = U.O + (size_t)(wid * 32) * U.ldo;
#pragma unroll
    for (int r = 0; r < 16; ++r) { const int orow = crow(r, hi);
#pragma unroll
        for (int d0 = 0; d0 < 2; ++d0) Ow[(size_t)orow * U.ldo + d0 * 32 + r32] = (bf16)f2bf(o[d0][r] * rli[r]); }
#undef SLOAD
#undef SWRITE
#undef RESC
#undef MASK
}

__device__ __forceinline__ void partialF(f32x16& p0) {
#pragma unroll
    for (int r = 0; r < 16; ++r) p0[r] = __builtin_amdgcn_exp2f(p0[r]);
}
__device__ __forceinline__ void finishF(f32x16& p0, f32x16& p1, float& lsum, bf16x8& pa0, bf16x8& pa1, bf16x8& pa2, bf16x8& pa3) {
#pragma unroll
    for (int r = 0; r < 16; ++r) p1[r] = __builtin_amdgcn_exp2f(p1[r]);
    { const f32x16 s16 = p0 + p1;
      const float a0 = (s16[0] + s16[1]) + (s16[2] + s16[3]), a1 = (s16[4] + s16[5]) + (s16[6] + s16[7]), a2 = (s16[8] + s16[9]) + (s16[10] + s16[11]), a3 = (s16[12] + s16[13]) + (s16[14] + s16[15]);
      lsum += (a0 + a1) + (a2 + a3); }
#define PK4(P, BASE, OUT) do { unsigned a0 = cvtpk(P[BASE + 0], P[BASE + 1]), a1 = cvtpk(P[BASE + 2], P[BASE + 3]);   \
    unsigned b0 = cvtpk(P[BASE + 4], P[BASE + 5]), b1 = cvtpk(P[BASE + 6], P[BASE + 7]);                              \
    auto r0 = __builtin_amdgcn_permlane32_swap(a0, b0, false, false); auto r1 = __builtin_amdgcn_permlane32_swap(a1, b1, false, false); \
    u32x4 w = {r0[0], r1[0], r0[1], r1[1]}; OUT = *reinterpret_cast<bf16x8*>(&w); } while (0)
    PK4(p0, 0, pa0); PK4(p0, 8, pa1); PK4(p1, 0, pa2); PK4(p1, 8, pa3);
#undef PK4
}
__device__ __forceinline__ void finishF_ns(f32x16& p0, f32x16& p1, f32x2& lacc, bf16x8& pa0, bf16x8& pa1, bf16x8& pa2, bf16x8& pa3) {
#pragma unroll
    for (int r = 0; r < 16; ++r) p1[r] = __builtin_amdgcn_exp2f(p1[r]);
    { const f32x16 s16 = p0 + p1; const f32x8 s8 = s16.lo + s16.hi; const f32x4 s4 = s8.lo + s8.hi; lacc += s4.lo + s4.hi; }
#define PK4N(P, BASE, OUT) do { const u32x4 w = {cvtpk(P[BASE + 0], P[BASE + 1]), cvtpk(P[BASE + 2], P[BASE + 3]), cvtpk(P[BASE + 4], P[BASE + 5]), cvtpk(P[BASE + 6], P[BASE + 7])}; OUT = __builtin_bit_cast(bf16x8, w); } while (0)
    PK4N(p0, 0, pa0); PK4N(p0, 8, pa1); PK4N(p1, 0, pa2); PK4N(p1, 8, pa3);
#undef PK4N
}
template <int DK> __device__ __forceinline__ void qkt_c(f32x16& p0, f32x16& p1, const LAS char* Ks, const bf16x8* qr, const f32x16& cinit, int r32, int hi) {
    constexpr int KS = 2 * DK + 16;
    bf16x8 kf[DK / 8];
#pragma unroll
    for (int d0 = 0; d0 < DK / 16; ++d0) { const int cb = (d0 * 16 + hi * 8) * 2;
        kf[2 * d0] = *(const LAS bf16x8*)(Ks + r32 * KS + cb); kf[2 * d0 + 1] = *(const LAS bf16x8*)(Ks + (32 + r32) * KS + cb); }
    SBAR();
#pragma unroll
    for (int d0 = 0; d0 < DK / 16; ++d0) {
        p0 = __builtin_amdgcn_mfma_f32_32x32x16_bf16(kf[2 * d0], qr[d0], d0 == 0 ? cinit : p0, 0, 0, 0);
        p1 = __builtin_amdgcn_mfma_f32_32x32x16_bf16(kf[2 * d0 + 1], qr[d0], d0 == 0 ? cinit : p1, 0, 0, 0); }
}
template <int DK> __device__ __forceinline__ void attn_unit_fm(const Unit& U, float Mref, LAS char* lds, const int tid) {
    constexpr int KS = 2 * DK + 16, SHM_V = 8192, SHM_K = 64 * KS, NKP = DK / 8;
    const int wid = __builtin_amdgcn_readfirstlane(tid >> 6), lane = tid & 63, r32 = lane & 31, hi = lane >> 5;
    LAS char* V_lds = lds; LAS char* K_lds = lds + 3 * SHM_V;
    LAS float* ws = (LAS float*)(lds + 3 * SHM_V + 2 * SHM_K) + wid * 64; LAS float* li_l = ws;
    float lsum = 0; f32x16 o[2] = {}; bf16x8 qr[DK / 16];
    const f32x16 cinit = {};
    const bf16* Qw = U.Q + (size_t)(wid * 32 + r32) * U.ldq + hi * 8;
#pragma unroll
    for (int d0 = 0; d0 < DK / 16; ++d0) qr[d0] = *(const bf16x8*)(Qw + d0 * 16);
    const int vkey = tid >> 3, vc = (tid & 7) * 8, vst = v_st(vkey, vc);
    const int k0key = tid / NKP, k0ch = tid % NKP, k1key = (512 + tid) / NKP, k1ch = (512 + tid) % NKP;
    const bool k1on = (DK == 96) && (tid < 256);
    const int vb0 = (int)(uintptr_t)V_lds + v_rd_base(lane);
    const int NT = U.nA + U.nB;
    auto tile_row = [&](int j) -> int { if (j < U.nA) return U.rowA + 64 * j; int r = U.rowB + 64 * (j - U.nA); r = r < U.rlo ? U.rlo : r; return r > U.rhi ? U.rhi : r; };
    struct Slot { bf16x8 v, k0, k1; };
    Slot s0, s1;
#define SLOAD(sl, j) do { const int _row = tile_row(j); sl.v = *(const bf16x8*)(U.V + (size_t)(_row + vkey) * U.ldk + vc); sl.k0 = *(const bf16x8*)(U.K + (size_t)(_row + k0key) * U.ldk + k0ch * 8); \
        if (k1on) sl.k1 = *(const bf16x8*)(U.K + (size_t)(_row + k1key) * U.ldk + k1ch * 8); } while (0)
#define SWRITE(kb, vbuf, sl) do { *(LAS bf16x8*)(V_lds + (vbuf) * SHM_V + vst) = sl.v; *(LAS bf16x8*)(K_lds + (kb) * SHM_K + k0key * KS + k0ch * 16) = sl.k0; \
        if (k1on) *(LAS bf16x8*)(K_lds + (kb) * SHM_K + k1key * KS + k1ch * 16) = sl.k1; } while (0)
#define MASK(P0, P1, j) do { if (U.mask && (j) >= U.nA) { const int kb = U.kb0 + 64 * ((j) - U.nA), dq = wid * 32 + r32; \
        _Pragma("unroll") for (int r = 0; r < 16; ++r) { const int k0_ = kb + crow(r, hi), k1_ = k0_ + 32; \
            const bool ok0 = (k0_ - dq <= 128) && (dq - k0_ <= 128) && ((unsigned)(U.q0 + k0_) < (unsigned)S); \
            const bool ok1 = (k1_ - dq <= 128) && (dq - k1_ <= 128) && ((unsigned)(U.q0 + k1_) < (unsigned)S); \
            P0[r] = ok0 ? P0[r] : -INFINITY; P1[r] = ok1 ? P1[r] : -INFINITY; } } } while (0)
    f32x16 pA0, pA1, pB0, pB1; bf16x8 pa0, pa1, pa2, pa3;
    __syncthreads();
    SLOAD(s0, 0); SLOAD(s1, 1);
    SWRITE(0, 0, s0); if (2 < NT) SLOAD(s0, 2);
    SWRITE(1, 1, s1); if (3 < NT) SLOAD(s1, 3);
    __syncthreads();
    qkt_c<DK>(pA0, pA1, K_lds, qr, cinit, r32, hi); MASK(pA0, pA1, 0); partialF(pA0);
    int vcur = 0;
    for (int t = 0; t < NT; t += 2) {
        __syncthreads();
        SBAR(); qkt_c<DK>(pB0, pB1, K_lds + SHM_K, qr, cinit, r32, hi); MASK(pB0, pB1, t + 1);
        finishF(pA0, pA1, lsum, pa0, pa1, pa2, pa3); SBAR();
        { const int vb = vb0 + vcur * SHM_V; pv_one<0>(o[0], vb, pa0, pa1, pa2, pa3); pv_one<1>(o[1], vb, pa0, pa1, pa2, pa3); } partialF(pB0);
        { const int v2 = vcur == 0 ? 2 : vcur - 1;
          if (t + 2 < NT) { SWRITE(0, v2, s0); if (t + 4 < NT) SLOAD(s0, t + 4); } }
        vcur = vcur == 2 ? 0 : vcur + 1;
        __syncthreads();
        SBAR(); if (t + 2 < NT) { qkt_c<DK>(pA0, pA1, K_lds, qr, cinit, r32, hi); MASK(pA0, pA1, t + 2); }
        finishF(pB0, pB1, lsum, pa0, pa1, pa2, pa3); SBAR();
        { const int vb = vb0 + vcur * SHM_V; pv_one<0>(o[0], vb, pa0, pa1, pa2, pa3); pv_one<1>(o[1], vb, pa0, pa1, pa2, pa3); } if (t + 2 < NT) partialF(pA0);
        { const int v2 = vcur == 0 ? 2 : vcur - 1;
          if (t + 3 < NT) { SWRITE(1, v2, s1); if (t + 5 < NT) SLOAD(s1, t + 5); } }
        vcur = vcur == 2 ? 0 : vcur + 1;
    }
    { auto rr = __builtin_amdgcn_permlane32_swap(__float_as_uint(lsum), __float_as_uint(lsum), false, false); lsum = __uint_as_float(rr[0]) + __uint_as_float(rr[1]); }
    if (U.has_sink) lsum += __builtin_amdgcn_exp2f(U.sink * LOG2E);
    if (hi == 0) li_l[r32] = lsum; asm volatile("s_waitcnt lgkmcnt(0)" ::: "memory");
    float rli[16];
#pragma unroll
    for (int r = 0; r < 16; ++r) rli[r] = __builtin_amdgcn_rcpf(li_l[crow(r, hi)]);
    bf16* Ow = U.O + (size_t)(wid * 32) * U.ldo;
#pragma unroll
    for (int r = 0; r < 16; ++r) { const int orow = crow(r, hi);
#pragma unroll
        for (int d0 = 0; d0 < 2; ++d0) Ow[(size_t)orow * U.ldo + d0 * 32 + r32] = (bf16)f2bf(o[d0][r] * rli[r]); }
#undef SLOAD
#undef SWRITE
#undef MASK
}

template <int DK> __device__ __forceinline__ void prep_q(const Unit& U, bf16x8* qr, int wid, int r32, int hi) {
    if (U.qprep) {
        float v[DK / 16][8]; float ss = 0.f;
#pragma unroll
        for (int d0 = 0; d0 < DK / 16; ++d0) { const u32x4 w = __builtin_bit_cast(u32x4, qr[d0]);
            v[d0][0] = bflo(w.x); v[d0][1] = bfhi(w.x); v[d0][2] = bflo(w.y); v[d0][3] = bfhi(w.y); v[d0][4] = bflo(w.z); v[d0][5] = bfhi(w.z); v[d0][6] = bflo(w.w); v[d0][7] = bfhi(w.w);
#pragma unroll
            for (int j = 0; j < 8; ++j) ss += v[d0][j] * v[d0][j]; }
        ss += __shfl_xor(ss, 32);
        const float rs = U.qc2 / sqrtf(ss * (1.f / DK) + EPS);
#pragma unroll
        for (int d0 = 0; d0 < DK / 16; ++d0) { const f32x4 g0 = *(const f32x4*)(U.qgain + 16 * d0 + 8 * hi), g1 = *(const f32x4*)(U.qgain + 16 * d0 + 8 * hi + 4);
            v[d0][0] *= rs * g0.x; v[d0][1] *= rs * g0.y; v[d0][2] *= rs * g0.z; v[d0][3] *= rs * g0.w; v[d0][4] *= rs * g1.x; v[d0][5] *= rs * g1.y; v[d0][6] *= rs * g1.z; v[d0][7] *= rs * g1.w; }
        if (U.qrope) {
            constexpr int NA = DK == 64 ? 32 : 16, NP = DK == 64 ? 2 : 1, D1 = DK == 64 ? 0 : 4, DD = DK == 64 ? 2 : 1;
            const f32x2* cs = U.ropet + (size_t)(U.qpos0 + wid * 32 + r32) * NA + 8 * hi;
#pragma unroll
            for (int p = 0; p < NP; ++p)
#pragma unroll
                for (int j = 0; j < 8; ++j) { const f32x2 c = cs[16 * p + j]; const float x1 = v[D1 + p][j], x2 = v[D1 + p + DD][j]; v[D1 + p][j] = x1 * c.x - x2 * c.y; v[D1 + p + DD][j] = x2 * c.x + x1 * c.y; }
        }
#pragma unroll
        for (int d0 = 0; d0 < DK / 16; ++d0) { const u32x4 w = {pk2(v[d0][0], v[d0][1]), pk2(v[d0][2], v[d0][3]), pk2(v[d0][4], v[d0][5]), pk2(v[d0][6], v[d0][7])}; qr[d0] = __builtin_bit_cast(bf16x8, w); }
    }
}
__device__ __forceinline__ const bf16* rflp(const bf16* p) { const unsigned long long v = (unsigned long long)p; const unsigned lo = __builtin_amdgcn_readfirstlane((unsigned)v), hi = __builtin_amdgcn_readfirstlane((unsigned)(v >> 32)); return (const bf16*)(((unsigned long long)hi << 32) | lo); }
__device__ __forceinline__ void glds16(const void* gsrc, unsigned lds_dst) { unsigned keep;
    asm volatile("s_mov_b32 %0, m0\n\ts_mov_b32 m0, %2\n\ts_nop 0\n\tglobal_load_lds_dwordx4 %1, off\n\ts_mov_b32 m0, %0" : "=&s"(keep) : "v"(gsrc), "s"(lds_dst) : "memory"); }
#define WAIT_BAR(N) asm volatile("s_waitcnt vmcnt(" #N ") lgkmcnt(0)\n\ts_barrier" ::: "memory")
template <int DK> __device__ __forceinline__ void attn_unit_dma(const Unit& U, LAS char* lds, const int tid) {
    constexpr int KS = 2 * DK + 16, SHM_V = 8192, SHM_K = 64 * KS, NKP = DK / 8, NPK = SHM_K / 1024;
    static_assert(SHM_K % 1024 == 0, "K tile is a whole number of 1 KiB DMA pieces");
    const int wid = __builtin_amdgcn_readfirstlane(tid >> 6), lane = tid & 63, r32 = lane & 31, hi = lane >> 5;
    LAS char* V_lds = lds; LAS char* K_lds = lds + 4 * SHM_V;
    LAS float* ws = (LAS float*)(lds + 4 * SHM_V + 3 * SHM_K) + wid * 64; LAS float* li_l = ws;
    const unsigned lds0 = (unsigned)(uintptr_t)lds;
    f32x2 lacc = {0.f, 0.f}; f32x16 o[2] = {}; bf16x8 qr[DK / 16];
    const int nA_ = __builtin_amdgcn_readfirstlane(U.nA), NT = __builtin_amdgcn_readfirstlane(U.nA + U.nB), rowA_ = __builtin_amdgcn_readfirstlane(U.rowA), rowB_ = __builtin_amdgcn_readfirstlane(U.rowB);
    const int rlo_ = __builtin_amdgcn_readfirstlane(U.rlo), rhi_ = __builtin_amdgcn_readfirstlane(U.rhi), ldk_ = __builtin_amdgcn_readfirstlane(U.ldk);
    const bf16* Kp = rflp(U.K); const bf16* Vp = rflp(U.V);
    const f32x16 cinit = {};
    const bf16* Qw = U.Q + (size_t)(wid * 32 + r32) * U.ldq + hi * 8;
#pragma unroll
    for (int d0 = 0; d0 < DK / 16; ++d0) qr[d0] = *(const bf16x8*)(Qw + d0 * 16);
    const int kp1 = (wid + 8 < NPK) ? wid + 8 : wid;
    int koff0, koff1, voff;
    { const int b0 = wid * 1024 + lane * 16, r0 = b0 / KS, c0 = (b0 % KS) / 16; koff0 = r0 * U.ldk + (c0 < NKP ? c0 : 0) * 8;
      const int b1 = kp1 * 1024 + lane * 16, r1 = b1 / KS, c1 = (b1 % KS) / 16; koff1 = r1 * U.ldk + (c1 < NKP ? c1 : 0) * 8;
      const int i = wid * 64 + lane, sub = i >> 5, sl = i & 31, kk = (sub >> 1) * 8 + (sl >> 2), c = (sub & 1) * 32 + (sl & 3) * 8, key = kk;
      voff = key * U.ldk + c; }
    const unsigned kdst0 = lds0 + 4 * SHM_V + wid * 1024, kdst1 = lds0 + 4 * SHM_V + kp1 * 1024, vdst = lds0 + wid * 1024;
    const int vb0 = (int)lds0 + v_rd_base(lane);
    auto tile_row = [&](int j) -> int { j = j < NT ? j : NT - 1; if (j < nA_) return rowA_ + 64 * j; int r = rowB_ + 64 * (j - nA_); r = r < rlo_ ? rlo_ : r; return r > rhi_ ? rhi_ : r; };
#define DMA_TILE(j, kslot, vslot) do { const unsigned ro_ = (unsigned)(tile_row(j) * ldk_);     \
        glds16(Vp + (ro_ + (unsigned)voff), (unsigned)__builtin_amdgcn_readfirstlane(vdst + (vslot) * SHM_V)); \
        glds16(Kp + (ro_ + (unsigned)koff0), (unsigned)__builtin_amdgcn_readfirstlane(kdst0 + (kslot) * SHM_K)); \
        glds16(Kp + (ro_ + (unsigned)koff1), (unsigned)__builtin_amdgcn_readfirstlane(kdst1 + (kslot) * SHM_K)); } while (0)
    const int dq_ = wid * 32 + r32, klo_ = (dq_ - 128 > -U.q0) ? dq_ - 128 : -U.q0, khi_ = (dq_ + 128 < S - 1 - U.q0) ? dq_ + 128 : S - 1 - U.q0;
    const unsigned krange_ = (unsigned)(khi_ - klo_); const int kofs_ = U.kb0 - 64 * U.nA - klo_ + 4 * hi;
#define MASK(P0, P1, j) do { if (U.mask && (j) >= U.nA) { const int t_ = kofs_ + 64 * (j); \
        _Pragma("unroll") for (int r = 0; r < 16; ++r) { const unsigned u0_ = (unsigned)(t_ + (r & 3) + 8 * (r >> 2)), u1_ = u0_ + 32u; \
            P0[r] = u0_ <= krange_ ? P0[r] : -INFINITY; P1[r] = u1_ <= krange_ ? P1[r] : -INFINITY; } } } while (0)
    f32x16 pA0, pA1, pB0, pB1; bf16x8 pa0, pa1, pa2, pa3;
    asm volatile("s_waitcnt lgkmcnt(0)\n\ts_barrier" ::: "memory");
    DMA_TILE(0, 0, 0); DMA_TILE(1, 1, 1); DMA_TILE(2, 2, 2);
    prep_q<DK>(U, qr, wid, r32, hi);
    WAIT_BAR(6);
    qkt_c<DK>(pA0, pA1, K_lds, qr, cinit, r32, hi); MASK(pA0, pA1, 0); partialF(pA0);
    int kn = 1, vc = 0, k3 = 0, v3 = 3;
#define STEP_A(t_) do { WAIT_BAR(3); DMA_TILE((t_) + 3, k3, v3); \
        SBAR(); qkt_c<DK>(pB0, pB1, K_lds + kn * SHM_K, qr, cinit, r32, hi); MASK(pB0, pB1, (t_) + 1); \
        finishF_ns(pA0, pA1, lacc, pa0, pa1, pa2, pa3); SBAR(); \
        { const int vb = vb0 + vc * SHM_V; pv_one<0>(o[0], vb, pa0, pa1, pa2, pa3); pv_one<1>(o[1], vb, pa0, pa1, pa2, pa3); } partialF(pB0); \
        kn = kn == 2 ? 0 : kn + 1; vc = (vc + 1) & 3; k3 = k3 == 2 ? 0 : k3 + 1; v3 = (v3 + 1) & 3; } while (0)
#define STEP_B(t_, HAS_NEXT) do { WAIT_BAR(3); DMA_TILE((t_) + 4, k3, v3); \
        SBAR(); if (HAS_NEXT) { qkt_c<DK>(pA0, pA1, K_lds + kn * SHM_K, qr, cinit, r32, hi); MASK(pA0, pA1, (t_) + 2); } \
        finishF_ns(pB0, pB1, lacc, pa0, pa1, pa2, pa3); SBAR(); \
        { const int vb = vb0 + vc * SHM_V; pv_one<0>(o[0], vb, pa0, pa1, pa2, pa3); pv_one<1>(o[1], vb, pa0, pa1, pa2, pa3); } if (HAS_NEXT) partialF(pA0); \
        kn = kn == 2 ? 0 : kn + 1; vc = (vc + 1) & 3; k3 = k3 == 2 ? 0 : k3 + 1; v3 = (v3 + 1) & 3; } while (0)
    if (wid >= 4) asm volatile("s_setprio 1" ::: "memory");
    int t = 0;
    for (; t + 2 < NT; t += 2) { STEP_A(t); STEP_B(t, true); }
    STEP_A(t); STEP_B(t, false);
    asm volatile("s_setprio 0" ::: "memory");
#undef STEP_A
#undef STEP_B
    asm volatile("s_waitcnt vmcnt(0)" ::: "memory");
    float lsum = lacc.x + lacc.y;
    { auto rr = __builtin_amdgcn_permlane32_swap(__float_as_uint(lsum), __float_as_uint(lsum), false, false); lsum = __uint_as_float(rr[0]) + __uint_as_float(rr[1]); }
    if (U.has_sink) lsum += __builtin_amdgcn_exp2f(U.sink * LOG2E);
    if (hi == 0) li_l[r32] = lsum; asm volatile("s_waitcnt lgkmcnt(0)" ::: "memory");
    float rli[16];
#pragma unroll
    for (int r = 0; r < 16; ++r) rli[r] = __builtin_amdgcn_rcpf(li_l[crow(r, hi)]);
    bf16* Ow = U.O + (size_t)(wid * 32) * U.ldo;
#pragma unroll
    for (int r = 0; r < 16; ++r) { const int orow = crow(r, hi);
#pragma unroll
        for (int d0 = 0; d0 < 2; ++d0) Ow[(size_t)orow * U.ldo + d0 * 32 + r32] = (bf16)f2bf(o[d0][r] * rli[r]); }
#undef DMA_TILE
#undef MASK
}

template <int V> struct IC { static constexpr int v = V; };
template <int I, int N, class F> __device__ __forceinline__ void sfor(F&& f) { if constexpr (I < N) { f(IC<I>{}); sfor<I + 1, N>(f); } }
template <int OFF> __device__ __forceinline__ bf16x8 rd128(int a) { u32x4 r; asm volatile("ds_read_b128 %0, %1 offset:%2" : "=&v"(r) : "v"(a), "i"(OFF) : "memory"); return __builtin_bit_cast(bf16x8, r); }
template <int N> __device__ __forceinline__ void lgkm_wait() { asm volatile("s_waitcnt lgkmcnt(%0)" :: "n"(N) : "memory"); }
#ifndef PP_PRIO
#define PP_PRIO 1
#endif
#ifndef PP_GRP
#define PP_GRP(w) ((w) >> 2)
#endif
template <int DK> __device__ __forceinline__ void attn_unit_pp(const Unit& U, LAS char* lds, const int tid) {
    constexpr int KS = 2 * DK + 16, SHM_V = 8192, SHM_K = 64 * KS, NKP = DK / 8, NPK = SHM_K / 1024;
    static_assert(SHM_K % 1024 == 0, "K tile is a whole number of 1 KiB DMA pieces");
    const int wid = __builtin_amdgcn_readfirstlane(tid >> 6), lane = tid & 63, r32 = lane & 31, hi = lane >> 5;
    LAS char* V_lds = lds; LAS char* K_lds = lds + 4 * SHM_V;
    LAS float* ws = (LAS float*)(lds + 4 * SHM_V + 3 * SHM_K) + wid * 64; LAS float* li_l = ws;
    const unsigned lds0 = (unsigned)(uintptr_t)lds;
    float lsum = 0; f32x16 o[2] = {}; bf16x8 qr[DK / 16];
    const f32x16 cinit = {};
    const bf16* Qw = U.Q + (size_t)(wid * 32 + r32) * U.ldq + hi * 8;
#pragma unroll
    for (int d0 = 0; d0 < DK / 16; ++d0) qr[d0] = *(const bf16x8*)(Qw + d0 * 16);
    prep_q<DK>(U, qr, wid, r32, hi);
    const int kp1 = (wid + 8 < NPK) ? wid + 8 : wid;
    int koff0, koff1, voff;
    { const int b0 = wid * 1024 + lane * 16, r0 = b0 / KS, c0 = (b0 % KS) / 16; koff0 = r0 * U.ldk + (c0 < NKP ? c0 : 0) * 8;
      const int b1 = kp1 * 1024 + lane * 16, r1 = b1 / KS, c1 = (b1 % KS) / 16; koff1 = r1 * U.ldk + (c1 < NKP ? c1 : 0) * 8;
      const int i = wid * 64 + lane, sub = i >> 5, sl = i & 31, kk = (sub >> 1) * 8 + (sl >> 2), c = (sub & 1) * 32 + (sl & 3) * 8, key = (kk & ~0xC) | ((kk & 4) << 1) | ((kk & 8) >> 1);
      voff = key * U.ldk + c; }
    const unsigned kdst0 = lds0 + 4 * SHM_V + wid * 1024, kdst1 = lds0 + 4 * SHM_V + kp1 * 1024, vdst = lds0 + wid * 1024;
    const int vb0 = (int)lds0 + v_rd_base(lane);
    const int ka0 = (int)lds0 + 4 * SHM_V + r32 * KS + hi * 16;
    const int NT = U.nA + U.nB;
    auto tile_row = [&](int j) -> int { j = j < NT ? j : NT - 1; if (j < U.nA) return U.rowA + 64 * j; int r = U.rowB + 64 * (j - U.nA); r = r < U.rlo ? U.rlo : r; return r > U.rhi ? U.rhi : r; };
#define DMA_TILE(j, kslot, vslot) do { const size_t ro_ = (size_t)tile_row(j) * U.ldk; \
        glds16(U.V + ro_ + voff, (unsigned)__builtin_amdgcn_readfirstlane(vdst + (vslot) * SHM_V)); \
        glds16(U.K + ro_ + koff0, (unsigned)__builtin_amdgcn_readfirstlane(kdst0 + (kslot) * SHM_K)); \
        glds16(U.K + ro_ + koff1, (unsigned)__builtin_amdgcn_readfirstlane(kdst1 + (kslot) * SHM_K)); } while (0)
#define MASK(P0, P1, j) do { if (U.mask && (j) >= U.nA) { const int kb = U.kb0 + 64 * ((j) - U.nA), dq = wid * 32 + r32; \
        _Pragma("unroll") for (int r = 0; r < 16; ++r) { const int k0_ = kb + crow(r, hi), k1_ = k0_ + 32; \
            const bool ok0 = (k0_ - dq <= 128) && (dq - k0_ <= 128) && ((unsigned)(U.q0 + k0_) < (unsigned)S); \
            const bool ok1 = (k1_ - dq <= 128) && (dq - k1_ <= 128) && ((unsigned)(U.q0 + k1_) < (unsigned)S); \
            P0[r] = ok0 ? P0[r] : -INFINITY; P1[r] = ok1 ? P1[r] : -INFINITY; } } } while (0)
    f32x16 p0, p1; bf16x8 pa0, pa1, pa2, pa3;
    const int grp = PP_GRP(wid);
    asm volatile("s_waitcnt vmcnt(0) lgkmcnt(0)\n\ts_barrier" ::: "memory");
    DMA_TILE(0, 0, 0); DMA_TILE(1, 1, 1); DMA_TILE(2, 2, 2);
    WAIT_BAR(6);
    if (grp) asm volatile("s_barrier" ::: "memory");
    qkt_c<DK>(p0, p1, K_lds, qr, cinit, r32, hi);
    int kn = 1, vc = 0, k3 = 0, v3 = 3;
    for (int k = 0; k < NT; ++k) {
        if (grp == 0) asm volatile("s_barrier" ::: "memory"); else { WAIT_BAR(3); DMA_TILE(k + 3, k3, v3); }
        SBAR(); MASK(p0, p1, k); partialF(p0); finishF(p0, p1, lsum, pa0, pa1, pa2, pa3); asm volatile("" : "+v"(lsum)); SBAR();
        if (grp == 0) { WAIT_BAR(3); DMA_TILE(k + 3, k3, v3); } else if (k + 1 < NT) asm volatile("s_barrier" ::: "memory");
        SBAR();
        if (PP_PRIO) asm volatile("s_setprio 2" ::: "memory");
        if (k + 1 < NT) {
            constexpr int ND = DK / 16, VS = (16 + ND - 1) / ND;
            const int vb = vb0 + vc * SHM_V, ka = ka0 + kn * SHM_K;
            bf16x8 kf[2 * ND]; s16x4 vr[16];
            sfor<0, ND>([&](auto d) __attribute__((always_inline)) { constexpr int d0 = decltype(d)::v; kf[2 * d0] = rd128<d0 * 32>(ka); kf[2 * d0 + 1] = rd128<32 * KS + d0 * 32>(ka); });
            sfor<0, ND>([&](auto d) __attribute__((always_inline)) { constexpr int d0 = decltype(d)::v; constexpr int V0 = VS * d0 < 16 ? VS * d0 : 16, V1 = VS * (d0 + 1) < 16 ? VS * (d0 + 1) : 16;
                lgkm_wait<2 * ND - 2 * (d0 + 1) + V0>(); SBAR();
                p0 = __builtin_amdgcn_mfma_f32_32x32x16_bf16(kf[2 * d0], qr[d0], d0 == 0 ? cinit : p0, 0, 0, 0);
                p1 = __builtin_amdgcn_mfma_f32_32x32x16_bf16(kf[2 * d0 + 1], qr[d0], d0 == 0 ? cinit : p1, 0, 0, 0); SBAR();
                sfor<V0, V1>([&](auto n_) __attribute__((always_inline)) { constexpr int n = decltype(n_)::v, j = n >> 1; vr[n] = tr_read<v_rd_off(j & 1, j >> 1, n & 1)>(vb); }); });
            const bf16x8 pa[4] = {pa0, pa1, pa2, pa3};
            sfor<0, 8>([&](auto j_) __attribute__((always_inline)) { constexpr int j = decltype(j_)::v;
                lgkm_wait<14 - 2 * j>(); SBAR();
                const bf16x8 vf = {vr[2 * j][0], vr[2 * j][1], vr[2 * j][2], vr[2 * j][3], vr[2 * j + 1][0], vr[2 * j + 1][1], vr[2 * j + 1][2], vr[2 * j + 1][3]};
                o[j & 1] = __builtin_amdgcn_mfma_f32_32x32x16_bf16(pa[j >> 1], vf, o[j & 1], 0, 0, 0); SBAR(); });
        } else { const int vb = vb0 + vc * SHM_V; pv_one<0>(o[0], vb, pa0, pa1, pa2, pa3); pv_one<1>(o[1], vb, pa0, pa1, pa2, pa3); }
        if (PP_PRIO) asm volatile("s_setprio 0" ::: "memory");
        kn = kn == 2 ? 0 : kn + 1; vc = (vc + 1) & 3; k3 = k3 == 2 ? 0 : k3 + 1; v3 = (v3 + 1) & 3;
    }
    asm volatile("s_waitcnt vmcnt(0)" ::: "memory");
    { auto rr = __builtin_amdgcn_permlane32_swap(__float_as_uint(lsum), __float_as_uint(lsum), false, false); lsum = __uint_as_float(rr[0]) + __uint_as_float(rr[1]); }
    if (U.has_sink) lsum += __builtin_amdgcn_exp2f(U.sink * LOG2E);
    if (hi == 0) li_l[r32] = lsum; asm volatile("s_waitcnt lgkmcnt(0)" ::: "memory");
    float rli[16];
#pragma unroll
    for (int r = 0; r < 16; ++r) rli[r] = __builtin_amdgcn_rcpf(li_l[crow(r, hi)]);
    bf16* Ow = U.O + (size_t)(wid * 32) * U.ldo;
#pragma unroll
    for (int r = 0; r < 16; ++r) { const int orow = crow(r, hi);
#pragma unroll
        for (int d0 = 0; d0 < 2; ++d0) Ow[(size_t)orow * U.ldo + d0 * 32 + r32] = (bf16)f2bf(o[d0][r] * rli[r]); }
#undef DMA_TILE
#undef MASK
}

__device__ __forceinline__ void finishF_b(f32x16& p0, f32x16& p1, float& lsum, bf16x8& pa0, bf16x8& pa1, bf16x8& pa2, bf16x8& pa3) {
    { const f32x16 s16 = p0 + p1;
      const float a0 = (s16[0] + s16[1]) + (s16[2] + s16[3]), a1 = (s16[4] + s16[5]) + (s16[6] + s16[7]), a2 = (s16[8] + s16[9]) + (s16[10] + s16[11]), a3 = (s16[12] + s16[13]) + (s16[14] + s16[15]);
      lsum += (a0 + a1) + (a2 + a3); }
#define PK4(P, BASE, OUT) do { unsigned a0 = cvtpk(P[BASE + 0], P[BASE + 1]), a1 = cvtpk(P[BASE + 2], P[BASE + 3]);   \
    unsigned b0 = cvtpk(P[BASE + 4], P[BASE + 5]), b1 = cvtpk(P[BASE + 6], P[BASE + 7]);                              \
    auto r0 = __builtin_amdgcn_permlane32_swap(a0, b0, false, false); auto r1 = __builtin_amdgcn_permlane32_swap(a1, b1, false, false); \
    u32x4 w = {r0[0], r1[0], r0[1], r1[1]}; OUT = *reinterpret_cast<bf16x8*>(&w); } while (0)
    PK4(p0, 0, pa0); PK4(p0, 8, pa1); PK4(p1, 0, pa2); PK4(p1, 8, pa3);
#undef PK4
}
template <int DK, int EX> __device__ __forceinline__ void attn_unit_dma_x(const Unit& U, LAS char* lds, const int tid) {
    constexpr int KS = 2 * DK + 16, SHM_V = 8192, SHM_K = 64 * KS, NKP = DK / 8, NPK = SHM_K / 1024;
    static_assert(SHM_K % 1024 == 0, "K tile is a whole number of 1 KiB DMA pieces");
    const int wid = __builtin_amdgcn_readfirstlane(tid >> 6), lane = tid & 63, r32 = lane & 31, hi = lane >> 5;
    LAS char* V_lds = lds; LAS char* K_lds = lds + 4 * SHM_V;
    LAS float* ws = (LAS float*)(lds + 4 * SHM_V + 3 * SHM_K) + wid * 64; LAS float* li_l = ws;
    const unsigned lds0 = (unsigned)(uintptr_t)lds;
    float lsum = 0; f32x16 o[2] = {}; bf16x8 qr[DK / 16];
    const f32x16 cinit = {};
    const bf16* Qw = U.Q + (size_t)(wid * 32 + r32) * U.ldq + hi * 8;
#pragma unroll
    for (int d0 = 0; d0 < DK / 16; ++d0) qr[d0] = *(const bf16x8*)(Qw + d0 * 16);
    const int kp1 = (wid + 8 < NPK) ? wid + 8 : wid;
    int koff0, koff1, voff;
    { const int b0 = wid * 1024 + lane * 16, r0 = b0 / KS, c0 = (b0 % KS) / 16; koff0 = r0 * U.ldk + (c0 < NKP ? c0 : 0) * 8;
      const int b1 = kp1 * 1024 + lane * 16, r1 = b1 / KS, c1 = (b1 % KS) / 16; koff1 = r1 * U.ldk + (c1 < NKP ? c1 : 0) * 8;
      const int i = wid * 64 + lane, sub = i >> 5, sl = i & 31, kk = (sub >> 1) * 8 + (sl >> 2), c = (sub & 1) * 32 + (sl & 3) * 8, key = (kk & ~0xC) | ((kk & 4) << 1) | ((kk & 8) >> 1);
      voff = key * U.ldk + c; }
    const unsigned kdst0 = lds0 + 4 * SHM_V + wid * 1024, kdst1 = lds0 + 4 * SHM_V + kp1 * 1024, vdst = lds0 + wid * 1024;
    const int vb0 = (int)lds0 + v_rd_base(lane);
    const int NT = U.nA + U.nB;
    auto tile_row = [&](int j) -> int { j = j < NT ? j : NT - 1; if (j < U.nA) return U.rowA + 64 * j; int r = U.rowB + 64 * (j - U.nA); r = r < U.rlo ? U.rlo : r; return r > U.rhi ? U.rhi : r; };
#define DMA_TILE(j, kslot, vslot) do { if (EX == 2) break; const size_t ro_ = (size_t)tile_row(j) * U.ldk; \
        glds16(U.V + ro_ + voff, (unsigned)__builtin_amdgcn_readfirstlane(vdst + (vslot) * SHM_V)); \
        glds16(U.K + ro_ + koff0, (unsigned)__builtin_amdgcn_readfirstlane(kdst0 + (kslot) * SHM_K)); \
        glds16(U.K + ro_ + koff1, (unsigned)__builtin_amdgcn_readfirstlane(kdst1 + (kslot) * SHM_K)); } while (0)
#define MASK(P0, P1, j) do { if (U.mask && (j) >= U.nA) { const int kb = U.kb0 + 64 * ((j) - U.nA), dq = wid * 32 + r32; \
        _Pragma("unroll") for (int r = 0; r < 16; ++r) { const int k0_ = kb + crow(r, hi), k1_ = k0_ + 32; \
            const bool ok0 = (k0_ - dq <= 128) && (dq - k0_ <= 128) && ((unsigned)(U.q0 + k0_) < (unsigned)S); \
            const bool ok1 = (k1_ - dq <= 128) && (dq - k1_ <= 128) && ((unsigned)(U.q0 + k1_) < (unsigned)S); \
            P0[r] = ok0 ? P0[r] : -INFINITY; P1[r] = ok1 ? P1[r] : -INFINITY; } } } while (0)
    f32x16 pA0, pA1, pB0, pB1; bf16x8 pa0, pa1, pa2, pa3;
    asm volatile("s_waitcnt vmcnt(0) lgkmcnt(0)\n\ts_barrier" ::: "memory");
    DMA_TILE(0, 0, 0); DMA_TILE(1, 1, 1); DMA_TILE(2, 2, 2);
    WAIT_BAR(6);
    qkt_c<DK>(pA0, pA1, K_lds, qr, cinit, r32, hi); MASK(pA0, pA1, 0); partialF(pA0);
    int kn = 1, vc = 0, k3 = 0, v3 = 3;
#define STEP_A(t_) do { if (EX == 6) {} else if (EX == 2) asm volatile("s_waitcnt lgkmcnt(0)\n\ts_barrier" ::: "memory"); else WAIT_BAR(3); DMA_TILE((t_) + 3, k3, v3); \
        SBAR(); if (EX != 5) qkt_c<DK>(pB0, pB1, K_lds + kn * SHM_K, qr, cinit, r32, hi); else { asm volatile("" : "+v"(pB0), "+v"(pB1)); } MASK(pB0, pB1, (t_) + 1); \
        if (EX != 3) finishF(pA0, pA1, lsum, pa0, pa1, pa2, pa3); else finishF_b(pA0, pA1, lsum, pa0, pa1, pa2, pa3); SBAR(); \
        { const int vb = vb0 + vc * SHM_V; if (EX != 4) { pv_one<0>(o[0], vb, pa0, pa1, pa2, pa3); pv_one<1>(o[1], vb, pa0, pa1, pa2, pa3); } else { asm volatile("" :: "v"(pa0), "v"(pa1), "v"(pa2), "v"(pa3)); } } if (EX != 3) partialF(pB0); \
        kn = kn == 2 ? 0 : kn + 1; vc = (vc + 1) & 3; k3 = k3 == 2 ? 0 : k3 + 1; v3 = (v3 + 1) & 3; } while (0)
#define STEP_B(t_, HAS_NEXT) do { if (EX == 6) {} else if (EX == 2) asm volatile("s_waitcnt lgkmcnt(0)\n\ts_barrier" ::: "memory"); else WAIT_BAR(3); DMA_TILE((t_) + 4, k3, v3); \
        SBAR(); if (HAS_NEXT) { if (EX != 5) qkt_c<DK>(pA0, pA1, K_lds + kn * SHM_K, qr, cinit, r32, hi); else { asm volatile("" : "+v"(pA0), "+v"(pA1)); } MASK(pA0, pA1, (t_) + 2); } \
        if (EX != 3) finishF(pB0, pB1, lsum, pa0, pa1, pa2, pa3); else finishF_b(pB0, pB1, lsum, pa0, pa1, pa2, pa3); SBAR(); \
        { const int vb = vb0 + vc * SHM_V; if (EX != 4) { pv_one<0>(o[0], vb, pa0, pa1, pa2, pa3); pv_one<1>(o[1], vb, pa0, pa1, pa2, pa3); } else { asm volatile("" :: "v"(pa0), "v"(pa1), "v"(pa2), "v"(pa3)); } } if (HAS_NEXT && EX != 3) partialF(pA0); \
        kn = kn == 2 ? 0 : kn + 1; vc = (vc + 1) & 3; k3 = k3 == 2 ? 0 : k3 + 1; v3 = (v3 + 1) & 3; } while (0)
    int t = 0;
    for (; t + 2 < NT; t += 2) { STEP_A(t); STEP_B(t, true); }
    STEP_A(t); STEP_B(t, false);
#undef STEP_A
#undef STEP_B
    asm volatile("s_waitcnt vmcnt(0)" ::: "memory");
    { auto rr = __builtin_amdgcn_permlane32_swap(__float_as_uint(lsum), __float_as_uint(lsum), false, false); lsum = __uint_as_float(rr[0]) + __uint_as_float(rr[1]); }
    if (U.has_sink) lsum += __builtin_amdgcn_exp2f(U.sink * LOG2E);
    if (hi == 0) li_l[r32] = lsum; asm volatile("s_waitcnt lgkmcnt(0)" ::: "memory");
    float rli[16];
#pragma unroll
    for (int r = 0; r < 16; ++r) rli[r] = __builtin_amdgcn_rcpf(li_l[crow(r, hi)]);
    asm volatile("" :: "v"(o[0]), "v"(o[1]), "v"(rli[0]), "v"(rli[7]), "v"(rli[15]));
#undef DMA_TILE
#undef MASK
}

typedef float f32x4_ __attribute__((ext_vector_type(4)));
template <int OFF> __device__ __forceinline__ s16x4 tr_read16(int vb) { s16x4 r; asm volatile("ds_read_b64_tr_b16 %0, %1 offset:%2" : "=&v"(r) : "v"(vb), "i"(OFF) : "memory"); return r; }
template <int DK> __device__ __forceinline__ void attn_unit_dma16(const Unit& U, LAS char* lds, const int tid) {
    constexpr int KS = 2 * DK + 16, VS = 160, SHM_V = 64 * VS, SHM_K = 64 * KS, NKP = DK / 8, NPK = SHM_K / 1024, NPV = SHM_V / 1024, NDS = DK / 32;
    static_assert(SHM_K % 1024 == 0 && SHM_V % 1024 == 0, "whole DMA pieces");
    const int wid = __builtin_amdgcn_readfirstlane(tid >> 6), lane = tid & 63, c = lane & 15, g = lane >> 4;
    LAS char* V_lds = lds; LAS char* K_lds = lds + 4 * SHM_V;
    const unsigned lds0 = (unsigned)(uintptr_t)lds;
    float lsum[2] = {0.f, 0.f}; f32x4_ o[4][2]; bf16x8 qf[2][NDS];
#pragma unroll
    for (int d = 0; d < 4; ++d)
#pragma unroll
        for (int q = 0; q < 2; ++q) o[d][q] = (f32x4_){0.f, 0.f, 0.f, 0.f};
#pragma unroll
    for (int qb = 0; qb < 2; ++qb)
#pragma unroll
        for (int ds = 0; ds < NDS; ++ds) qf[qb][ds] = *(const bf16x8*)(U.Q + (size_t)(wid * 32 + 16 * qb + c) * U.ldq + 32 * ds + 8 * g);
    const int kp1 = (wid + 8 < NPK) ? wid + 8 : wid, vp1 = (wid + 8 < NPV) ? wid + 8 : wid;
    int koff0, koff1, voff0, voff1;
    { const int b0 = wid * 1024 + lane * 16, r0 = b0 / KS, c0 = (b0 % KS) / 16; koff0 = r0 * U.ldk + (c0 < NKP ? c0 : 0) * 8;
      const int b1 = kp1 * 1024 + lane * 16, r1 = b1 / KS, c1 = (b1 % KS) / 16; koff1 = r1 * U.ldk + (c1 < NKP ? c1 : 0) * 8;
      const int b2 = wid * 1024 + lane * 16, r2 = b2 / VS, c2 = (b2 % VS) / 16; voff0 = r2 * U.ldk + (c2 < 8 ? c2 : 0) * 8;
      const int b3 = vp1 * 1024 + lane * 16, r3 = b3 / VS, c3 = (b3 % VS) / 16; voff1 = r3 * U.ldk + (c3 < 8 ? c3 : 0) * 8; }
    const unsigned kdst0 = lds0 + 4 * SHM_V + wid * 1024, kdst1 = lds0 + 4 * SHM_V + kp1 * 1024, vdst0 = lds0 + wid * 1024, vdst1 = lds0 + vp1 * 1024;
    const int kb0_ = c * KS + 16 * g;
    const int vrd = (int)lds0 + (4 * g + ((lane >> 2) & 3)) * VS + (lane & 3) * 8;
    const int NT = U.nA + U.nB;
    auto tile_row = [&](int j) -> int { j = j < NT ? j : NT - 1; if (j < U.nA) return U.rowA + 64 * j; int r = U.rowB + 64 * (j - U.nA); r = r < U.rlo ? U.rlo : r; return r > U.rhi ? U.rhi : r; };
#define DMA_TILE(j, kslot, vslot) do { const size_t ro_ = (size_t)tile_row(j) * U.ldk; \
        glds16(U.V + ro_ + voff0, (unsigned)__builtin_amdgcn_readfirstlane(vdst0 + (vslot) * SHM_V)); \
        glds16(U.V + ro_ + voff1, (unsigned)__builtin_amdgcn_readfirstlane(vdst1 + (vslot) * SHM_V)); \
        glds16(U.K + ro_ + koff0, (unsigned)__builtin_amdgcn_readfirstlane(kdst0 + (kslot) * SHM_K)); \
        glds16(U.K + ro_ + koff1, (unsigned)__builtin_amdgcn_readfirstlane(kdst1 + (kslot) * SHM_K)); } while (0)
#define WAIT_BAR4(N) asm volatile("s_waitcnt vmcnt(" #N ") lgkmcnt(0)\n\ts_barrier" ::: "memory")
#define QK16(SC, Ks) do { bf16x8 kf[4][NDS]; \
        _Pragma("unroll") for (int kb = 0; kb < 4; ++kb) _Pragma("unroll") for (int ds = 0; ds < NDS; ++ds) kf[kb][ds] = *(const LAS bf16x8*)((Ks) + kb0_ + kb * 16 * KS + ds * 64); \
        SBAR(); \
        _Pragma("unroll") for (int ds = 0; ds < NDS; ++ds) _Pragma("unroll") for (int kb = 0; kb < 4; ++kb) _Pragma("unroll") for (int qb = 0; qb < 2; ++qb) \
            SC[kb][qb] = __builtin_amdgcn_mfma_f32_16x16x32_bf16(kf[kb][ds], qf[qb][ds], ds == 0 ? (f32x4_){0.f, 0.f, 0.f, 0.f} : SC[kb][qb], 0, 0, 0); } while (0)
#define MASK16(SC, j) do { if (U.mask && (j) >= U.nA) { const int kbase = U.kb0 + 64 * ((j) - U.nA); \
        _Pragma("unroll") for (int kb = 0; kb < 4; ++kb) _Pragma("unroll") for (int qb = 0; qb < 2; ++qb) _Pragma("unroll") for (int i = 0; i < 4; ++i) { \
            const int k_ = kbase + 16 * kb + 4 * g + i, dq = wid * 32 + 16 * qb + c; \
            const bool ok = (k_ - dq <= 128) && (dq - k_ <= 128) && ((unsigned)(U.q0 + k_) < (unsigned)S); SC[kb][qb][i] = ok ? SC[kb][qb][i] : -INFINITY; } } } while (0)
#define EXPH(SC, KB0) do { _Pragma("unroll") for (int kb = KB0; kb < KB0 + 2; ++kb) _Pragma("unroll") for (int qb = 0; qb < 2; ++qb) _Pragma("unroll") for (int i = 0; i < 4; ++i) SC[kb][qb][i] = __builtin_amdgcn_exp2f(SC[kb][qb][i]); } while (0)
#define FINISH16(SC) do { EXPH(SC, 2); \
        _Pragma("unroll") for (int qb = 0; qb < 2; ++qb) { const f32x4_ t0 = SC[0][qb] + SC[1][qb], t1 = SC[2][qb] + SC[3][qb], t = t0 + t1; lsum[qb] += (t[0] + t[1]) + (t[2] + t[3]); \
            _Pragma("unroll") for (int s_ = 0; s_ < 2; ++s_) { u32x4 w_ = {cvtpk(SC[2 * s_][qb][0], SC[2 * s_][qb][1]), cvtpk(SC[2 * s_][qb][2], SC[2 * s_][qb][3]), cvtpk(SC[2 * s_ + 1][qb][0], SC[2 * s_ + 1][qb][1]), cvtpk(SC[2 * s_ + 1][qb][2], SC[2 * s_ + 1][qb][3])}; \
                pb[s_][qb] = *reinterpret_cast<bf16x8*>(&w_); } } } while (0)
#define PVS(S_, vb_) do { s16x4 va[4], vh[4]; \
        va[0] = tr_read16<(S_) * 32 * VS + 0>(vb_); vh[0] = tr_read16<(S_) * 32 * VS + 16 * VS + 0>(vb_); va[1] = tr_read16<(S_) * 32 * VS + 32>(vb_); vh[1] = tr_read16<(S_) * 32 * VS + 16 * VS + 32>(vb_); \
        va[2] = tr_read16<(S_) * 32 * VS + 64>(vb_); vh[2] = tr_read16<(S_) * 32 * VS + 16 * VS + 64>(vb_); va[3] = tr_read16<(S_) * 32 * VS + 96>(vb_); vh[3] = tr_read16<(S_) * 32 * VS + 16 * VS + 96>(vb_); \
        asm volatile("s_waitcnt lgkmcnt(0)" ::: "memory"); SBAR(); \
        _Pragma("unroll") for (int dvb = 0; dvb < 4; ++dvb) { const bf16x8 vf = (bf16x8){va[dvb][0], va[dvb][1], va[dvb][2], va[dvb][3], vh[dvb][0], vh[dvb][1], vh[dvb][2], vh[dvb][3]}; \
            _Pragma("unroll") for (int qb = 0; qb < 2; ++qb) o[dvb][qb] = __builtin_amdgcn_mfma_f32_16x16x32_bf16(vf, pb[(S_)][qb], o[dvb][qb], 0, 0, 0); } } while (0)
    f32x4_ scA[4][2], scB[4][2]; bf16x8 pb[2][2];
    asm volatile("s_waitcnt vmcnt(0) lgkmcnt(0)\n\ts_barrier" ::: "memory");
    DMA_TILE(0, 0, 0); DMA_TILE(1, 1, 1); DMA_TILE(2, 2, 2);
    WAIT_BAR4(8);
    QK16(scA, K_lds); MASK16(scA, 0); EXPH(scA, 0);
    int kn = 1, vc = 0, k3 = 0, v3 = 3;
#define STEP_A(t_) do { WAIT_BAR4(4); DMA_TILE((t_) + 3, k3, v3); \
        SBAR(); QK16(scB, K_lds + kn * SHM_K); MASK16(scB, (t_) + 1); FINISH16(scA); SBAR(); \
        { const int vb_ = vrd + vc * SHM_V; PVS(0, vb_); PVS(1, vb_); } EXPH(scB, 0); \
        kn = kn == 2 ? 0 : kn + 1; vc = (vc + 1) & 3; k3 = k3 == 2 ? 0 : k3 + 1; v3 = (v3 + 1) & 3; } while (0)
#define STEP_B(t_, HAS_NEXT) do { WAIT_BAR4(4); DMA_TILE((t_) + 4, k3, v3); \
        SBAR(); if (HAS_NEXT) { QK16(scA, K_lds + kn * SHM_K); MASK16(scA, (t_) + 2); } FINISH16(scB); SBAR(); \
        { const int vb_ = vrd + vc * SHM_V; PVS(0, vb_); PVS(1, vb_); } if (HAS_NEXT) EXPH(scA, 0); \
        kn = kn == 2 ? 0 : kn + 1; vc = (vc + 1) & 3; k3 = k3 == 2 ? 0 : k3 + 1; v3 = (v3 + 1) & 3; } while (0)
    int t = 0;
    for (; t + 2 < NT; t += 2) { STEP_A(t); STEP_B(t, true); }
    STEP_A(t); STEP_B(t, false);
#undef STEP_A
#undef STEP_B
    asm volatile("s_waitcnt vmcnt(0)" ::: "memory");
    const float snk = U.has_sink ? __builtin_amdgcn_exp2f(U.sink * LOG2E) : 0.f;
#pragma unroll
    for (int qb = 0; qb < 2; ++qb) { float l = lsum[qb]; l += __shfl_xor(l, 16); l += __shfl_xor(l, 32); const float rl = __builtin_amdgcn_rcpf(l + snk);
        bf16* orow = U.O + (size_t)(wid * 32 + 16 * qb + c) * U.ldo + 4 * g;
#pragma unroll
        for (int dvb = 0; dvb < 4; ++dvb) { const f32x4_ v = o[dvb][qb] * rl; *(u32x2*)(orow + 16 * dvb) = (u32x2){pk2(v[0], v[1]), pk2(v[2], v[3])}; } }
#undef DMA_TILE
#undef WAIT_BAR4
#undef QK16
#undef MASK16
#undef EXPH
#undef FINISH16
#undef PVS
}
}

constexpr float SWA_C2 = 0.125f * LOG2E;
__device__ __forceinline__ bool swa_fast(const Frame& F, int li) {
    float mq = 0.f, mk = 0.f, ms = -1e30f;
    for (int j = 0; j < 64; ++j) { mq = fmaxf(mq, fabsf(inp(F, I_SWAQG)[li * 64 + j])); mk = fmaxf(mk, fabsf(inp(F, I_SWAKG)[li * 64 + j])); }
    for (int j = 0; j < 12; ++j) ms = fmaxf(ms, inp(F, I_SINK)[li * 12 + j]);
    const float Mref = 8.f * LOG2E * mq * mk * 1.01f;
    return (Mref < 40.f) && (ms * LOG2E < 40.f);
}
__device__ __forceinline__ void phase_even_qk(Frame& F, int li, bool dry = false) {
    bf16* P = (bf16*)(F.ws + A_P); bf16* MIX = (bf16*)(F.ws + A_MIX);
    const f32x2* r64 = (const f32x2*)(F.ws + WS_ROPE);
    {
        const bool fast = swa_fast(F, li);
        const int head = fast ? 12 + ((F.lane >> 2) & 3) : F.lane >> 2, qt = F.lane & 3, RP = fast ? 4 : 1, sub = fast ? F.lane >> 4 : 0, NR = T / RP;
        const float* gain = (head < 12 ? inp(F, I_SWAQG) : inp(F, I_SWAKG)) + li * 64 + 16 * qt;
        float gn[16];
#pragma unroll
        for (int j = 0; j < 16; ++j) gn[j] = gain[j] * (head < 12 ? SWA_C2 : 1.f);
        u32x4 na = {0u, 0u, 0u, 0u}, nb = na;
        if (F.gw < NR) { const bf16* p = P + (size_t)(F.gw * RP + sub) * EV_N + 256 + 64 * head + 16 * qt; na = *(const u32x4*)p; nb = *(const u32x4*)(p + 8); }
        for (int rq = F.gw; rq < NR; rq += F.NGW) {
            const int r = rq * RP + sub;
            bf16* p = P + (size_t)r * EV_N + 256 + 64 * head + 16 * qt;
            const u32x4 a = na, b = nb;
            if (rq + F.NGW < NR) { const bf16* pn = P + (size_t)((rq + F.NGW) * RP + sub) * EV_N + 256 + 64 * head + 16 * qt; na = *(const u32x4*)pn; nb = *(const u32x4*)(pn + 8); }
            float v[16] = {bflo(a.x), bfhi(a.x), bflo(a.y), bfhi(a.y), bflo(a.z), bfhi(a.z), bflo(a.w), bfhi(a.w), bflo(b.x), bfhi(b.x), bflo(b.y), bfhi(b.y), bflo(b.z), bfhi(b.z), bflo(b.w), bfhi(b.w)};
            float ss = 0.f;
#pragma unroll
            for (int j = 0; j < 16; ++j) ss += v[j] * v[j];
            ss += dpp_f<0xB1>(ss); ss += dpp_f<0x4E>(ss);
            const float rstd = 1.f / sqrtf(ss * (1.f / 64.f) + EPS);
#pragma unroll
            for (int j = 0; j < 16; ++j) v[j] = v[j] * rstd * gn[j];
            if (r < TL) { const int s = r % S; const f32x2* cs = r64 + (size_t)s * 32 + 16 * (qt & 1);
#pragma unroll
                for (int j = 0; j < 16; ++j) { const float pr = dpp_f<0x4E>(v[j]); const f32x2 c = cs[j]; v[j] = (qt < 2) ? v[j] * c.x - pr * c.y : v[j] * c.x + pr * c.y; } }
            if (!dry) { *(u32x4*)p = (u32x4){pk2(v[0], v[1]), pk2(v[2], v[3]), pk2(v[4], v[5]), pk2(v[6], v[7])};
            *(u32x4*)(p + 8) = (u32x4){pk2(v[8], v[9]), pk2(v[10], v[11]), pk2(v[12], v[13]), pk2(v[14], v[15])}; }
        }
    }
}
__device__ __forceinline__ void phase_even_pool(Frame& F, int li, int t_begin = 0, int t_end = T / 32, int c_ = -1) {
    const bf16* P = (const bf16*)(F.ws + A_P); bf16* MIX = (bf16*)(F.ws + A_MIX);
    __syncthreads();
    constexpr int LPS = 264;
    LAS float* la = (LAS float*)F.lds;
    LAS bf16* lpb = (LAS bf16*)(la + 48 * 256);
    const int d = F.tid & 255, g = d >> 6, hh = F.tid >> 8, hw = 1 << g;
    const int gw_ = F.wave >> 1, nb = F.wave & 1, r32 = F.lane & 31, hi = F.lane >> 5;
    const bf16* wpt = (const bf16*)(F.ws + WS_WPT) + ((size_t)(li * 4 + gw_) * 64 + 32 * nb + r32) * 64 + 8 * hi;
    bf16x8 bfr[4];
#pragma unroll
    for (int ks = 0; ks < 4; ++ks) bfr[ks] = *(const bf16x8*)(wpt + 16 * ks);
    float ps[16];
#pragma unroll
    for (int r = 0; r < 16; ++r) ps[r] = inp(F, I_POOLS)[li * 256 + 64 * gw_ + 32 * nb + (r & 3) + 8 * (r >> 2) + 4 * hi];
    u32x4 nw[3];
    auto tile_geo = [&](int tile, int& r0, int& L, int& seq0, int& t0) { r0 = tile * 32; const bool lat = r0 < TL; L = lat ? S : CL; seq0 = lat ? (r0 / S) * S : TL + ((r0 - TL) / CL) * CL; t0 = r0 - seq0; };
    auto fetch = [&](int tile) { int r0, L, seq0, t0; tile_geo(tile, r0, L, seq0, t0);
#pragma unroll
        for (int k = 0; k < 3; ++k) { const int i = F.tid + NTHR * k, rr = i >> 5, c8 = (i & 31) * 8, t = t0 - 8 + rr;
            nw[k] = (u32x4){0u, 0u, 0u, 0u}; if (t >= 0 && t < L) nw[k] = *(const u32x4*)(P + (size_t)(seq0 + t) * EV_N + c8); } };
    const int tfirst = t_begin + (c_ < 0 ? F.vcu : c_);
    if (tfirst < t_end) fetch(tfirst);
    for (int tile = tfirst; tile < t_end; tile += F.G) {
        int r0, L, seq0, t0; tile_geo(tile, r0, L, seq0, t0);
        __syncthreads();
#pragma unroll
        for (int k = 0; k < 3; ++k) { const int i = F.tid + NTHR * k, rr = i >> 5, c8 = (i & 31) * 8; const u32x4 w = nw[k];
            LAS f32x4* dst = (LAS f32x4*)(la + rr * 256 + c8); dst[0] = (f32x4){bflo(w.x), bfhi(w.x), bflo(w.y), bfhi(w.y)}; dst[1] = (f32x4){bflo(w.z), bfhi(w.z), bflo(w.w), bfhi(w.w)}; }
        if (tile + F.G < t_end) fetch(tile + F.G);
        __syncthreads();
        { const int R0 = hh * 16; const bool inner = (t0 >= 8) && (t0 + 40 <= L);
          const LAS float* pM = la + (R0 + 8 - hw) * 256 + d; const LAS float* pC = la + (R0 + 8) * 256 + d; const LAS float* pP = la + (R0 + 8 + hw) * 256 + d;
          float s = 0.f; for (int k = 0; k < 2 * hw; ++k) s += pM[k * 256];
          const float rin = 1.f / (float)(2 * hw);
#pragma unroll
          for (int i = 0; i < 16; ++i) { float rc = rin;
              if (!inner) { const int t = t0 + R0 + i; int lo = t - hw, hi_ = t + hw; lo = lo < 0 ? 0 : lo; hi_ = hi_ > L ? L : hi_; rc = 1.f / (float)(hi_ - lo); }
              lpb[(R0 + i) * LPS + d] = (bf16)f2bf(s * rc - pC[i * 256]);
              if (i < 15) s += pP[i * 256] - pM[i * 256]; } }
        __syncthreads();
        { f32x16 acc = {};
#pragma unroll
          for (int ks = 0; ks < 4; ++ks) { const bf16x8 af = *(const LAS bf16x8*)(lpb + r32 * LPS + 64 * gw_ + 16 * ks + 8 * hi); acc = __builtin_amdgcn_mfma_f32_32x32x16_bf16(bfr[ks], af, acc, 0, 0, 0); }
          bf16* orow = MIX + (size_t)(r0 + r32) * D + 64 * gw_ + 32 * nb + 4 * hi;
#pragma unroll
          for (int q = 0; q < 4; ++q) *(u32x2*)(orow + 8 * q) = (u32x2){pk2(acc[4 * q] * ps[4 * q], acc[4 * q + 1] * ps[4 * q + 1]), pk2(acc[4 * q + 2] * ps[4 * q + 2], acc[4 * q + 3] * ps[4 * q + 3])}; }
    }
    __syncthreads();
}

__device__ __forceinline__ void phase_swa(Frame& F, int li, bool need_ctx) {
    const bf16* P = (const bf16*)(F.ws + A_P); bf16* MIX = (bf16*)(F.ws + A_MIX);
    const int nlat = NB * 12 * (S / 256), nctx = need_ctx ? NB * 12 : 0;
    const bool fast = swa_fast(F, li);
    asm volatile("s_waitcnt vmcnt(0)" ::: "memory");
    for (int u = F.vcu; u < nlat + nctx; u += F.G) {
        att::Unit U; U.ldq = EV_N; U.ldk = EV_N; U.ldo = D; U.has_sink = 1; U.qprep = fast ? 1 : 0; U.qgain = inp(F, I_SWAQG) + li * 64; U.ropet = (const f32x2*)(F.ws + WS_ROPE); U.qc2 = SWA_C2;
        if (u < nlat) { const int qb = u % (S / 256), qh = (u / (S / 256)) % 12, b = u / (12 * (S / 256)), kvh = qh / 3, row0 = b * S + qb * 256;
            U.Q = P + (size_t)row0 * EV_N + 256 + 64 * qh; U.K = P + 1024 + 64 * kvh; U.V = P + 1280 + 64 * kvh;
            U.nA = 4; U.rowA = TL + b * CL; U.nB = 8; U.rowB = row0 - 128; U.rlo = b * S; U.rhi = b * S + S - 64; U.mask = 1; U.kb0 = -128; U.q0 = qb * 256; U.qrope = 1; U.qpos0 = qb * 256;
            U.sink = inp(F, I_SINK)[li * 12 + qh]; U.O = MIX + (size_t)row0 * D + 256 + 64 * qh; }
        else { const int uu = u - nlat, qh = uu % 12, b = uu / 12, kvh = qh / 3, row0 = TL + b * CL;
            U.Q = P + (size_t)row0 * EV_N + 256 + 64 * qh; U.K = P + 1024 + 64 * kvh; U.V = P + 1280 + 64 * kvh;
            U.nA = 4; U.rowA = row0; U.nB = 0; U.rowB = 0; U.rlo = 0; U.rhi = 0; U.mask = 0; U.kb0 = 0; U.q0 = 0; U.qrope = 0; U.qpos0 = 0;
            U.sink = inp(F, I_SINK)[li * 12 + qh]; U.O = MIX + (size_t)row0 * D + 256 + 64 * qh; }
        if (fast) att::ATTN_FAST<64>(U, (LAS char*)F.lds, F.tid); else att::attn_unit<64>(U, (LAS char*)F.lds, F.tid);
    }
    __syncthreads();
    if (need_ctx && F.G >= 64 && F.vcu >= 24 && F.vcu < 40) phase_even_pool(F, li, TL / 32, T / 32, F.vcu - 24);
}

namespace fft {
constexpr int N = 16384, IMG_BYTES = 17408 * 8;
__device__ __forceinline__ int phys(int i) { return i + 4 * (i >> 6); }
__device__ __forceinline__ f32x2 cmul(f32x2 a, f32x2 b) { return (f32x2){a.x * b.x - a.y * b.y, a.x * b.y + a.y * b.x}; }
__device__ __forceinline__ f32x2 cconj(f32x2 a) { return (f32x2){a.x, -a.y}; }
__device__ __forceinline__ void init_tables(LAS f32x2* tw, int tid) {
    if (tid < 384) { const int m = tid < 256 ? 128 * tid : tid - 256; float s, c; sincospif(-(float)m * (1.f / 16384.f), &s, &c); tw[tid] = (f32x2){c, s}; }
}
__device__ __forceinline__ f32x2 tw32k(const LAS f32x2* tw, int m) { return cmul(tw[(m >> 7) & 255], tw[256 + (m & 127)]); }
__device__ __forceinline__ void dft4(f32x2& x0, f32x2& x1, f32x2& x2, f32x2& x3) {
    const f32x2 a = x0 + x2, b = x0 - x2, c = x1 + x3, d = x1 - x3;
    x0 = a + c; x2 = a - c; x1 = (f32x2){b.x + d.y, b.y - d.x}; x3 = (f32x2){b.x - d.y, b.y + d.x};
}
__device__ __forceinline__ void dft16(f32x2 (&v)[16]) {
#pragma unroll
    for (int b = 0; b < 4; ++b) dft4(v[b], v[4 + b], v[8 + b], v[12 + b]);
    const float C1 = 0.92387953251128674f, S1 = 0.38268343236508977f, R2 = 0.70710678118654752f;
    const f32x2 W1 = {C1, -S1}, W2 = {R2, -R2}, W3 = {S1, -C1}, W4 = {0.f, -1.f}, W6 = {-R2, -R2}, W9 = {-C1, S1};
    v[4 * 1 + 1] = cmul(v[4 * 1 + 1], W1); v[4 * 1 + 2] = cmul(v[4 * 1 + 2], W2); v[4 * 1 + 3] = cmul(v[4 * 1 + 3], W3);
    v[4 * 2 + 1] = cmul(v[4 * 2 + 1], W2); v[4 * 2 + 2] = cmul(v[4 * 2 + 2], W4); v[4 * 2 + 3] = cmul(v[4 * 2 + 3], W6);
    v[4 * 3 + 1] = cmul(v[4 * 3 + 1], W3); v[4 * 3 + 2] = cmul(v[4 * 3 + 2], W6); v[4 * 3 + 3] = cmul(v[4 * 3 + 3], W9);
    f32x2 o[16];
#pragma unroll
    for (int c = 0; c < 4; ++c) { f32x2 y0 = v[4 * c], y1 = v[4 * c + 1], y2 = v[4 * c + 2], y3 = v[4 * c + 3]; dft4(y0, y1, y2, y3); o[c] = y0; o[c + 4] = y1; o[c + 8] = y2; o[c + 12] = y3; }
#pragma unroll
    for (int r = 0; r < 16; ++r) v[r] = o[r];
}
template <bool INV> __device__ __forceinline__ void pass16(LAS f32x2* X, const LAS f32x2* tw, int Sd, int tid) {
#pragma unroll 1
    for (int q = 0; q < 2; ++q) {
        const int g = tid + 512 * q, blk = (g / Sd) * (16 * Sd), j = g % Sd; f32x2 v[16];
#pragma unroll
        for (int k = 0; k < 16; ++k) v[k] = X[phys(blk + j + Sd * k)];
        const f32x2 w1 = tw32k(tw, 2 * j * (1024 / Sd));
        const f32x2 w2 = cmul(w1, w1), w3 = cmul(w2, w1), w4 = cmul(w2, w2), w5 = cmul(w4, w1), w6 = cmul(w4, w2), w7 = cmul(w4, w3), w8 = cmul(w4, w4);
        const f32x2 w9 = cmul(w8, w1), w10 = cmul(w8, w2), w11 = cmul(w8, w3), w12 = cmul(w8, w4), w13 = cmul(w8, w5), w14 = cmul(w8, w6), w15 = cmul(w8, w7);
#define TWALL(OP) OP(1, w1) OP(2, w2) OP(3, w3) OP(4, w4) OP(5, w5) OP(6, w6) OP(7, w7) OP(8, w8) OP(9, w9) OP(10, w10) OP(11, w11) OP(12, w12) OP(13, w13) OP(14, w14) OP(15, w15)
#define TWMUL(r, w) v[r] = cmul(v[r], w);
        if (INV) {
#pragma unroll
            for (int k = 0; k < 16; ++k) v[k] = cconj(v[k]);
            TWALL(TWMUL)
            dft16(v);
#pragma unroll
            for (int k = 0; k < 16; ++k) v[k] = cconj(v[k]);
        } else { dft16(v); TWALL(TWMUL) }
#undef TWMUL
#undef TWALL
#pragma unroll
        for (int k = 0; k < 16; ++k) X[phys(blk + j + Sd * k)] = v[k];
    }
}
template <bool INV> __device__ __forceinline__ void pass4(LAS f32x2* X, int tid) {
#pragma unroll 1
    for (int q = 0; q < 8; ++q) {
        const int g = tid + 512 * q; LAS f32x2* p = X + phys(4 * g);
        f32x2 a = p[0], b = p[1], c = p[2], d = p[3];
        if (INV) { a = cconj(a); b = cconj(b); c = cconj(c); d = cconj(d); }
        dft4(a, b, c, d);
        if (INV) { a = cconj(a); b = cconj(b); c = cconj(c); d = cconj(d); }
        p[0] = a; p[1] = b; p[2] = c; p[3] = d;
    }
}
__device__ __forceinline__ void fwd(LAS f32x2* X, const LAS f32x2* tw, int tid) {
    __syncthreads(); pass16<false>(X, tw, 1024, tid); __syncthreads(); pass16<false>(X, tw, 64, tid); __syncthreads(); pass16<false>(X, tw, 4, tid); __syncthreads(); pass4<false>(X, tid); __syncthreads();
}
__device__ __forceinline__ void inv(LAS f32x2* X, const LAS f32x2* tw, int tid) {
    __syncthreads(); pass4<true>(X, tid); __syncthreads(); pass16<true>(X, tw, 4, tid); __syncthreads(); pass16<true>(X, tw, 64, tid); __syncthreads(); pass16<true>(X, tw, 1024, tid); __syncthreads();
}
}

namespace dft {
constexpr int RS = 136, PLANE = 128 * RS * 2;
__device__ __forceinline__ LAS bf16* DRp(LAS unsigned char* l) { return (LAS bf16*)l; }
__device__ __forceinline__ LAS bf16* DIp(LAS unsigned char* l) { return (LAS bf16*)(l + PLANE); }
__device__ __forceinline__ LAS bf16* FRp(LAS unsigned char* l) { return (LAS bf16*)(l + 2 * PLANE); }
__device__ __forceinline__ LAS bf16* FIp(LAS unsigned char* l) { return (LAS bf16*)(l + 3 * PLANE); }
static_assert(4 * PLANE == fft::IMG_BYTES, "planes fill the FFT image region exactly");
__device__ __forceinline__ void load_F(LAS unsigned char* l, const unsigned char* ws, int tid) {
    for (int i = tid; i < 2 * 128 * 16; i += NTHR) { const int pl = i >> 11, r = (i >> 4) & 127, ch = i & 15;
        *(LAS u32x4*)(l + (2 + pl) * PLANE + (r * RS + ch * 8) * 2) = *(const u32x4*)(ws + WS_F128 + ((size_t)pl * 128 * 128 + r * 128 + ch * 8) * 2); }
}
template <bool CA, bool CB> __device__ __forceinline__ void cstage(const LAS bf16* Ar, const LAS bf16* Ai, const LAS bf16* Br, const LAS bf16* Bi, f32x16 (&cr)[2], f32x16 (&ci)[2], int wave, int lane) {
    const int r32 = lane & 31, hi = lane >> 5, rb = wave >> 1, cb0 = 2 * (wave & 1);
    const int ao = (32 * rb + r32) * RS + 8 * hi, bo = (32 * cb0 + r32) * RS + 8 * hi;
    const u32x4 M = {0x80008000u, 0x80008000u, 0x80008000u, 0x80008000u};
    cr[0] = f32x16{}; cr[1] = f32x16{}; ci[0] = f32x16{}; ci[1] = f32x16{};
#pragma unroll 2
    for (int ks = 0; ks < 8; ++ks) {
        const u32x4 ar = *(const LAS u32x4*)(Ar + ao + 16 * ks); u32x4 ai = *(const LAS u32x4*)(Ai + ao + 16 * ks); if (CA) ai ^= M; const u32x4 nai = ai ^ M;
#pragma unroll
        for (int t = 0; t < 2; ++t) { const u32x4 br = *(const LAS u32x4*)(Br + bo + t * 32 * RS + 16 * ks); u32x4 bi = *(const LAS u32x4*)(Bi + bo + t * 32 * RS + 16 * ks); if (CB) bi ^= M;
#define BF8(x) __builtin_bit_cast(bf16x8, x)
            cr[t] = __builtin_amdgcn_mfma_f32_32x32x16_bf16(BF8(ar), BF8(br), cr[t], 0, 0, 0); cr[t] = __builtin_amdgcn_mfma_f32_32x32x16_bf16(BF8(nai), BF8(bi), cr[t], 0, 0, 0);
            ci[t] = __builtin_amdgcn_mfma_f32_32x32x16_bf16(BF8(ar), BF8(bi), ci[t], 0, 0, 0); ci[t] = __builtin_amdgcn_mfma_f32_32x32x16_bf16(BF8(ai), BF8(br), ci[t], 0, 0, 0);
#undef BF8
        } }
}
__device__ __forceinline__ int erow(int wave, int lane, int r) { return 32 * (wave >> 1) + (r & 3) + 8 * (r >> 2) + 4 * (lane >> 5); }
__device__ __forceinline__ int ecol(int wave, int lane, int t) { return 32 * (2 * (wave & 1) + t) + (lane & 31); }
__device__ __forceinline__ void put_rowmajor(LAS unsigned char* l, const f32x16 (&cr)[2], const f32x16 (&ci)[2], int wave, int lane) {
#pragma unroll
    for (int t = 0; t < 2; ++t)
#pragma unroll
        for (int r = 0; r < 16; ++r) { const int o = erow(wave, lane, r) * RS + ecol(wave, lane, t); DRp(l)[o] = (bf16)f2bf(cr[t][r]); DIp(l)[o] = (bf16)f2bf(ci[t][r]); }
}
__device__ __forceinline__ void put_transposed(LAS unsigned char* l, const f32x16 (&cr)[2], const f32x16 (&ci)[2], int wave, int lane) {
#pragma unroll
    for (int t = 0; t < 2; ++t)
#pragma unroll
        for (int q = 0; q < 4; ++q) { const int o = ecol(wave, lane, t) * RS + erow(wave, lane, 4 * q);
            *(LAS u32x2*)(DRp(l) + o) = (u32x2){pk2(cr[t][4 * q], cr[t][4 * q + 1]), pk2(cr[t][4 * q + 2], cr[t][4 * q + 3])};
            *(LAS u32x2*)(DIp(l) + o) = (u32x2){pk2(ci[t][4 * q], ci[t][4 * q + 1]), pk2(ci[t][4 * q + 2], ci[t][4 * q + 3])}; }
}
template <bool CONJ> __device__ __forceinline__ void twiddle(f32x16 (&cr)[2], f32x16 (&ci)[2], const LAS f32x2* tw, int wave, int lane) {
#pragma unroll
    for (int t = 0; t < 2; ++t)
#pragma unroll
        for (int r = 0; r < 16; ++r) { f32x2 w = fft::tw32k(tw, 2 * erow(wave, lane, r) * ecol(wave, lane, t)); if (CONJ) w.y = -w.y;
            const float a = cr[t][r], b = ci[t][r]; cr[t][r] = a * w.x - b * w.y; ci[t][r] = a * w.y + b * w.x; }
}
__device__ __forceinline__ void forward_a(LAS unsigned char* l, const LAS f32x2* tw, f32x16 (&cr)[2], f32x16 (&ci)[2], int wave, int lane) {
    __syncthreads();
    cstage<false, false>(DRp(l), DIp(l), FRp(l), FIp(l), cr, ci, wave, lane);
    twiddle<false>(cr, ci, tw, wave, lane);
    __syncthreads(); put_transposed(l, cr, ci, wave, lane); __syncthreads();
}
__device__ __forceinline__ void forward_b(LAS unsigned char* l, f32x16 (&cr)[2], f32x16 (&ci)[2], int wave, int lane) {
    cstage<false, false>(FRp(l), FIp(l), DRp(l), DIp(l), cr, ci, wave, lane);
}
__device__ __forceinline__ void forward(LAS unsigned char* l, const LAS f32x2* tw, f32x16 (&cr)[2], f32x16 (&ci)[2], int wave, int lane) { forward_a(l, tw, cr, ci, wave, lane); forward_b(l, cr, ci, wave, lane); }
__device__ __forceinline__ void inverse_a(LAS unsigned char* l, const LAS f32x2* tw, f32x16 (&cr)[2], f32x16 (&ci)[2], int wave, int lane) {
    __syncthreads(); put_transposed(l, cr, ci, wave, lane); __syncthreads();
    cstage<false, true>(DRp(l), DIp(l), FRp(l), FIp(l), cr, ci, wave, lane);
    twiddle<true>(cr, ci, tw, wave, lane);
    __syncthreads(); put_transposed(l, cr, ci, wave, lane); __syncthreads();
}
__device__ __forceinline__ void inverse_b(LAS unsigned char* l, f32x16 (&cr)[2], f32x16 (&ci)[2], int wave, int lane) {
    cstage<true, false>(FRp(l), FIp(l), DRp(l), DIp(l), cr, ci, wave, lane);
}
}

__device__ __forceinline__ void hyena_filter_task(Frame& F, int i, int L, int n0, float* gh, int npos = 64) {
    LAS float* lz = (LAS float*)F.lds;
    LAS float* l1 = lz + 64 * 33;
    LAS float* l2 = l1 + 64 * 64;
    LAS bf16* l2b = (LAS bf16*)(l2 + 64 * 64);
    const float* w1 = inp(F, I_HYW1) + i * 33 * 64; const float* b1 = inp(F, I_HYB1) + i * 64; const float* w2 = inp(F, I_HYW2) + i * 64 * 64; const float* b2 = inp(F, I_HYB2) + i * 64;
    const float* w3 = inp(F, I_HYW3) + (size_t)i * 64 * 1024; const float* fq = inp(F, I_HYFREQ) + i * 128;
    __syncthreads();
    for (int idx = F.tid; idx < npos * 33; idx += NTHR) { const int p = idx / 33, e = idx % 33; const float pos = (float)(n0 + p);
        float val;
        if (e == 0) val = pos / (float)(L - 1);
        else { const int jj = (e - 1) & 15; const float fr = 1e-4f + (float)jj * ((15.f - 1e-4f) / 15.f); const float ang = (6.283185307179586f / (float)L) * pos * fr; val = e <= 16 ? cosf(ang) : -sinf(ang); }
        lz[idx] = val; }
    __syncthreads();
    { const int k = F.tid & 63, pg = F.tid >> 6;
      float wr[33];
#pragma unroll
      for (int e = 0; e < 33; ++e) wr[e] = w1[e * 64 + k];
      const float bb = b1[k], ff = fq[k];
#pragma unroll 1
      for (int p = pg * (npos >> 3); p < (pg + 1) * (npos >> 3); ++p) { float s = bb;
#pragma unroll
          for (int e = 0; e < 33; ++e) s += lz[p * 33 + e] * wr[e];
          l1[p * 64 + k] = sinf(ff * s); } }
    __syncthreads();
    { const int k = F.tid & 63, pg = F.tid >> 6;
      float wr[64];
#pragma unroll
      for (int e = 0; e < 64; ++e) wr[e] = w2[e * 64 + k];
      const float bb = b2[k], ff = fq[64 + k];
#pragma unroll 1
      for (int p = pg * (npos >> 3); p < (pg + 1) * (npos >> 3); ++p) { float s = bb;
#pragma unroll
          for (int e4 = 0; e4 < 64; e4 += 4) { const f32x4 h = *(const LAS f32x4*)(l1 + p * 64 + e4); s += h.x * wr[e4] + h.y * wr[e4 + 1] + h.z * wr[e4 + 2] + h.w * wr[e4 + 3]; }
          const float hv = sinf(ff * s); l2[p * 64 + k] = hv; l2b[p * 64 + k] = (bf16)f2bf(hv); } }
    __syncthreads();
    if (npos == 64) {
        const bf16* wt3 = (const bf16*)(F.ws + WS_WT3) + (size_t)i * 1024 * 64; const int r32 = F.lane & 31, hi = F.lane >> 5;
        const float d0 = logf(1e-2f) / 0.3f, d1 = logf(1e-2f) / 1.5f;
        bf16x8 bfr[2][4];
#pragma unroll
        for (int pb = 0; pb < 2; ++pb)
#pragma unroll
            for (int ks = 0; ks < 4; ++ks) bfr[pb][ks] = *(const LAS bf16x8*)(l2b + (32 * pb + r32) * 64 + 16 * ks + 8 * hi);
#pragma unroll 1
        for (int cbi = 0; cbi < 4; ++cbi) { const int cb = 4 * F.wave + cbi; bf16x8 af[4];
#pragma unroll
            for (int ks = 0; ks < 4; ++ks) af[ks] = *(const bf16x8*)(wt3 + (size_t)(32 * cb + r32) * 64 + 16 * ks + 8 * hi);
#pragma unroll
            for (int pb = 0; pb < 2; ++pb) { f32x16 acc = {};
#pragma unroll
                for (int ks = 0; ks < 4; ++ks) acc = __builtin_amdgcn_mfma_f32_32x32x16_bf16(af[ks], bfr[pb][ks], acc, 0, 0, 0);
                const int pos = 32 * pb + r32; const float nt = -((float)(n0 + pos) / (float)(L - 1)) * LOG2E;
#pragma unroll
                for (int r = 0; r < 16; ++r) { const int col = 32 * cb + (r & 3) + 8 * (r >> 2) + 4 * hi, c = col & 511, dir = col >> 9;
                    const float delta = fabsf(d0 + (d1 - d0) * ((float)c / 511.f));
                    gh[((size_t)dir * 512 + c) * L + n0 + pos] = acc[r] * __builtin_amdgcn_exp2f(nt * delta); } } }
    } else
    {
      const int c = F.tid;
      const float d0 = logf(1e-2f) / 0.3f, d1 = logf(1e-2f) / 1.5f; const float delta = fabsf(d0 + (d1 - d0) * ((float)c / 511.f));
#pragma unroll 1
      for (int dir = 0; dir < 2; ++dir) { float w[64];
#pragma unroll
          for (int e = 0; e < 64; ++e) w[e] = w3[e * 1024 + dir * 512 + c];
          float* go = gh + ((size_t)dir * 512 + c) * L + n0;
#pragma unroll 1
          for (int p4 = 0; p4 < npos; p4 += 4) { f32x4 o;
#pragma unroll 1
              for (int pp = 0; pp < 4; ++pp) { const int p = p4 + pp; float sa = 0.f, sb = 0.f; asm volatile("" ::: "memory");
#pragma unroll
                  for (int e4 = 0; e4 < 64; e4 += 8) { const f32x4 h = *(const LAS f32x4*)(l2 + p * 64 + e4), g = *(const LAS f32x4*)(l2 + p * 64 + e4 + 4);
                      sa += h.x * w[e4] + h.y * w[e4 + 1] + h.z * w[e4 + 2] + h.w * w[e4 + 3]; sb += g.x * w[e4 + 4] + g.y * w[e4 + 5] + g.z * w[e4 + 6] + g.w * w[e4 + 7]; }
                  const float val = (sa + sb) * expf(-((float)(n0 + p) / (float)(L - 1)) * delta);
                  o.x = pp == 0 ? val : o.x; o.y = pp == 1 ? val : o.y; o.z = pp == 2 ? val : o.z; o.w = pp == 3 ? val : o.w; }
              *(f32x4*)(go + p4) = o; } } }
    __syncthreads();
}

constexpr size_t GHC_OFF = 12 * MiB;
constexpr size_t ZC_OFF = 10 * MiB + 1536 * 1024;
__device__ __forceinline__ float sconv(const bf16* P, int seq0, int L, int t, int col, float w0, float w1, float w2, float bias) {
    const bf16* p = P + (size_t)(seq0 + t) * OD_N + col;
    float s = bias + w1 * bf2f(p[0]);
    if (t > 0) s += w0 * bf2f(p[-OD_N]);
    if (t + 1 < L) s += w2 * bf2f(p[OD_N]);
    return s;
}
__device__ __forceinline__ void hyena_z_tile(Frame& F, int li, int seq0, int L, int t0, int c0, bf16* Zrow0  , int Lz) {
    LAS bf16* l1 = (LAS bf16*)F.lds;
    LAS bf16* l2 = l1 + 130 * 64;
    const bf16* P = (const bf16*)(F.ws + A_P);
    __syncthreads();
    for (int i = F.tid; i < 130 * 8 * 2; i += NTHR) { const int which = i / (130 * 8), r = (i % (130 * 8)) / 8, c8 = (i % 8) * 8, t = t0 - 1 + r;
        u32x4 w = {0u, 0u, 0u, 0u}; if (t >= 0 && t < L) w = *(const u32x4*)(P + (size_t)(seq0 + t) * OD_N + (which ? 1024 : 512) + c0 + c8);
        *(LAS u32x4*)((which ? l2 : l1) + r * 64 + c8) = w; }
    __syncthreads();
    const int c = F.tid & 63, tc = F.tid >> 6;
    const float* cw = inp(F, I_HYCW) + (size_t)li * 3 * 1536; const float* cb = inp(F, I_HYCB) + (size_t)li * 1536;
    const int ca = 512 + c0 + c, cv = 1024 + c0 + c;
    const float a0 = cw[ca], a1 = cw[1536 + ca], a2 = cw[3072 + ca], ab = cb[ca], v0 = cw[cv], v1 = cw[1536 + cv], v2 = cw[3072 + cv], vb = cb[cv];
    float xr[18], vr[18];
#pragma unroll
    for (int i = 0; i < 18; ++i) { xr[i] = bf2f(l1[(tc * 16 + i) * 64 + c]); vr[i] = bf2f(l2[(tc * 16 + i) * 64 + c]); }
    unsigned o[8];
#pragma unroll
    for (int i = 0; i < 16; i += 2) { float z[2];
#pragma unroll
        for (int k = 0; k < 2; ++k) { const int r = i + k + 1;
            const float x1 = ab + a0 * xr[r - 1] + a1 * xr[r] + a2 * xr[r + 1];
            const float vv = vb + v0 * vr[r - 1] + v1 * vr[r] + v2 * vr[r + 1];
            z[k] = x1 * vv; }
        o[i / 2] = pk2(z[0], z[1]); }
    bf16* dst = Zrow0 + (size_t)(c0 + c) * Lz + t0 + tc * 16;
    *(u32x4*)dst = (u32x4){o[0], o[1], o[2], o[3]}; *(u32x4*)(dst + 8) = (u32x4){o[4], o[5], o[6], o[7]};
}
__device__ __forceinline__ void hyena_z_compute(Frame& F, int li, int t0, int c0, bf16* Zrow0, int Lz) {
    LAS bf16* l1 = (LAS bf16*)F.lds; LAS bf16* l2 = l1 + 130 * 64;
    const int c = F.tid & 63, tc = F.tid >> 6;
    const float* cw = inp(F, I_HYCW) + (size_t)li * 3 * 1536; const float* cb = inp(F, I_HYCB) + (size_t)li * 1536;
    const int ca = 512 + c0 + c, cv = 1024 + c0 + c;
    const float a0 = cw[ca], a1 = cw[1536 + ca], a2 = cw[3072 + ca], ab = cb[ca], v0 = cw[cv], v1 = cw[1536 + cv], v2 = cw[3072 + cv], vb = cb[cv];
    float xr[18], vr[18];
#pragma unroll
    for (int i = 0; i < 18; ++i) { xr[i] = bf2f(l1[(tc * 16 + i) * 64 + c]); vr[i] = bf2f(l2[(tc * 16 + i) * 64 + c]); }
    unsigned o[8];
#pragma unroll
    for (int i = 0; i < 16; i += 2) { float z[2];
#pragma unroll
        for (int k = 0; k < 2; ++k) { const int r = i + k + 1;
            const float x1 = ab + a0 * xr[r - 1] + a1 * xr[r] + a2 * xr[r + 1];
            const float vv = vb + v0 * vr[r - 1] + v1 * vr[r] + v2 * vr[r + 1];
            z[k] = x1 * vv; }
        o[i / 2] = pk2(z[0], z[1]); }
    bf16* dst = Zrow0 + (size_t)(c0 + c) * Lz + t0 + tc * 16;
    *(u32x4*)dst = (u32x4){o[0], o[1], o[2], o[3]}; *(u32x4*)(dst + 8) = (u32x4){o[4], o[5], o[6], o[7]};
}
__device__ __forceinline__ void hyena_filter_fft_unit(Frame& F, int c, int par) {
    LAS unsigned char* l = F.lds; LAS f32x2* tw = (LAS f32x2*)(F.lds + fft::IMG_BYTES); LAS float* red = (LAS float*)(F.lds + fft::IMG_BYTES + 3072);
    const float* hf = (const float*)(F.ws + A_KVU) + (size_t)c * S; const float* hb = hf + (size_t)512 * S;
    __syncthreads();
    float an = 0.f;
    { const int n2 = F.tid & 127, g = F.tid >> 7;
#pragma unroll 1
      for (int it = 0; it < 4; ++it) { const int n1b = 32 * it + 8 * g; float fv[8], gv[8];
#pragma unroll
          for (int i = 0; i < 8; ++i) { const int n = 128 * (n1b + i) + n2; fv[i] = hf[n]; gv[i] = hb[n ? S - n : 0]; }
          float vr[8], vi[8];
#pragma unroll
          for (int i = 0; i < 8; ++i) { const int n = 128 * (n1b + i) + n2; const float f = fv[i], gg = n ? gv[i] : 0.f; an += fabsf(f) + fabsf(gg);
              if (par == 0) { vr[i] = f + gg; vi[i] = 0.f; } else { const f32x2 tt = fft::tw32k(tw, n); vr[i] = (f - gg) * tt.x; vi[i] = (f - gg) * tt.y; } }
          const int o = n2 * dft::RS + n1b;
          *(LAS u32x4*)(dft::DRp(l) + o) = (u32x4){pk2(vr[0], vr[1]), pk2(vr[2], vr[3]), pk2(vr[4], vr[5]), pk2(vr[6], vr[7])};
          *(LAS u32x4*)(dft::DIp(l) + o) = (u32x4){pk2(vi[0], vi[1]), pk2(vi[2], vi[3]), pk2(vi[4], vi[5]), pk2(vi[6], vi[7])}; } }
    an = wave_sum(an); if (F.lane == 0) red[F.wave] = an;
    f32x16 cr[2], ci[2];
    int ln = F.lane; asm volatile("" : "+v"(ln));
    dft::forward(l, tw, cr, ci, F.wave, ln);
    float nrm = 0.f;
#pragma unroll
    for (int w = 0; w < 8; ++w) nrm += red[w];
    const float sc = 1.f / (nrm * 2.f * (float)S);
    unsigned* G = (unsigned*)(F.ws + A_G) + ((size_t)c * 2 + par) * S;
#pragma unroll
    for (int t = 0; t < 2; ++t)
#pragma unroll
        for (int r = 0; r < 16; ++r) G[dft::erow(F.wave, ln, r) * 128 + dft::ecol(F.wave, ln, t)] = pk2(cr[t][r] * sc, ci[t][r] * sc);
}
__device__ __forceinline__ void hyena_conv_unit(Frame& F, int c, bool dry) {
    LAS unsigned char* l = F.lds; LAS f32x2* tw = (LAS f32x2*)(F.lds + fft::IMG_BYTES);
    bf16* z0 = (bf16*)(F.ws + A_ZY) + (size_t)c * S; bf16* z1 = z0 + (size_t)512 * S;
    const unsigned* G = (const unsigned*)(F.ws + A_G) + (size_t)c * 2 * S;
    unsigned* yeg = (unsigned*)(F.ws + WS_H) + (size_t)F.bx * S;
    f32x16 cr[2], ci[2];
#define EOFF(t, r) (32 * (t) + 128 * (((r) & 3) + 8 * ((r) >> 2)))
#pragma unroll 1
    for (int par = 0; par < 2; ++par) {
        int nb = 128 * (32 * (F.wave >> 1) + 4 * (F.lane >> 5)) + 64 * (F.wave & 1) + (F.lane & 31); asm volatile("" : "+v"(nb));
        int ln = F.lane; asm volatile("" : "+v"(ln));
        __syncthreads();
        { const int nb2 = F.tid & 15, g1 = F.tid >> 4; u32x4 a[4], b[4];
#pragma unroll
          for (int j = 0; j < 4; ++j) { const int n0 = 128 * (4 * g1 + j) + 8 * nb2; a[j] = *(const u32x4*)(z0 + n0); b[j] = *(const u32x4*)(z1 + n0); }
#pragma unroll
          for (int i = 0; i < 8; ++i) { float vr[4], vi[4];
#pragma unroll
              for (int j = 0; j < 4; ++j) { const unsigned wa = a[j][i >> 1], wb = b[j][i >> 1]; f32x2 v = {(i & 1) ? bfhi(wa) : bflo(wa), (i & 1) ? bfhi(wb) : bflo(wb)};
                  if (par) v = fft::cmul(v, fft::tw32k(tw, 128 * (4 * g1 + j) + 8 * nb2 + i)); vr[j] = v.x; vi[j] = v.y; }
              const int o = (8 * nb2 + i) * dft::RS + 4 * g1;
              *(LAS u32x2*)(dft::DRp(l) + o) = (u32x2){pk2(vr[0], vr[1]), pk2(vr[2], vr[3])}; *(LAS u32x2*)(dft::DIp(l) + o) = (u32x2){pk2(vi[0], vi[1]), pk2(vi[2], vi[3])}; } }
        dft::forward_a(l, tw, cr, ci, F.wave, ln);
        unsigned gq[2][16];
        { const unsigned* Gp = G + (size_t)par * S + nb;
#pragma unroll
          for (int t = 0; t < 2; ++t)
#pragma unroll
            for (int r = 0; r < 16; ++r) gq[t][r] = Gp[EOFF(t, r)]; }
        dft::forward_b(l, cr, ci, F.wave, ln);
#pragma unroll
        for (int t = 0; t < 2; ++t)
#pragma unroll
            for (int r = 0; r < 16; ++r) { const float gx = bflo(gq[t][r]), gy = bfhi(gq[t][r]); const float x = cr[t][r], y = ci[t][r]; cr[t][r] = x * gx - y * gy; ci[t][r] = x * gy + y * gx; }
        asm volatile("" : "+v"(ln));
        dft::inverse_a(l, tw, cr, ci, F.wave, ln);
        asm volatile("" : "+v"(nb));
        if (par == 0) { dft::inverse_b(l, cr, ci, F.wave, ln); unsigned* yp = yeg + nb;
#pragma unroll
            for (int t = 0; t < 2; ++t)
#pragma unroll
                for (int r = 0; r < 16; ++r) yp[EOFF(t, r)] = pk2(cr[t][r], ci[t][r]);
        } else { const unsigned* yp = yeg + nb; bf16* zp0 = z0 + nb; bf16* zp1 = z1 + nb;
#pragma unroll
            for (int t = 0; t < 2; ++t)
#pragma unroll
                for (int r = 0; r < 16; ++r) gq[t][r] = yp[EOFF(t, r)];
            dft::inverse_b(l, cr, ci, F.wave, ln);
#pragma unroll
            for (int t = 0; t < 2; ++t)
#pragma unroll
                for (int r = 0; r < 16; ++r) { const f32x2 v = fft::cmul((f32x2){cr[t][r], ci[t][r]}, fft::cconj(fft::tw32k(tw, nb + EOFF(t, r)))); const float ex = bflo(gq[t][r]), ey = bfhi(gq[t][r]);
                    if (!dry) { zp0[EOFF(t, r)] = (bf16)f2bf(ex + v.x); zp1[EOFF(t, r)] = (bf16)f2bf(ey + v.y); } }
        }
    }
#undef EOFF
}
__device__ __forceinline__ void hyena_ctx_conv_unit(Frame& F, int c_lo, int c_hi) {
    LAS float* lf = (LAS float*)F.lds; LAS float* lb = lf + 256; LAS float* lz = lb + 256; LAS float* red = lz + 512;
    const float* ghc = (const float*)(F.ws + GHC_OFF); bf16* zc = (bf16*)(F.ws + ZC_OFF);
    const int t = F.tid & 255, b = F.tid >> 8;
    for (int c = c_lo; c < c_hi; ++c) {
        __syncthreads();
        float an = 0.f;
        if (F.tid < 256) { const float f = ghc[(size_t)c * CL + t], g = ghc[((size_t)512 + c) * CL + t]; lf[t] = f; lb[t] = g; an = fabsf(f) + (t ? fabsf(g) : 0.f); }
        lz[b * 256 + t] = bf2f(zc[((size_t)b * 512 + c) * CL + t]);
        an = wave_sum(an); if (F.lane == 0) red[F.wave] = an;
        __syncthreads();
        float nrm = 0.f;
#pragma unroll
        for (int w = 0; w < 8; ++w) nrm += red[w];
        float y = 0.f;
        for (int s = 0; s <= t; ++s) y += lf[t - s] * lz[b * 256 + s];
        for (int s = t + 1; s < CL; ++s) y += lb[s - t] * lz[b * 256 + s];
        __syncthreads();
        zc[((size_t)b * 512 + c) * CL + t] = (bf16)f2bf(y / nrm);
    }
}
__device__ __forceinline__ void hyena_gate_tile(Frame& F, int li, int seq0, int L, int t0, int c0, const bf16* Yrow0, int Lz) {
    LAS bf16* l0 = (LAS bf16*)F.lds; LAS bf16* l1 = l0 + 130 * 64; LAS bf16* l2 = l1 + 130 * 64;
    const bf16* P = (const bf16*)(F.ws + A_P); bf16* MIX = (bf16*)(F.ws + A_MIX);
    __syncthreads();
    for (int i = F.tid; i < 130 * 8 * 3; i += NTHR) { const int which = i / (130 * 8), r = (i % (130 * 8)) / 8, c8 = (i % 8) * 8, t = t0 - 1 + r;
        u32x4 w = {0u, 0u, 0u, 0u}; if (t >= 0 && t < L) w = *(const u32x4*)(P + (size_t)(seq0 + t) * OD_N + which * 512 + c0 + c8);
        *(LAS u32x4*)((which == 0 ? l0 : which == 1 ? l1 : l2) + r * 64 + c8) = w; }
    __syncthreads();
    const int c = F.tid & 63, tc = F.tid >> 6;
    const float* cw = inp(F, I_HYCW) + (size_t)li * 3 * 1536; const float* cb = inp(F, I_HYCB) + (size_t)li * 1536;
    const int c0_ = c0 + c, ca = 512 + c0 + c, cv = 1024 + c0 + c;
    const float x0w0 = cw[c0_], x0w1 = cw[1536 + c0_], x0w2 = cw[3072 + c0_], x0b = cb[c0_];
    const float a0 = cw[ca], a1 = cw[1536 + ca], a2 = cw[3072 + ca], ab = cb[ca], v0 = cw[cv], v1 = cw[1536 + cv], v2 = cw[3072 + cv], vb = cb[cv];
    const float skip = inp(F, I_HYSKIP)[li * 512 + c0_];
    const bf16* ysrc = Yrow0 + (size_t)c0_ * Lz + t0 + tc * 16;
    const u32x4 ya = *(const u32x4*)ysrc, yb = *(const u32x4*)(ysrc + 8);
    const float yv[16] = {bflo(ya.x), bfhi(ya.x), bflo(ya.y), bfhi(ya.y), bflo(ya.z), bfhi(ya.z), bflo(ya.w), bfhi(ya.w), bflo(yb.x), bfhi(yb.x), bflo(yb.y), bfhi(yb.y), bflo(yb.z), bfhi(yb.z), bflo(yb.w), bfhi(yb.w)};
    float xr0[18], xr[18], vr[18];
#pragma unroll
    for (int i = 0; i < 18; ++i) { xr0[i] = bf2f(l0[(tc * 16 + i) * 64 + c]); xr[i] = bf2f(l1[(tc * 16 + i) * 64 + c]); vr[i] = bf2f(l2[(tc * 16 + i) * 64 + c]); }
#pragma unroll
    for (int i = 0; i < 16; ++i) { const int r = i + 1;
        const float x0 = x0b + x0w0 * xr0[r - 1] + x0w1 * xr0[r] + x0w2 * xr0[r + 1];
        const float x1 = ab + a0 * xr[r - 1] + a1 * xr[r] + a2 * xr[r + 1];
        const float vv = vb + v0 * vr[r - 1] + v1 * vr[r] + v2 * vr[r + 1];
        const float z = x1 * vv;
        MIX[(size_t)(seq0 + t0 + tc * 16 + i) * D + c0_] = (bf16)f2bf(x0 * (yv[i] + skip * z)); }
}

__device__ __forceinline__ void phase_odd_prep(Frame& F, int li, bool need_ctx) {
    const bf16* P = (const bf16*)(F.ws + A_P); float* rs = (float*)(F.ws + WS_MISC + MISC_RSTD);
    for (int r = F.gw; r < T; r += 8 * F.NGW) {
        u32x2 a[8]; unsigned b[8];
#pragma unroll
        for (int q = 0; q < 8; ++q) { const int rq = r + q * F.NGW; a[q] = (u32x2){0u, 0u}; b[q] = 0u;
            if (rq < T) { const bf16* p = P + (size_t)rq * OD_N + 1536; a[q] = *(const u32x2*)(p + 4 * F.lane); b[q] = *(const unsigned*)(p + 256 + 2 * F.lane); } }
#pragma unroll
        for (int q = 0; q < 8; ++q) { const int rq = r + q * F.NGW;
            if (rq < T) {
                float s1 = bflo(a[q].x) * bflo(a[q].x) + bfhi(a[q].x) * bfhi(a[q].x) + bflo(a[q].y) * bflo(a[q].y) + bfhi(a[q].y) * bfhi(a[q].y), s2 = bflo(b[q]) * bflo(b[q]) + bfhi(b[q]) * bfhi(b[q]);
                s1 = wave_sum(s1); s2 = wave_sum(s2);
                if (F.lane == 0) { rs[rq] = 1.f / sqrtf(s1 * (1.f / 256.f) + EPS); rs[T + rq] = 1.f / sqrtf(s2 * (1.f / 128.f) + EPS); } } }
    }
    const int nz = 2048 + (need_ctx ? 32 : 0);
    {
        const bf16* Pz = (const bf16*)(F.ws + A_P);
        LAS bf16* l1 = (LAS bf16*)F.lds; LAS bf16* l2 = l1 + 130 * 64;
        auto zgeo = [&](int u, int& seq0, int& L, int& t0, int& c0, bf16*& Zr, int& Lz) {
            if (u < 2048) { const int cc = u & 7, tt = (u >> 3) & 127, b = u >> 10; seq0 = b * S; L = S; t0 = tt * 128; c0 = cc * 64; Zr = (bf16*)(F.ws + A_ZY) + (size_t)b * 512 * S; Lz = S; }
            else { const int uu = u - 2048, cc = uu & 7, tt = (uu >> 3) & 1, b = uu >> 4; seq0 = TL + b * CL; L = CL; t0 = tt * 128; c0 = cc * 64; Zr = (bf16*)(F.ws + ZC_OFF) + (size_t)b * 512 * CL; Lz = CL; } };
        u32x4 nw[5];
        auto zfetch = [&](int u) { int seq0, L, t0, c0, Lz; bf16* Zr; zgeo(u, seq0, L, t0, c0, Zr, Lz);
#pragma unroll
            for (int k = 0; k < 5; ++k) { const int i = F.tid + NTHR * k; nw[k] = (u32x4){0u, 0u, 0u, 0u};
                if (i < 130 * 8 * 2) { const int which = i / (130 * 8), r = (i % (130 * 8)) / 8, c8 = (i % 8) * 8, t = t0 - 1 + r;
                    if (t >= 0 && t < L) nw[k] = *(const u32x4*)(Pz + (size_t)(seq0 + t) * OD_N + (which ? 1024 : 512) + c0 + c8); } } };
        if (F.vcu < nz) zfetch(F.vcu);
        for (int u = F.vcu; u < nz; u += F.G) {
            int seq0, L, t0, c0, Lz; bf16* Zr; zgeo(u, seq0, L, t0, c0, Zr, Lz);
            __syncthreads();
#pragma unroll
            for (int k = 0; k < 5; ++k) { const int i = F.tid + NTHR * k;
                if (i < 130 * 8 * 2) { const int which = i / (130 * 8), r = (i % (130 * 8)) / 8, c8 = (i % 8) * 8; *(LAS u32x4*)((which ? l2 : l1) + r * 64 + c8) = nw[k]; } }
            if (u + F.G < nz) zfetch(u + F.G);
            __syncthreads();
            hyena_z_compute(F, li, t0, c0, Zr, Lz);
        }
    }
    __syncthreads(); dft::load_F(F.lds, F.ws, F.tid); fft::init_tables((LAS f32x2*)(F.lds + fft::IMG_BYTES), F.tid); __syncthreads();
    for (int u = F.vcu; u < 1024; u += F.G) hyena_filter_fft_unit(F, u >> 1, u & 1);
    __syncthreads();
}
constexpr float MLA_C2 = 0.10206207261596577f * LOG2E;
__device__ __forceinline__ bool mla_fast(const Frame& F, int li) {
    float mq = 0.f, mk = 0.f;
    for (int j = 0; j < 96; ++j) { mq = fmaxf(mq, fabsf(inp(F, I_MQG)[li * 96 + j])); mk = fmaxf(mk, fabsf(inp(F, I_MKG)[li * 96 + j])); }
    return 9.797958971f * LOG2E * mq * mk * 1.01f < 40.f;
}
__device__ __forceinline__ void phase_mla_prep(Frame& F, int li, bool dry = false) {
    const bf16* P = (const bf16*)(F.ws + A_P); bf16* QU = (bf16*)(F.ws + A_QU); bf16* KVU = (bf16*)(F.ws + A_KVU);
    const f32x2* r32t = (const f32x2*)(F.ws + WS_ROPE) + (size_t)S * 32;
    const bool fast = mla_fast(F, li);
    const int hd = fast ? 8 + ((F.lane >> 2) & 7) : F.lane >> 2, qt = F.lane & 3, isk = hd >= 8, h = hd & 7, RP = fast ? 2 : 1, sub = fast ? F.lane >> 5 : 0, NR = T / RP;
    const float* gain = (isk ? inp(F, I_MKG) : inp(F, I_MQG)) + li * 96 + 24 * qt;
    float gn[24];
#pragma unroll
    for (int j = 0; j < 24; ++j) gn[j] = gain[j] * (isk ? 1.f : MLA_C2);
    u32x4 nw[3];
    auto ld3 = [&](int rr, u32x4 (&w3)[3]) { const bf16* bs = isk ? KVU + (size_t)rr * KVU_N + 160 * h : QU + (size_t)rr * QU_N + 96 * h;
#pragma unroll
        for (int j8 = 0; j8 < 3; ++j8) { const int e0 = 24 * qt + 8 * j8;
            if (isk && e0 >= 64) w3[j8] = *(const u32x4*)(P + (size_t)rr * OD_N + 1920 + (e0 - 64)); else w3[j8] = *(const u32x4*)(bs + e0); } };
    if (F.gw < NR) ld3(F.gw * RP + sub, nw);
    for (int rq = F.gw; rq < NR; rq += F.NGW) {
        const int r = rq * RP + sub;
        bf16* base = isk ? KVU + (size_t)r * KVU_N + 160 * h : QU + (size_t)r * QU_N + 96 * h;
        float v[24]; u32x4 cw[3];
#pragma unroll
        for (int j8 = 0; j8 < 3; ++j8) cw[j8] = nw[j8];
        if (rq + F.NGW < NR) ld3((rq + F.NGW) * RP + sub, nw);
#pragma unroll
        for (int j8 = 0; j8 < 3; ++j8) { const u32x4 w = cw[j8];
            v[8 * j8 + 0] = bflo(w.x); v[8 * j8 + 1] = bfhi(w.x); v[8 * j8 + 2] = bflo(w.y); v[8 * j8 + 3] = bfhi(w.y); v[8 * j8 + 4] = bflo(w.z); v[8 * j8 + 5] = bfhi(w.z); v[8 * j8 + 6] = bflo(w.w); v[8 * j8 + 7] = bfhi(w.w); }
        float ss = 0.f;
#pragma unroll
        for (int j = 0; j < 24; ++j) ss += v[j] * v[j];
        ss += dpp_f<0xB1>(ss); ss += dpp_f<0x4E>(ss);
        const float rstd = 1.f / sqrtf(ss * (1.f / 96.f) + EPS);
#pragma unroll
        for (int j = 0; j < 24; ++j) v[j] *= rstd * gn[j];
        if (r < TL) {
            const int s = r % S; const f32x2* cs = r32t + (size_t)s * 16;
            float x2lo[8], x1lo[8];
#pragma unroll
            for (int i = 0; i < 8; ++i) { x2lo[i] = dpp_f<0xB1>(v[8 + i]); x1lo[i] = dpp_f<0xB1>(v[16 + i]); }
            if (qt == 2) {
#pragma unroll
                for (int i = 0; i < 8; ++i) { const f32x2 c = cs[i]; v[16 + i] = v[16 + i] * c.x - x2lo[i] * c.y; }
            } else if (qt == 3) {
#pragma unroll
                for (int i = 0; i < 8; ++i) { const f32x2 c = cs[i]; const float x2 = v[8 + i]; v[8 + i] = x2 * c.x + x1lo[i] * c.y; }
#pragma unroll
                for (int i = 0; i < 8; ++i) { const f32x2 c = cs[8 + i]; const float x1 = v[i], x2 = v[16 + i]; v[i] = x1 * c.x - x2 * c.y; v[16 + i] = x2 * c.x + x1 * c.y; }
            }
        }
#pragma unroll
        for (int j8 = 0; j8 < 3; ++j8) if (!dry) *(u32x4*)(base + 24 * qt + 8 * j8) = (u32x4){pk2(v[8 * j8], v[8 * j8 + 1]), pk2(v[8 * j8 + 2], v[8 * j8 + 3]), pk2(v[8 * j8 + 4], v[8 * j8 + 5]), pk2(v[8 * j8 + 6], v[8 * j8 + 7])};
    }
}
template <int EX = 0> __device__ __forceinline__ void phase_mla(Frame& F, int li, bool need_ctx) {
    const bf16* QU = (const bf16*)(F.ws + A_QU); const bf16* KVU = (const bf16*)(F.ws + A_KVU); bf16* MIX = (bf16*)(F.ws + A_MIX);
    const int nlat = NB * MLA_H * (S / 256), nctx = need_ctx ? NB * MLA_H : 0;
    const bool fast = mla_fast(F, li);
    asm volatile("s_waitcnt vmcnt(0)" ::: "memory");
    for (int u = F.vcu; u < nlat + nctx; u += F.G) {
        att::Unit U; U.ldq = QU_N; U.ldk = KVU_N; U.ldo = D; U.has_sink = 0; U.sink = 0.f; U.mask = 0; U.kb0 = 0; U.q0 = 0; U.rlo = 0; U.rhi = T;
        U.qprep = fast ? 1 : 0; U.qgain = inp(F, I_MQG) + li * 96; U.ropet = (const f32x2*)(F.ws + WS_ROPE) + (size_t)S * 32; U.qc2 = MLA_C2;
        if (u < nlat) { const int qb = u % (S / 256), h = (u / (S / 256)) % MLA_H, b = u / (MLA_H * (S / 256)), row0 = b * S + qb * 256;
            U.Q = QU + (size_t)row0 * QU_N + 96 * h; U.K = KVU + 160 * h; U.V = KVU + 160 * h + 96;
            U.nA = S / 64; U.rowA = b * S; U.nB = CL / 64; U.rowB = TL + b * CL; U.O = MIX + (size_t)row0 * D + 512 + 64 * h; U.qrope = 1; U.qpos0 = qb * 256; }
        else { const int uu = u - nlat, h = uu % MLA_H, b = uu / MLA_H, row0 = TL + b * CL;
            U.Q = QU + (size_t)row0 * QU_N + 96 * h; U.K = KVU + 160 * h; U.V = KVU + 160 * h + 96;
            U.nA = CL / 64; U.rowA = row0; U.nB = 0; U.rowB = 0; U.O = MIX + (size_t)row0 * D + 512 + 64 * h; U.qrope = 0; U.qpos0 = 0; }
        if constexpr (EX > 0) att::attn_unit_dma_x<96, EX>(U, (LAS char*)F.lds, F.tid);
        else { if (fast) att::ATTN_FAST<96>(U, (LAS char*)F.lds, F.tid); else att::attn_unit<96>(U, (LAS char*)F.lds, F.tid); }
    }
    __syncthreads();
}
__device__ __forceinline__ void phase_hyena_conv(Frame& F, int li, bool need_ctx, bool dry = false) {
    __syncthreads(); dft::load_F(F.lds, F.ws, F.tid); fft::init_tables((LAS f32x2*)(F.lds + fft::IMG_BYTES), F.tid); __syncthreads();
    unsigned* ctr = (unsigned*)(F.ws + WS_CTL) + CW_WQ + 64 * (li * 2 + (dry ? 1 : 0)); LAS int* sh = (LAS int*)(F.lds + fft::IMG_BYTES + 3584);
    for (;;) {
        __syncthreads();
        if (F.tid == 0) *sh = (int)atomicAdd(ctr, 1u);
        __syncthreads();
        const int c = *sh;
        if (c >= 512) break;
        hyena_conv_unit(F, c, dry);
    }
    __syncthreads();
}
__device__ __forceinline__ void phase_hyena_ctx_conv(Frame& F, int li, bool need_ctx) {
    if (need_ctx) for (int c = F.vcu; c < 512; c += F.G) hyena_ctx_conv_unit(F, c, c + 1);
    __syncthreads();
}
__device__ __forceinline__ void phase_hyena_gate(Frame& F, int li, bool need_ctx) {
    const int nz = 2048 + (need_ctx ? 32 : 0);
    for (int u = F.vcu; u < nz; u += F.G) {
        if (u < 2048) { const int cc = u & 7, tt = (u >> 3) & 127, b = u >> 10; hyena_gate_tile(F, li, b * S, S, tt * 128, cc * 64, (const bf16*)(F.ws + A_ZY) + (size_t)b * 512 * S, S); }
        else { const int uu = u - 2048, cc = uu & 7, tt = (uu >> 3) & 1, b = uu >> 4; hyena_gate_tile(F, li, TL + b * CL, CL, tt * 128, cc * 64, (const bf16*)(F.ws + ZC_OFF) + (size_t)b * 512 * CL, CL); }
    }
    __syncthreads();
}


__device__ __forceinline__ void ph_gemm_store(Frame& F, const bf16* A, const bf16* Bt, int lda, int K, int M, int N, bf16* O, int ldc, const float* rowscale, bool rev = false) {
    asm volatile("" : "+s"(K), "+s"(lda)); pg8::Gemm g{A, Bt, lda, K}; pg8::StaticOrder So; So.init(M, N, F.G, rev ? F.G - 1 - F.bx : F.bx); pg8::EpiStoreBf16 E{O, ldc, rowscale}; pg8::gemm_phase(F.lds, g, So, E, F.tid);
}
__device__ __forceinline__ void ph_gemm_res(Frame& F, const bf16* A, const bf16* Bt, int M, const float* srcL, float* dstL, const float* srcC, float* dstC, const float* gate, float on) {
    pg8::Gemm g{A, Bt, D, D}; pg8::StaticOrder So; So.init(M, D, F.G, F.bx); pg8::EpiResidual E{srcL, dstL, srcC, dstC, gate, on}; pg8::gemm_phase(F.lds, g, So, E, F.tid);
}
__device__ __forceinline__ void ph_gemm_res2(Frame& F, const bf16* A, int M) {
    pg8::Gemm g{A, (const bf16*)(F.ws + WS_WOS), D, D}; pg8::ResOrder So; So.init(M, D, F.G, F.bx); pg8::EpiResInit E{(const bf16*)(F.ws + WS_HB), (bf16*)(F.ws + WS_HB)}; pg8::gemm_phase(F.lds, g, So, E, F.tid);
}
__device__ __forceinline__ void ph_gemm_moe_gu(Frame& F, int l) {
    const int ntiles = moe_tile_table(F, l); pg8::Gemm g{(const bf16*)(F.ws + WS_H), (const bf16*)(F.ws + WS_WMOE), D, D};
    pg8::MoeGatherOrder So; So.tab = (const LAS i32x4*)(F.lds + 131072); So.ntiles = ntiles; So.nN = 4; So.G = F.G; So.c = F.vcu; So.list = (const int*)(F.ws + WS_LIST);
    pg8::EpiSwiglu E{(bf16*)(F.ws + A_ACT)}; pg8::gemm_phase_gather(F.lds, g, So, E, F.tid);
}
__device__ __forceinline__ void ph_gemm_moe_down(Frame& F, int l) {
    const int ntiles = moe_tile_table(F, l); pg8::Gemm g{(const bf16*)(F.ws + A_ACT), (const bf16*)(F.ws + WS_WMOE) + (size_t)NE * 1024 * 1024, FF, FF};
    pg8::MoeOrder So; So.tab = (const LAS i32x4*)(F.lds + 131072); So.ntiles = ntiles; So.nN = 4; So.G = F.G; So.c = F.vcu;
    pg8::EpiStoreBf16 E{(bf16*)(F.ws + A_YS), D, nullptr}; pg8::gemm_phase<pg8::EpiStoreBf16, pg8::MoeOrder, GEMM_ALIGN_MD>(F.lds, g, So, E, F.tid);
}


__device__ __forceinline__ void ph_gemm_moe_down_x(Frame& F, int l) {
    const int ntiles = moe_tile_table(F, l); pg8::Gemm g{(const bf16*)(F.ws + A_ACT), (const bf16*)(F.ws + WS_WMOE) + (size_t)NE * 1024 * 1024, FF, FF};
    pg8::MoeOrder So; So.tab = (const LAS i32x4*)(F.lds + 131072); So.ntiles = ntiles; So.nN = 4; So.G = F.G; So.c = F.vcu;
    pg8::EpiNull E{}; pg8::gemm_phase(F.lds, g, So, E, F.tid);
}
template <int MODE>
__device__ __forceinline__ void ctx_gemm(Frame& F, const bf16* A, int lda, int K, const bf16* Wt, int N, bf16* O, int ldc, const float* rowscale, const float* xsrc, float* xdst, bool rev = false) {
    LAS float* part = (LAS float*)F.lds;
    const int lane = F.lane, w = F.wave, r32 = lane & 31, hi = lane >> 5, kw = K / 8, npieces = 16 * (N / 64);
    for (int pc = rev ? F.G - 1 - F.vcu : F.vcu; pc < npieces; pc += F.G) {
        const int row0 = (pc & 15) * 32, n0 = (pc >> 4) * 64;
        f32x16 a0 = {}, a1 = {};
        const bf16* ap = A + (size_t)(row0 + r32) * lda + w * kw + 8 * hi;
        const bf16* bp0 = Wt + (size_t)(n0 + r32) * K + w * kw + 8 * hi; const bf16* bp1 = bp0 + (size_t)32 * K;
#pragma unroll 2
        for (int ks = 0; ks < kw; ks += 16) { const bf16x8 af = *(const bf16x8*)(ap + ks), b0 = *(const bf16x8*)(bp0 + ks), b1 = *(const bf16x8*)(bp1 + ks);
            a0 = __builtin_amdgcn_mfma_f32_32x32x16_bf16(af, b0, a0, 0, 0, 0); a1 = __builtin_amdgcn_mfma_f32_32x32x16_bf16(af, b1, a1, 0, 0, 0); }
        __syncthreads();
#pragma unroll
        for (int r = 0; r < 16; ++r) { part[(w * 32 + r) * 64 + lane] = a0[r]; part[(w * 32 + 16 + r) * 64 + lane] = a1[r]; }
        __syncthreads();
#pragma unroll
        for (int q = 0; q < 4; ++q) { const int idx = F.tid + NTHR * q, reg = idx >> 6, ln = idx & 63; float s = 0.f;
#pragma unroll
            for (int ww = 0; ww < 8; ++ww) s += part[(ww * 32 + reg) * 64 + ln];
            const int r16 = reg & 15, col = 32 * (reg >> 4) + (ln & 31), row = (r16 & 3) + 8 * (r16 >> 2) + 4 * (ln >> 5), gr = row0 + row, gc = n0 + col;
            if (MODE == 0) O[(size_t)(TL + gr) * ldc + gc] = (bf16)f2bf(s * (rowscale ? rowscale[TL + gr] : 1.f));
            else xdst[(size_t)gr * D + gc] = xsrc[(size_t)gr * D + gc] + s; }
    }
    __syncthreads();
}

__global__ void __launch_bounds__(NTHR, 2) mk_fwd(Args args) {
    extern __shared__ __attribute__((aligned(16))) unsigned char lds_raw[];
    Frame F;
    F.lds = (LAS unsigned char*)lds_raw; F.in = (const LAS unsigned long long*)(F.lds + LDSCTL_OFF + 512); F.out = args.out; F.ws = args.ws;
    F.tid = threadIdx.x; F.lane = F.tid & 63; F.wave = __builtin_amdgcn_readfirstlane(F.tid >> 6);
    F.G = gridDim.x; F.bx = blockIdx.x; F.vcu = F.bx; F.gw = 0; F.NGW = F.G * NWAVES;
    volatile LAS unsigned* MISC = (volatile LAS unsigned*)(F.lds + MISC_OFF);
    for (int u = F.tid; u < (LDS_BYTES - LDSCTL_OFF) / 4; u += NTHR) ((LAS unsigned*)(F.lds + LDSCTL_OFF))[u] = 0u;
    __syncthreads();
    if (F.tid == 0) { LAS unsigned long long* tab = (LAS unsigned long long*)(F.lds + LDSCTL_OFF + 512);
#pragma unroll
        for (int i = 0; i < 36; ++i) tab[i] = (unsigned long long)args.in[i]; }
    __syncthreads();
    const int lo = args.ph_lo, hi = args.ph_hi;
    XcdBarrier bar; bar.bar = (unsigned*)(F.ws + WS_CTL) + CW_BAR; bar.x = 0; bar.st = nullptr;
    if (hi - lo > 1) bar = xcd_barrier_post((unsigned*)(F.ws + WS_CTL) + CW_BAR, MISC + 8);
    int k = 0;
#if PROBE_KIND >= 0
#define pacc ((LAS float*)(F.lds + LDSCTL_OFF + 1024))
#define plast ((LAS unsigned long long*)(F.lds + LDSCTL_OFF + 1024 + 256))
    if (threadIdx.x == 0) { plast[0] = __builtin_amdgcn_s_memrealtime(); plast[1] = plast[0]; }
#define PROBE_ADD(kind) do { if (threadIdx.x == 0) { const unsigned long long n_ = __builtin_amdgcn_s_memrealtime(); pacc[kind] += (float)(n_ - plast[0]); plast[0] = n_; } } while (0)
#define pwait ((LAS float*)(F.lds + LDSCTL_OFF + 1536))
#define PROBE_WAIT(kind, stmt) do { if (threadIdx.x == 0) plast[2] = __builtin_amdgcn_s_memrealtime(); stmt; if (threadIdx.x == 0) { const float w_ = (float)(__builtin_amdgcn_s_memrealtime() - plast[2]); pacc[31] += w_; pwait[kind] += w_; } } while (0)
#else
#define PROBE_ADD(kind) do {} while (0)
#define PROBE_WAIT(kind, stmt) stmt
#endif
#define REOPAQUE { int t_ = threadIdx.x; asm volatile("" : "+v"(t_)); F.tid = t_; F.lane = t_ & 63; F.wave = __builtin_amdgcn_readfirstlane(t_ >> 6); \
        int b_ = blockIdx.x; asm volatile("" : "+s"(b_)); F.bx = b_; F.vcu = (F.G % 8 == 0) ? (b_ % 8) * (F.G / 8) + b_ / 8 : b_; F.gw = F.vcu * NWAVES + F.wave; \
        unsigned char* w_ = args.ws; asm volatile("" : "+s"(w_)); F.ws = w_; float* o_ = args.out; asm volatile("" : "+s"(o_)); F.out = o_; int g_ = gridDim.x; asm volatile("" : "+s"(g_)); F.G = g_; F.NGW = g_ * NWAVES; }
#define PH_BEGIN if (lo <= k && k < hi) { REOPAQUE
#define PH_END_K(kind) if (k + 1 < hi) PROBE_WAIT(kind, xcd_barrier(bar)); PROBE_ADD(kind); } ++k;
#define PH_END PH_END_K(30)
#define DUP2(kind, ...) { __VA_ARGS__; } if ((DUP_MASK >> (kind)) & 1) { __syncthreads(); REOPAQUE __VA_ARGS__; }
#define DUPX(kind, ...) if ((DUP_MASK >> (kind)) & 1) { __syncthreads(); REOPAQUE __VA_ARGS__; }
#define PH_END_NOBAR_K(kind) __syncthreads(); PROBE_ADD(kind); }
#define PH_END_NOBAR PH_END_NOBAR_K(30)
    LAS unsigned char* glds = F.lds;
#define wsm ((bf16*)(F.ws + WS_WSM))
#define H ((bf16*)(F.ws + WS_H))
#define P ((bf16*)(F.ws + A_P))
#define MIX ((bf16*)(F.ws + A_MIX))
#define XC ((float*)(F.ws + WS_XC))

    PH_BEGIN DUP2(0, phase_prologue(F)) PH_END_K(0)

#pragma unroll 1
    for (int lp = 0; lp < 2; ++lp) {
        {
            const int l = 2 * lp, li = lp; const bool need_ctx = true;
            PH_BEGIN phase_norm1(F, l); DUPX(12, phase_norm1(F, l, 0.f)) __syncthreads(); DUP2(11, moe_weight_convert(F, l)) __syncthreads(); wout_scaled_convert(F, l, (STOP_AFTER >= 2 * l + 1) ? 1.f : 0.f); PH_END_K(1)
            PH_BEGIN DUP2(1, (ph_gemm_store(F, H, (const bf16*)((const char*)wsm + W_EIN) + (size_t)li * EV_N * D, D, D, TL, EV_N, P, EV_N, nullptr), ctx_gemm<0>(F, H + (size_t)TL * D, D, D, (const bf16*)((const char*)wsm + W_EIN) + (size_t)li * EV_N * D, EV_N, P, EV_N, nullptr, nullptr, nullptr))) PH_END_K(3)
            PH_BEGIN phase_even_qk(F, li); DUPX(17, phase_even_qk(F, li, true)) PH_END_NOBAR_K(5)
            PH_BEGIN DUP2(15, phase_even_pool(F, li, 0, F.G >= 64 ? TL / 32 : T / 32)) PH_END_K(5)
            PH_BEGIN DUP2(2, phase_swa(F, li, need_ctx)) PH_END_K(6)
            PH_BEGIN ph_gemm_res2(F, MIX, TL); ctx_gemm<1>(F, MIX + (size_t)TL * D, D, D, (const bf16*)(F.ws + WS_WOS) + (size_t)2 * D * D, D, nullptr, 0, nullptr, l == 0 ? inp(F, I_CTX) : XC, XC); PH_END_K(7)
            PH_BEGIN phase_norm2_route(F, l); DUPX(13, phase_norm2_route(F, l, true)) PH_END_K(8)
            PH_BEGIN DUP2(4, ph_gemm_moe_gu(F, l)) PH_END_K(10)
            PH_BEGIN ph_gemm_moe_down(F, l); DUPX(5, ph_gemm_moe_down(F, l)) DUPX(20, ph_gemm_moe_down_x(F, l)) PH_END_K(11)
        }
        {
            const int l = 2 * lp + 1, li = lp; const bool need_ctx = (l < DEPTH - 1); const int Mx = need_ctx ? T : TL;
            PH_BEGIN phase_norm1(F, l); DUPX(12, phase_norm1(F, l, 0.f)) __syncthreads(); DUP2(11, moe_weight_convert(F, l)) __syncthreads(); wout_scaled_convert(F, l, (STOP_AFTER >= 2 * l + 1) ? 1.f : 0.f);
                DUP2(10, for (int t = F.vcu; t < S / 64 + (need_ctx ? CL / 8 : 0); t += F.G) { if (t < S / 64) hyena_filter_task(F, li, S, t * 64, (float*)(F.ws + A_KVU)); else hyena_filter_task(F, li, CL, (t - S / 64) * 8, (float*)(F.ws + GHC_OFF), 8); })
            PH_END_K(2)
            PH_BEGIN DUP2(1, (ph_gemm_store(F, H, (const bf16*)((const char*)wsm + W_OIN) + (size_t)li * OD_N * D, D, D, TL, OD_N, P, OD_N, nullptr), ctx_gemm<0>(F, H + (size_t)TL * D, D, D, (const bf16*)((const char*)wsm + W_OIN) + (size_t)li * OD_N * D, OD_N, P, OD_N, nullptr, nullptr, nullptr))) PH_END_K(4)
            PH_BEGIN DUP2(7, phase_odd_prep(F, li, need_ctx)) PH_END_K(12)
            PH_BEGIN DUP2(9, (ph_gemm_store(F, P + 1536, (const bf16*)((const char*)wsm + W_UQ) + (size_t)li * QU_N * 256, OD_N, 256, TL, QU_N, (bf16*)(F.ws + A_QU), QU_N, (const float*)(F.ws + WS_MISC + MISC_RSTD)), ctx_gemm<0>(F, P + (size_t)TL * OD_N + 1536, OD_N, 256, (const bf16*)((const char*)wsm + W_UQ) + (size_t)li * QU_N * 256, QU_N, (bf16*)(F.ws + A_QU), QU_N, (const float*)(F.ws + WS_MISC + MISC_RSTD), nullptr, nullptr))) PH_END_NOBAR_K(13)
            PH_BEGIN DUP2(9, (ph_gemm_store(F, P + 1792, (const bf16*)((const char*)wsm + W_UKV) + (size_t)li * KVU_N * 256, OD_N, 256, TL, KVU_N, (bf16*)(F.ws + A_KVU), KVU_N, (const float*)(F.ws + WS_MISC + MISC_RSTD) + T, true), ctx_gemm<0>(F, P + (size_t)TL * OD_N + 1792, OD_N, 256, (const bf16*)((const char*)wsm + W_UKV) + (size_t)li * KVU_N * 256, KVU_N, (bf16*)(F.ws + A_KVU), KVU_N, (const float*)(F.ws + WS_MISC + MISC_RSTD) + T, nullptr, nullptr, true))) PH_END_K(13)
            PH_BEGIN phase_mla_prep(F, li); DUPX(16, phase_mla_prep(F, li, true)) PH_END_K(14)
            PH_BEGIN phase_mla(F, li, need_ctx); DUPX(3, phase_mla<MLA_EXPT>(F, li, need_ctx)) PH_END_NOBAR_K(15)
            PH_BEGIN phase_hyena_ctx_conv(F, li, need_ctx); PH_END_NOBAR_K(20)
            PH_BEGIN phase_hyena_conv(F, li, need_ctx); DUPX(14, phase_hyena_conv(F, li, need_ctx, true)) PH_END_K(19)
            PH_BEGIN DUP2(8, phase_hyena_gate(F, li, need_ctx)) PH_END_K(16)
            PH_BEGIN ph_gemm_res2(F, MIX, TL); if (need_ctx) ctx_gemm<1>(F, MIX + (size_t)TL * D, D, D, (const bf16*)(F.ws + WS_WOS) + (size_t)2 * D * D, D, nullptr, 0, nullptr, XC, XC); PH_END_K(17)
            PH_BEGIN phase_norm2_route(F, l); DUPX(13, phase_norm2_route(F, l, true)) PH_END_K(8)
            PH_BEGIN DUP2(4, ph_gemm_moe_gu(F, l)) PH_END_K(10)
            PH_BEGIN ph_gemm_moe_down(F, l); DUPX(5, ph_gemm_moe_down(F, l)) DUPX(20, ph_gemm_moe_down_x(F, l)) PH_END_K(11)
        }
    }
    PH_BEGIN phase_final(F); DUPX(19, phase_final(F, 0.f)) PH_END_K(18)
#if PROBE_KIND >= 0
    {
        float* diag = (float*)(F.ws + WS_MISC + 900 * 1024);
        if (threadIdx.x == 0) { pacc[29] = (float)(__builtin_amdgcn_s_memrealtime() - plast[1]); __hip_atomic_store(diag + 2 * blockIdx.x, PROBE_KIND >= 100 ? pwait[PROBE_KIND - 100] : pacc[PROBE_KIND >= 100 ? 0 : PROBE_KIND], __ATOMIC_RELAXED, __HIP_MEMORY_SCOPE_AGENT); __hip_atomic_store(diag + 2 * blockIdx.x + 1, pacc[29], __ATOMIC_RELAXED, __HIP_MEMORY_SCOPE_AGENT); }
        xcd_barrier(bar);
        float a = 0.f, b = 0.f; for (int i = 0; i < (int)gridDim.x; ++i) { a += __hip_atomic_load(diag + 2 * i, __ATOMIC_RELAXED, __HIP_MEMORY_SCOPE_AGENT); b += __hip_atomic_load(diag + 2 * i + 1, __ATOMIC_RELAXED, __HIP_MEMORY_SCOPE_AGENT); }
        float fr_ = a / b; if (PROBE_Q > 0) fr_ = floorf(fr_ * PROBE_Q + 0.5f) / PROBE_Q; const float sc = 1.f + 0.1f + PROBE_MUL * fr_;
        for (size_t i = (size_t)blockIdx.x * NTHR + threadIdx.x; i < (size_t)TL * D / 4; i += (size_t)gridDim.x * NTHR) { f32x4 v = ((f32x4*)args.out)[i]; ((f32x4*)args.out)[i] = v * sc; }
    }
#endif
#undef PH_BEGIN
#undef PH_END
#undef DUP2
#undef DUPX
#undef REOPAQUE
#undef PH_END_NOBAR
#undef wsm
#undef H
#undef P
#undef MIX
#undef XC
}
constexpr int N_PHASES = 1 + 2 * (8 + 11) + 1;

extern "C" void kernel_launch(void* const* d_in, const int* in_sizes, int n_in, void* d_out, int out_size, void* d_ws, size_t ws_size, hipStream_t stream) {
    static int grid = 0;
    if (grid == 0) {
        if (n_in != 36 || out_size != TL * D || ws_size < WS_END) { fprintf(stderr, "kernel_launch: shape mismatch: n_in %d out %d ws %zu (need %zu)\n", n_in, out_size, ws_size, (size_t)WS_END); grid = -1; return; }
        int dev = 0, cus = 0, per_cu = 0;
        if (hipGetDevice(&dev) != hipSuccess || hipDeviceGetAttribute(&cus, hipDeviceAttributeMultiprocessorCount, dev) != hipSuccess) { grid = -1; return; }
        if (hipFuncSetAttribute((const void*)mk_fwd, hipFuncAttributeMaxDynamicSharedMemorySize, LDS_BYTES) != hipSuccess) { fprintf(stderr, "kernel_launch: hipFuncSetAttribute failed\n"); grid = -1; return; }
        if (hipOccupancyMaxActiveBlocksPerMultiprocessor(&per_cu, (const void*)mk_fwd, NTHR, LDS_BYTES) != hipSuccess || per_cu < 1) fprintf(stderr, "kernel_launch: occupancy query says %d\n", per_cu);
        (void)hipGetLastError();
        grid = cus;
    }
    if (grid < 0) return;
    if (hipMemsetAsync((char*)d_ws + WS_CTL, 0, CTL_ZERO_BYTES, stream) != hipSuccess) return;
    Args a{};
    for (int i = 0; i < 36; ++i) a.in[i] = (const float*)d_in[i];
    a.out = (float*)d_out; a.ws = (unsigned char*)d_ws;
#if MK_MULTI
    for (int p = 0; p < N_PHASES; ++p) { a.ph_lo = p; a.ph_hi = p + 1; hipLaunchKernelGGL(mk_fwd, dim3(grid), dim3(NTHR), LDS_BYTES, stream, a); }
#else
    a.ph_lo = 0; a.ph_hi = N_PHASES; hipLaunchKernelGGL(mk_fwd, dim3(grid), dim3(NTHR), LDS_BYTES, stream, a);
#endif
    const hipError_t le = hipPeekAtLastError();
    if (le != hipSuccess) fprintf(stderr, "kernel_launch: launch failed: %s\n", hipGetErrorName(le));
}
```
